# Optimizing an MI355X kernel written in HIP

```python
import jax, jax.numpy as jnp
from jax import lax
import numpy as np

D_MODEL = 1024
BATCH = 4
SEQ = 8192
DEPTH = 4

CONV_DIM = D_MODEL // 2
CONV_WIDTH = 31
POOL_WINDOWS = (2, 4, 8, 16)
N_POOL_GROUPS = len(POOL_WINDOWS)
POOL_DIM = D_MODEL // 2
POOL_GROUP_DIM = POOL_DIM // N_POOL_GROUPS
POOL_GROUP_OUT = D_MODEL // N_POOL_GROUPS
IN_SPLITS = (CONV_DIM, 2 * CONV_DIM, 2 * CONV_DIM + POOL_DIM, 2 * CONV_DIM + POOL_DIM + D_MODEL)
IN_COLS = 2 * CONV_DIM + POOL_DIM + 2 * D_MODEL
D_FF = 2816
N_EXPERTS = 8
TOP_K = 2
D_FF_EXPERT = 3584
RMS_EPS = 1e-6
LN_EPS = 1e-5

kernel_name = "hybrid_conv_pool_gated_moe_trunk"


def rms_norm(x, g):
    xf = x.astype(jnp.float32)
    y = xf * lax.rsqrt(jnp.mean(xf * xf, axis=-1, keepdims=True) + RMS_EPS)
    return (y * g.astype(jnp.float32)).astype(x.dtype)


def layer_norm(x, g, b):
    xf = x.astype(jnp.float32)
    mu = jnp.mean(xf, axis=-1, keepdims=True)
    xc = xf - mu
    var = jnp.mean(xc * xc, axis=-1, keepdims=True)
    y = xc * lax.rsqrt(var + LN_EPS) * g.astype(jnp.float32) + b.astype(jnp.float32)
    return y.astype(x.dtype)


def swiglu(h, w_gate, w_up, w_down):
    return (jax.nn.silu(h @ w_gate) * (h @ w_up)) @ w_down


def conformer_conv(a, b, dw, dw_b, ln_g, ln_b, w_conv_out):
    u = a * jax.nn.sigmoid(b)
    u = lax.conv_general_dilated(
        u, dw[:, None, :].astype(u.dtype), window_strides=(1,),
        padding=[(CONV_WIDTH - 1, 0)],
        dimension_numbers=("NWC", "WIO", "NWC"),
        feature_group_count=u.shape[-1]) + dw_b
    u = jax.nn.silu(layer_norm(u, ln_g, ln_b))
    return u @ w_conv_out


def multiscale_pool(p, w_pool, pool_scale):
    B, S, _ = p.shape
    pf = p.astype(jnp.float32).reshape(B, S, N_POOL_GROUPS, POOL_GROUP_DIM)
    cs = jnp.cumsum(pf, axis=1)
    pos = jnp.arange(S, dtype=jnp.int32)
    deltas = []
    for g, w in enumerate(POOL_WINDOWS):
        csg = cs[:, :, g]
        prev = jnp.pad(csg, ((0, 0), (w, 0), (0, 0)))[:, :S]
        count = jnp.minimum(pos + 1, w).astype(jnp.float32)[:, None]
        deltas.append((csg - prev) / count - pf[:, :, g])
    d = jnp.stack(deltas, axis=2).astype(p.dtype)
    y = jnp.einsum("bsgc,gco->bsgo", d, w_pool).reshape(B, S, D_MODEL)
    return y * pool_scale


def hybrid_mixer(h, w_in, conv_dw, conv_dw_b, conv_ln_g, conv_ln_b, w_conv_out,
                 w_pool, pool_scale, w_out):
    proj = h @ w_in
    a, b, p, gc, gp = jnp.split(proj, IN_SPLITS, axis=-1)
    yc = conformer_conv(a, b, conv_dw, conv_dw_b, conv_ln_g, conv_ln_b, w_conv_out)
    yp = multiscale_pool(p, w_pool, pool_scale)
    merged = jax.nn.sigmoid(gc) * yc + jax.nn.sigmoid(gp) * yp
    return merged @ w_out


def moe_ffn(h, router_w, w_gate, w_up, w_down):
    B, S, D = h.shape
    t = h.reshape(B * S, D)
    logits = (t @ router_w).astype(jnp.float32)
    top_v, top_i = lax.top_k(logits, TOP_K)
    top_p = jax.nn.softmax(top_v, axis=-1)
    comb = jnp.sum(jax.nn.one_hot(top_i, N_EXPERTS, dtype=jnp.float32) * top_p[..., None],
                   axis=1).astype(h.dtype)
    y = jnp.zeros_like(t)
    for e in range(N_EXPERTS):
        y = y + comb[:, e:e + 1] * swiglu(t, w_gate[e], w_up[e], w_down[e])
    return y.reshape(B, S, D)


def setup_inputs(seed: int = 0) -> dict:
    key = jax.random.key(seed)
    ks = iter(jax.random.split(key, 32))
    n_dense = (DEPTH + 1) // 2
    n_moe = DEPTH // 2
    f32 = jnp.float32

    def nrm(shape, scale):
        return jax.random.normal(next(ks), shape, f32) * scale

    def gain(shape):
        return 1.0 + 0.02 * jax.random.normal(next(ks), shape, f32)

    return {
        "x": nrm((BATCH, SEQ, D_MODEL), 1.0),
        "mix_norm": gain((DEPTH, D_MODEL)),
        "w_in": nrm((DEPTH, D_MODEL, IN_COLS), D_MODEL ** -0.5),
        "conv_dw": nrm((DEPTH, CONV_WIDTH, CONV_DIM), CONV_WIDTH ** -0.5),
        "conv_dw_b": nrm((DEPTH, CONV_DIM), 0.02),
        "conv_ln_g": gain((DEPTH, CONV_DIM)),
        "conv_ln_b": nrm((DEPTH, CONV_DIM), 0.02),
        "w_conv_out": nrm((DEPTH, CONV_DIM, D_MODEL), CONV_DIM ** -0.5),
        "w_pool": nrm((DEPTH, N_POOL_GROUPS, POOL_GROUP_DIM, POOL_GROUP_OUT), POOL_GROUP_DIM ** -0.5),
        "pool_scale": gain((DEPTH, D_MODEL)),
        "w_out": nrm((DEPTH, D_MODEL, D_MODEL), D_MODEL ** -0.5),
        "ffn_norm": gain((DEPTH, D_MODEL)),
        "dense_w_gate": nrm((n_dense, D_MODEL, D_FF), D_MODEL ** -0.5),
        "dense_w_up": nrm((n_dense, D_MODEL, D_FF), D_MODEL ** -0.5),
        "dense_w_down": nrm((n_dense, D_FF, D_MODEL), D_FF ** -0.5),
        "router_w": nrm((n_moe, D_MODEL, N_EXPERTS), D_MODEL ** -0.5),
        "moe_w_gate": nrm((n_moe, N_EXPERTS, D_MODEL, D_FF_EXPERT), D_MODEL ** -0.5),
        "moe_w_up": nrm((n_moe, N_EXPERTS, D_MODEL, D_FF_EXPERT), D_MODEL ** -0.5),
        "moe_w_down": nrm((n_moe, N_EXPERTS, D_FF_EXPERT, D_MODEL), D_FF_EXPERT ** -0.5),
        "final_norm": gain((D_MODEL,)),
    }


def reference(x, mix_norm, w_in, conv_dw, conv_dw_b, conv_ln_g, conv_ln_b, w_conv_out,
              w_pool, pool_scale, w_out, ffn_norm, dense_w_gate, dense_w_up, dense_w_down,
              router_w, moe_w_gate, moe_w_up, moe_w_down, final_norm):
    for layer in range(DEPTH):
        h = rms_norm(x, mix_norm[layer])
        x = x + hybrid_mixer(h, w_in[layer], conv_dw[layer], conv_dw_b[layer],
                             conv_ln_g[layer], conv_ln_b[layer], w_conv_out[layer],
                             w_pool[layer], pool_scale[layer], w_out[layer])
        h = rms_norm(x, ffn_norm[layer])
        i = layer // 2
        if layer % 2 == 0:
            x = x + swiglu(h, dense_w_gate[i], dense_w_up[i], dense_w_down[i])
        else:
            x = x + moe_ffn(h, router_w[i], moe_w_gate[i], moe_w_up[i], moe_w_down[i])
    return rms_norm(x, final_norm)
```

```cpp
#include <hip/hip_runtime.h>
#include <cstdio>
#include <cstdint>

#ifndef PH_MASK
#define PH_MASK 0xFFF
#endif
#define PHON(b) ((PH_MASK >> (b)) & 1)
#ifndef DUP_MASK
#define DUP_MASK 0
#endif
#define NREP(b) (((DUP_MASK >> (b)) & 1) ? 2 : 1)
#ifndef MK_PER_PHASE
#define MK_PER_PHASE 0
#endif

#define LAS __attribute__((address_space(3)))
#define GAS __attribute__((address_space(1)))
typedef unsigned short bf16_t;
typedef short bf16x8 __attribute__((ext_vector_type(8)));
typedef float f32x4 __attribute__((ext_vector_type(4)));
typedef float f32x2 __attribute__((ext_vector_type(2)));
typedef unsigned u32x4 __attribute__((ext_vector_type(4)));
typedef unsigned u32x2 __attribute__((ext_vector_type(2)));
typedef GAS unsigned gu32;
typedef GAS bf16_t* gbf_t; typedef const GAS bf16_t* gcbf_t; typedef GAS float* gf_t; typedef const GAS float* gcf_t; typedef GAS unsigned* gu_t;
#define ST4U(p) (*(GAS u32x4*)(p))
#define LD4U(p) (*(const GAS u32x4*)(p))
#define ST4F(p) (*(GAS f32x4*)(p))
#define LD4F(p) (*(const GAS f32x4*)(p))
#define RLX_AGENT __ATOMIC_RELAXED, __HIP_MEMORY_SCOPE_AGENT

constexpr int NTOK = 32768, DM = 1024, SEQ = 8192, DEPTH = 4;
constexpr int CONV_DIM = 512, CONV_W = 31;
constexpr int IN_COLS = 3584;
constexpr int DFF = 2816, NEXP = 8, DFFE = 3584;
constexpr int NSLOT = 2 * NTOK + NEXP * 256;
constexpr float RMS_EPS = 1e-6f, LN_EPS = 1e-5f;
constexpr int NWAVES = 8;

constexpr size_t MiB = 1u << 20;
constexpr size_t WS_CTL = 0, CTL_ZERO_BYTES = 65536;
constexpr size_t WS_SSQ4 = 1 * MiB;
constexpr size_t WS_TOKE = 3 * MiB;
constexpr size_t WS_TOKP = WS_TOKE + 131072;
constexpr size_t WS_TOKR = WS_TOKP + 131072;
constexpr size_t WS_SLOTOF = WS_TOKR + 131072;
constexpr size_t WS_CNT = WS_SLOTOF + 262144;
constexpr size_t WS_PANEL = WS_CNT + 8192;
constexpr size_t WS_RSLOT = WS_PANEL + 4096;
constexpr size_t WS_WIN = 6 * MiB;
constexpr size_t WS_WM = 34 * MiB;
constexpr size_t WS_WOUT = 39 * MiB;
constexpr size_t WS_DGU = 47 * MiB;
constexpr size_t WS_DD = 69 * MiB;
constexpr size_t WS_MGU = 80 * MiB;
constexpr size_t WS_MD = 192 * MiB;
constexpr size_t WS_XB = 248 * MiB;
constexpr size_t WS_ACT = 312 * MiB;
constexpr size_t WS_U = WS_ACT;
constexpr size_t WS_P = WS_ACT + 32 * MiB;
constexpr size_t WS_RQ = WS_ACT + 64 * MiB;
constexpr size_t WS_SGP = WS_ACT + 128 * MiB;
constexpr size_t WS_SD = WS_ACT + 192 * MiB;
constexpr size_t WS_MERGED = WS_ACT + 256 * MiB;
constexpr size_t WS_HMID = WS_ACT;
constexpr size_t WS_XG = WS_ACT;
constexpr size_t WS_Y = WS_ACT + 66 * MiB;
constexpr size_t WS_HE = WS_ACT + 198 * MiB;
constexpr size_t WS_H8 = WS_ACT;
constexpr size_t WS_YP = WS_ACT + 464 * MiB;
constexpr size_t WS_END = WS_ACT + 594 * MiB;
constexpr size_t WS_XB8 = WS_ACT + 432 * MiB;
constexpr size_t WS_WIN8 = 20 * MiB;
constexpr size_t WS_DGU8 = 58 * MiB;
constexpr size_t WS_DD8 = 75 * MiB;
constexpr size_t WS_END2 = WS_END;
static_assert(WS_WIN + (size_t)2 * IN_COLS * DM * 2 <= WS_WIN8 && WS_WIN8 + (size_t)2 * IN_COLS * DM <= WS_WM && WS_DGU + (size_t)2 * DFF * DM * 2 <= WS_DGU8 && WS_DGU8 + (size_t)2 * DFF * DM <= WS_DD && WS_DD + (size_t)DM * DFF * 2 <= WS_DD8 && WS_DD8 + (size_t)DM * DFF <= WS_MGU && WS_XB8 + (size_t)NTOK * DM <= WS_END && WS_HE + (size_t)NSLOT * DFFE <= WS_XB8, "d_ws map (fp8 copies)");
static_assert((size_t)NSLOT * DM <= 66 * MiB && (size_t)NSLOT * DM * 2 <= 132 * MiB && WS_HE + (size_t)NSLOT * DFFE <= WS_END && (size_t)2 * NEXP * 2 * DFFE * DM <= 112 * MiB && (size_t)2 * NEXP * DFFE * DM <= 56 * MiB, "d_ws map");

constexpr int CW_BAR = 4096;

constexpr int RING_BYTES = 131072;
constexpr int LDSCTL_OFF = RING_BYTES, MISC_OFF = LDSCTL_OFF + 320, PTAB_OFF = LDSCTL_OFF + 1024;
constexpr int RTAB_OFF = LDSCTL_OFF + 3072, STAB_OFF = LDSCTL_OFF + 4096, RAW_OFF = LDSCTL_OFF + 8192;
constexpr int LDS_BYTES = 147456;

__device__ __forceinline__ unsigned cvt_pk_bf16(float lo, float hi) { unsigned r; asm volatile("v_cvt_pk_bf16_f32 %0, %1, %2" : "=v"(r) : "v"(lo), "v"(hi)); return r; }
__device__ __forceinline__ float bf_lo(unsigned w) { return __uint_as_float(w << 16); }
__device__ __forceinline__ float bf_hi(unsigned w) { return __uint_as_float(w & 0xffff0000u); }
__device__ __forceinline__ float fast_exp(float x) { return __builtin_amdgcn_exp2f(x * 1.4426950408889634f); }
__device__ __forceinline__ float clamp30(float x) { return __builtin_fminf(__builtin_fmaxf(x, -30.f), 30.f); }
__device__ __forceinline__ float sigmoidf_(float x) { return __builtin_amdgcn_rcpf(1.0f + fast_exp(-clamp30(x))); }
__device__ __forceinline__ int hw_tid(int wave) { unsigned ones = ~0u; asm volatile("" : "+s"(ones));
    return wave * 64 + (int)__builtin_amdgcn_mbcnt_hi(ones, __builtin_amdgcn_mbcnt_lo(ones, 0u)); }
template <int M> __device__ __forceinline__ int shx_i(int v, int lane) {
    if constexpr (M < 32) return __builtin_amdgcn_ds_swizzle(v, (M << 10) | 0x1F);
    else return __builtin_amdgcn_ds_bpermute((lane ^ 32) << 2, v);
}
template <int M> __device__ __forceinline__ float shx(float v, int lane) { return __int_as_float(shx_i<M>(__float_as_int(v), lane)); }
__device__ __forceinline__ float wave_sum_l(float v, int lane) { v += shx<1>(v, lane); v += shx<2>(v, lane); v += shx<4>(v, lane); v += shx<8>(v, lane); v += shx<16>(v, lane); v += shx<32>(v, lane); return v; }
#define LDS_WAIT() asm volatile("s_waitcnt lgkmcnt(0)" ::: "memory")
#define VM_WAIT() asm volatile("s_waitcnt vmcnt(0)" ::: "memory")

namespace pg8 {
constexpr int BM = 256, BK = 64, HALF = 128, HTB = HALF * BK * 2, STAGE_BYTES = 8 * HTB, NXCD = 8, WGM = 8;
__host__ __device__ __forceinline__ int lds_byte(int r, int c) { const int st = (r >> 4) * 2 + (c >> 5), rr = r & 15, cc = c & 31, ob = rr * 64 + cc * 2; return st * 1024 + (ob ^ (((ob >> 9) & 1) << 5)); }
__host__ __device__ __forceinline__ void stage_rc(int b, int& R, int& C) { const int st = b / 1024, sb = b % 1024, swz = sb ^ (((sb >> 9) & 1) << 5); R = (st >> 1) * 16 + swz / 64; C = (st & 1) * 32 + (swz % 64) / 2; }
__host__ __device__ __forceinline__ int perm32(int rho) { const int n = rho >> 4, i = rho & 15; return 8 * (i >> 2) + 4 * n + (i & 3); }

struct Unit { int pm, pn, pb; int kt0 = 0, ntu = 0, part = -1; };
struct Gemm { gcbf_t A; gcbf_t Bt; int lda, ldb, K; int sg_n = 4, sg_k = 0; };

struct KPlain { static __device__ __forceinline__ int koff(const Unit&, int t) { return t * BK; } };
struct KPlainV { static __device__ __forceinline__ int koff(const Unit& u, int t) { return (u.kt0 + t) * BK; } };
struct KMerge { static __device__ __forceinline__ int koff(const Unit& u, int t) { return t < 8 ? 512 + t * BK : u.pn * 128 + (t - 8) * BK; } };

struct StaticOrder {
    int nM, nN, nwg, G, c;
    __device__ __forceinline__ void init(int M, int N, int G_, int c_) { nM = M / BM; nN = N / BM; nwg = nM * nN; G = G_; c = c_; }
    __device__ __forceinline__ bool next(int i, Unit& u) const {
        const long L = (long)i * G + c; if (i > 0 && L >= nwg) return false;
        int wgid = (int)L; { const int q = nwg / NXCD, r = nwg % NXCD, xcd = wgid % NXCD, off = wgid / NXCD; wgid = (xcd < r ? xcd * (q + 1) : r * (q + 1) + (xcd - r) * q) + off; }
        const int nig = WGM * nN, gid = wgid / nig, fm = gid * WGM, gsz = (nM - fm) < WGM ? (nM - fm) : WGM;
        u.pm = __builtin_amdgcn_readfirstlane(fm + ((wgid % nig) % gsz)); u.pn = __builtin_amdgcn_readfirstlane((wgid % nig) / gsz); u.pb = u.pn; return true;
    }
};
struct HotOrder { int NU; int c; __device__ __forceinline__ bool next(int i, Unit& u) const { if (i >= NU) return false; u.pm = 0; u.pn = 0; u.pb = 0; return true; } };
struct MoeOrder {
    int nM, nN, nwg, G, c; const LAS unsigned* ptab;
    __device__ __forceinline__ void init(const LAS unsigned* pt, int N, int G_, int c_) { ptab = pt; nM = __builtin_amdgcn_readfirstlane((int)pt[0]); nN = N / BM; nwg = nM * nN; G = G_; c = c_; }
    __device__ __forceinline__ bool next(int i, Unit& u) const {
        const long L = (long)i * G + c; if (i > 0 && L >= nwg) return false;
        int wgid = (int)L; { const int q = nwg / NXCD, r = nwg % NXCD, xcd = wgid % NXCD, off = wgid / NXCD; wgid = (xcd < r ? xcd * (q + 1) : r * (q + 1) + (xcd - r) * q) + off; }
        const int nig = WGM * nN, gid = wgid / nig, fm = gid * WGM, gsz = (nM - fm) < WGM ? (nM - fm) : WGM;
        u.pm = __builtin_amdgcn_readfirstlane(fm + ((wgid % nig) % gsz)); u.pn = __builtin_amdgcn_readfirstlane((wgid % nig) / gsz);
        u.pb = __builtin_amdgcn_readfirstlane((int)ptab[1 + u.pm]) * nN + u.pn; return true;
    }
};

struct MoeOrder2 {
    int nM, mainP, tailP, S, Um, nwg, G, c; const LAS unsigned* ptab;
    static __device__ __forceinline__ void split(int nM_, int G_, int& mainP_, int& tailP_, int& S_) {
        tailP_ = (G_ % 4 == 0) ? nM_ % (G_ / 4) : 0; S_ = tailP_ == 0 ? 1 : (28 * tailP_ <= G_ ? 7 : (8 * tailP_ <= G_ ? 2 : 1));
        if (S_ == 1) tailP_ = 0; mainP_ = nM_ - tailP_; }
    __device__ __forceinline__ void init(const LAS unsigned* pt, int G_, int c_) { ptab = pt; nM = __builtin_amdgcn_readfirstlane((int)pt[0]); G = G_; c = c_; split(nM, G, mainP, tailP, S); mainP = __builtin_amdgcn_readfirstlane(mainP); tailP = __builtin_amdgcn_readfirstlane(tailP); S = __builtin_amdgcn_readfirstlane(S); Um = mainP * 4; nwg = Um + tailP * 4 * S; }
    __device__ __forceinline__ bool next(int i, Unit& u) const {
        const long L = (long)i * G + c; if (i > 0 && L >= nwg) return false;
        if (L < Um) { int wgid = (int)L; { const int q = Um / NXCD, r = Um % NXCD, xcd = wgid % NXCD, off = wgid / NXCD; wgid = (xcd < r ? xcd * (q + 1) : r * (q + 1) + (xcd - r) * q) + off; }
            const int nig = WGM * 4, gid = wgid / nig, fm = gid * WGM, gsz = (mainP - fm) < WGM ? (mainP - fm) : WGM;
            u.pm = __builtin_amdgcn_readfirstlane(fm + ((wgid % nig) % gsz)); u.pn = __builtin_amdgcn_readfirstlane((wgid % nig) / gsz); u.kt0 = 0; u.ntu = 28; u.part = -1; }
        else { const int q = (int)L - Um, j = q / S, sp = q % S; u.pm = __builtin_amdgcn_readfirstlane(mainP + j / 4); u.pn = __builtin_amdgcn_readfirstlane(j % 4); u.ntu = __builtin_amdgcn_readfirstlane(28 / S); u.kt0 = __builtin_amdgcn_readfirstlane(sp * (28 / S)); u.part = __builtin_amdgcn_readfirstlane(sp); }
        u.pb = __builtin_amdgcn_readfirstlane((int)ptab[1 + u.pm]) * 4 + u.pn; return true;
    }
};

typedef f32x4 Acc[2][2][4][2];

__device__ __forceinline__ u32x4 pack8(const f32x4 v0, const f32x4 v1) { u32x4 w; w.x = cvt_pk_bf16(v0[0], v0[1]); w.y = cvt_pk_bf16(v0[2], v0[3]); w.z = cvt_pk_bf16(v1[0], v1[1]); w.w = cvt_pk_bf16(v1[2], v1[3]); return w; }
__device__ __forceinline__ void unpack8(const u32x4 w, f32x4& v0, f32x4& v1) { v0 = (f32x4){bf_lo(w.x), bf_hi(w.x), bf_lo(w.y), bf_hi(w.y)}; v1 = (f32x4){bf_lo(w.z), bf_hi(w.z), bf_lo(w.w), bf_hi(w.w)}; }

__device__ __forceinline__ unsigned long long uni64(const GAS char* p) { const unsigned long long v = (unsigned long long)p; const unsigned lo = __builtin_amdgcn_readfirstlane((unsigned)v), hi = __builtin_amdgcn_readfirstlane((unsigned)(v >> 32)); return ((unsigned long long)hi << 32) | lo; }
typedef short s16x2 __attribute__((ext_vector_type(2)));
__device__ __forceinline__ unsigned pk_fp8x4_s(float a, float b, float c, float d, float scale) { s16x2 w = {0, 0}; w = __builtin_amdgcn_cvt_scalef32_pk_fp8_f32(w, a, b, scale, false); w = __builtin_amdgcn_cvt_scalef32_pk_fp8_f32(w, c, d, scale, true); return __builtin_bit_cast(unsigned, w); }
__device__ __forceinline__ unsigned pk_fp8x4(float a, float b, float c, float d) { int w = __builtin_amdgcn_cvt_pk_fp8_f32(a, b, 0, false); w = __builtin_amdgcn_cvt_pk_fp8_f32(c, d, w, true); return (unsigned)w; }

__device__ __forceinline__ void unpack_fp8x8(const u32x2 w, f32x4& a, f32x4& b) {
    const f32x2 a0 = __builtin_amdgcn_cvt_pk_f32_fp8((int)w.x, false), a1 = __builtin_amdgcn_cvt_pk_f32_fp8((int)w.x, true), b0 = __builtin_amdgcn_cvt_pk_f32_fp8((int)w.y, false), b1 = __builtin_amdgcn_cvt_pk_f32_fp8((int)w.y, true);
    a = (f32x4){a0.x, a0.y, a1.x, a1.y}; b = (f32x4){b0.x, b0.y, b1.x, b1.y}; }

struct PreNone { static constexpr bool HAS_PRE = false;
    __device__ __forceinline__ void issue(const Unit&, int, int) const {}
    __device__ __forceinline__ void finish(int) const {} };
struct PreSsq4 { static constexpr bool HAS_PRE = true;
    gcf_t ssq4; LAS float* rtab; LAS float* raw;
    __device__ __forceinline__ void issue(const Unit& u, int tid, int wid) const {
        if (wid < 4) { int te = tid; asm volatile("" : "+v"(te)); const unsigned vo = (unsigned)te * 4u, l0 = (unsigned)(size_t)raw + (unsigned)wid * 256u;
#pragma unroll
            for (int k = 0; k < 4; ++k) { unsigned keep;
                asm volatile("s_mov_b32 %0, m0\n\ts_mov_b32 m0, %3\n\ts_nop 0\n\tglobal_load_lds_dword %1, %2\n\ts_mov_b32 m0, %0" : "=&s"(keep) : "v"(vo), "s"(uni64((const GAS char*)(ssq4 + u.pm * BM + k * NTOK))), "s"(l0 + (unsigned)k * 1024u) : "memory"); } } }
    __device__ __forceinline__ void finish(int tid) const {
        asm volatile("s_waitcnt vmcnt(16)" ::: "memory");
        int te = tid; asm volatile("" : "+v"(te));
        if (te < 256) { const unsigned la = (unsigned)(size_t)raw + (unsigned)te * 4u; float a, b, c, d;
            asm volatile("ds_read_b32 %0, %4\n\tds_read_b32 %1, %4 offset:1024\n\tds_read_b32 %2, %4 offset:2048\n\tds_read_b32 %3, %4 offset:3072\n\ts_waitcnt lgkmcnt(0)" : "=&v"(a), "=&v"(b), "=&v"(c), "=&v"(d) : "v"(la) : "memory");
            rtab[te] = __builtin_amdgcn_rsqf(((a + b) + (c + d)) * (1.0f / DM) + RMS_EPS); } } };
struct PreRow { static constexpr bool HAS_PRE = true;
    gcf_t rrow; LAS float* rtab; LAS float* raw;
    __device__ __forceinline__ void issue(const Unit& u, int tid, int wid) const {
        if (wid < 4) { int te = tid; asm volatile("" : "+v"(te)); const unsigned vo = (unsigned)te * 4u, l0 = (unsigned)(size_t)raw + (unsigned)wid * 256u; unsigned keep;
            asm volatile("s_mov_b32 %0, m0\n\ts_mov_b32 m0, %3\n\ts_nop 0\n\tglobal_load_lds_dword %1, %2\n\ts_mov_b32 m0, %0" : "=&s"(keep) : "v"(vo), "s"(uni64((const GAS char*)(rrow + u.pm * BM))), "s"(l0) : "memory"); } }
    __device__ __forceinline__ void finish(int tid) const {
        asm volatile("s_waitcnt vmcnt(16)" ::: "memory");
        int te = tid; asm volatile("" : "+v"(te));
        if (te < 256) { const unsigned la = (unsigned)(size_t)raw + (unsigned)te * 4u; float a;
            asm volatile("ds_read_b32 %0, %1\n\ts_waitcnt lgkmcnt(0)" : "=&v"(a) : "v"(la) : "memory");
            rtab[te] = a; } } };

struct EpiIn {
    static constexpr bool HAS_MID = false; static constexpr int MID_T = -1; typedef PreSsq4 Pre;
    Pre pre; gbf_t U, P, RQ, SGP; float ascale;
    __device__ __forceinline__ void mid(Acc&, const Unit&, int, int, int, int) const {}
    __device__ __forceinline__ void operator()(const Acc& acc, const Unit& u, int wr, int wc, int fr, int fq) const {
        const int rl0 = wr * 64 + fr, row0 = u.pm * BM + rl0, cw = wc * 32 + 8 * fq;
        float rs[2][4];
#pragma unroll
        for (int ai = 0; ai < 2; ++ai)
#pragma unroll
            for (int m = 0; m < 4; ++m) rs[ai][m] = pre.rtab[rl0 + ai * HALF + m * 16] * ascale;
        if (u.pn < 4) {
#pragma unroll
            for (int ai = 0; ai < 2; ++ai)
#pragma unroll
                for (int m = 0; m < 4; ++m) { const int row = row0 + ai * HALF + m * 16; const float r = rs[ai][m], rn = r * -1.4426950408889634f; f32x4 o[2];
#pragma unroll
                    for (int n = 0; n < 2; ++n)
#pragma unroll
                        for (int j = 0; j < 4; ++j) { const float a = acc[ai][0][m][n][j] * r, e = __builtin_amdgcn_exp2f(acc[ai][1][m][n][j] * rn); o[n][j] = a * __builtin_amdgcn_rcpf(1.0f + e); }
                    ST4U(U + ((unsigned)row * CONV_DIM + u.pn * 128 + cw)) = pack8(o[0], o[1]); }
        } else if (u.pn < 6) {
#pragma unroll
            for (int ai = 0; ai < 2; ++ai)
#pragma unroll
                for (int m = 0; m < 4; ++m) { const int row = row0 + ai * HALF + m * 16; const float r = rs[ai][m];
#pragma unroll
                    for (int bj = 0; bj < 2; ++bj) ST4U(P + ((unsigned)row * 512 + (u.pn - 4) * 256 + bj * HALF + cw)) = pack8(acc[ai][bj][m][0] * r, acc[ai][bj][m][1] * r); }
        } else {
#pragma unroll
            for (int ai = 0; ai < 2; ++ai)
#pragma unroll
                for (int m = 0; m < 4; ++m) { const int row = row0 + ai * HALF + m * 16; const float rn = rs[ai][m] * -1.4426950408889634f; unsigned qc[2][4], qp[2][4];
#pragma unroll
                    for (int n = 0; n < 2; ++n)
#pragma unroll
                        for (int j = 0; j < 4; ++j) { const float ec = __builtin_amdgcn_exp2f(acc[ai][0][m][n][j] * rn), ep = __builtin_amdgcn_exp2f(acc[ai][1][m][n][j] * rn);
                            qc[n][j] = __float_as_uint(__builtin_fmaf(__builtin_amdgcn_rcpf(1.0f + ec), 255.0f, 8388608.0f));
                            qp[n][j] = __float_as_uint(__builtin_fmaxf(__builtin_amdgcn_rcpf(1.0f + ep) * 255.0f, 1.0f) + 8388608.0f); }
                    const unsigned off = (unsigned)row * DM + (u.pn - 6) * 128 + cw;
                    u32x4 wq;
#pragma unroll
                    for (int d = 0; d < 4; ++d) { const int n = d >> 1, j = 2 * (d & 1);
                        wq[d] = __builtin_amdgcn_perm(__builtin_amdgcn_perm(qp[n][j + 1], qc[n][j + 1], 0x0c0c0400u), __builtin_amdgcn_perm(qp[n][j], qc[n][j], 0x0c0c0400u), 0x05040100u); }
                    ST4U((GAS unsigned char*)RQ + 2u * off) = wq; }
        }
    }
};
__device__ __forceinline__ u32x4 widen8(u32x2 a, u32x2 b) {
    const auto rx = __builtin_amdgcn_permlane16_swap(a.x, b.x, false, false), ry = __builtin_amdgcn_permlane16_swap(a.y, b.y, false, false);
    u32x4 o; o.x = rx[0]; o.y = ry[0]; o.z = rx[1]; o.w = ry[1]; return o; }
__device__ __forceinline__ void unpack_gates(const u32x4 w, f32x4& c0, f32x4& c1, f32x4& p0, f32x4& p1) {
    c0 = (f32x4){(float)(w.x & 255u), (float)((w.x >> 16) & 255u), (float)(w.y & 255u), (float)((w.y >> 16) & 255u)}; p0 = (f32x4){(float)((w.x >> 8) & 255u), (float)(w.x >> 24), (float)((w.y >> 8) & 255u), (float)(w.y >> 24)};
    c1 = (f32x4){(float)(w.z & 255u), (float)((w.z >> 16) & 255u), (float)(w.w & 255u), (float)((w.w >> 16) & 255u)}; p1 = (f32x4){(float)((w.z >> 8) & 255u), (float)(w.z >> 24), (float)((w.w >> 8) & 255u), (float)(w.w >> 24)}; }
template <bool F8  > struct EpiMerge {
    static constexpr bool HAS_MID = true; static constexpr int MID_T = 8; typedef PreNone Pre;
    Pre pre; gcbf_t RQ, SGP; gbf_t MG;
    __device__ __forceinline__ void mid(Acc& acc, const Unit& u, int wr, int wc, int fr, int fq) const {
        const int row0 = u.pm * BM + wr * 64 + fr, col0 = u.pn * BM + wc * 32 + 8 * fq;
        u32x4 wg_[2][4][2];
#pragma unroll
        for (int ai = 0; ai < 2; ++ai)
#pragma unroll
            for (int m = 0; m < 4; ++m)
#pragma unroll
                for (int bj = 0; bj < 2; ++bj) wg_[ai][m][bj] = LD4U((const GAS unsigned char*)RQ + 2u * ((unsigned)(row0 + ai * HALF + m * 16) * DM + col0 + bj * HALF));
        __builtin_amdgcn_sched_barrier(0);
#pragma unroll
        for (int ai = 0; ai < 2; ++ai)
#pragma unroll
            for (int m = 0; m < 4; ++m)
#pragma unroll
                for (int bj = 0; bj < 2; ++bj) { f32x4 c0, c1, p0, p1; unpack_gates(wg_[ai][m][bj], c0, c1, p0, p1);
#pragma unroll
                    for (int j = 0; j < 4; ++j) { acc[ai][bj][m][0][j] *= c0[j] * __builtin_amdgcn_rcpf(p0[j]); acc[ai][bj][m][1][j] *= c1[j] * __builtin_amdgcn_rcpf(p1[j]); } }
    }
    __device__ __forceinline__ void operator()(const Acc& acc, const Unit& u, int wr, int wc, int fr, int fq) const {
        const int row0 = u.pm * BM + wr * 64 + fr, col0 = u.pn * BM + wc * 32 + 8 * fq;
        u32x4 w[2][4][2]; u32x2 o8[2][2]; (void)o8;
#pragma unroll
        for (int ai = 0; ai < 2; ++ai)
#pragma unroll
            for (int m = 0; m < 4; ++m)
#pragma unroll
                for (int bj = 0; bj < 2; ++bj) w[ai][m][bj] = LD4U((const GAS unsigned char*)RQ + 2u * ((unsigned)(row0 + ai * HALF + m * 16) * DM + col0 + bj * HALF));
        __builtin_amdgcn_sched_barrier(0);
#pragma unroll
        for (int ai = 0; ai < 2; ++ai)
#pragma unroll
            for (int m = 0; m < 4; ++m)
#pragma unroll
                for (int bj = 0; bj < 2; ++bj) { f32x4 c0, c1, s0, s1; unpack_gates(w[ai][m][bj], c0, c1, s0, s1); (void)c0; (void)c1; const f32x4 a = acc[ai][bj][m][0] * (s0 * (1.0f / 255.0f)), b = acc[ai][bj][m][1] * (s1 * (1.0f / 255.0f));
                    if constexpr (F8) { o8[m & 1][bj].x = pk_fp8x4(a[0], a[1], a[2], a[3]); o8[m & 1][bj].y = pk_fp8x4(b[0], b[1], b[2], b[3]);
                        if (m & 1) ST4U((GAS unsigned char*)MG + ((unsigned)(row0 + ai * HALF + (m - 1) * 16 + (fq & 1) * 16) * DM + (col0 - 8 * (fq & 1)) + bj * HALF)) = widen8(o8[0][bj], o8[1][bj]); }
                    else ST4U(MG + ((unsigned)(row0 + ai * HALF + m * 16) * DM + col0 + bj * HALF)) = pack8(a, b); }
    }
};
struct EpiRes {
    static constexpr bool HAS_MID = false; static constexpr int MID_T = -1; typedef PreNone Pre;
    Pre pre; gbf_t xs; gf_t ssq4; LAS float* stab; float scale; GAS unsigned char* xb8;
    __device__ __forceinline__ void mid(Acc&, const Unit&, int, int, int, int) const {}
    __device__ __forceinline__ void operator()(const Acc& acc, const Unit& u, int wr, int wc, int fr, int fq) const {
        const int rl0 = wr * 64 + fr, col0 = u.pn * BM + wc * 32 + 8 * fq;
        u32x4 xw[2][4][2]; u32x2 w8[2][2];
#pragma unroll
        for (int ai = 0; ai < 2; ++ai)
#pragma unroll
            for (int m = 0; m < 4; ++m)
#pragma unroll
                for (int bj = 0; bj < 2; ++bj) xw[ai][m][bj] = LD4U(xs + ((unsigned)(u.pm * BM + rl0 + ai * HALF + m * 16) * DM + col0 + bj * HALF));
#pragma unroll
        for (int ai = 0; ai < 2; ++ai)
#pragma unroll
            for (int m = 0; m < 4; ++m) { const int rl = rl0 + ai * HALF + m * 16; const unsigned off = (unsigned)(u.pm * BM + rl) * DM + col0; float ss = 0.f;
#pragma unroll
                for (int bj = 0; bj < 2; ++bj) { f32x4 x0, x1; unpack8(xw[ai][m][bj], x0, x1);
                    const f32x4 y0 = x0 + acc[ai][bj][m][0] * scale, y1 = x1 + acc[ai][bj][m][1] * scale;
                    ST4U(xs + off + bj * HALF) = pack8(y0, y1);
                    if (xb8) { w8[m & 1][bj].x = pk_fp8x4(y0[0], y0[1], y0[2], y0[3]); w8[m & 1][bj].y = pk_fp8x4(y1[0], y1[1], y1[2], y1[3]);
                        if (m & 1) ST4U(xb8 + ((unsigned)(u.pm * BM + rl - 16 + (fq & 1) * 16) * DM + (col0 - 8 * (fq & 1)) + bj * HALF)) = widen8(w8[0][bj], w8[1][bj]); }
                    ss += ((y0[0] * y0[0] + y0[1] * y0[1]) + (y0[2] * y0[2] + y0[3] * y0[3])) + ((y1[0] * y1[0] + y1[1] * y1[1]) + (y1[2] * y1[2] + y1[3] * y1[3])); }
                ss += shx<16>(ss, fq * 16 + fr); ss += shx<32>(ss, fq * 16 + fr);
                if (fq == 0) stab[rl * 4 + wc] = ss; }
        asm volatile("s_waitcnt lgkmcnt(0)" ::: "memory"); __builtin_amdgcn_s_barrier(); asm volatile("" ::: "memory");
        const int tid = (wr * 4 + wc) * 64 + fq * 16 + fr;
        if (tid < 256) { const f32x4 v = *(const LAS f32x4*)(stab + tid * 4); ssq4[(unsigned)(u.pn * NTOK + u.pm * BM + tid)] = (v[0] + v[1]) + (v[2] + v[3]); }
    }
};
template <class PRE, bool O8  > struct EpiSwiglu {
    static constexpr bool HAS_MID = false; static constexpr int MID_T = -1; typedef PRE Pre;
    Pre pre; GAS void* Hv; int ldh;
    __device__ __forceinline__ void mid(Acc&, const Unit&, int, int, int, int) const {}
    __device__ __forceinline__ void operator()(const Acc& acc, const Unit& u, int wr, int wc, int fr, int fq) const {
        const int rl0 = wr * 64 + fr, row0 = u.pm * BM + rl0, cw = wc * 32 + 8 * fq;
        float rs[2][4]; u32x2 w8[2]; (void)w8;
#pragma unroll
        for (int ai = 0; ai < 2; ++ai)
#pragma unroll
            for (int m = 0; m < 4; ++m) rs[ai][m] = pre.rtab[rl0 + ai * HALF + m * 16] * (O8 ? 0.03125f : 1.0f);
#pragma unroll
        for (int ai = 0; ai < 2; ++ai)
#pragma unroll
            for (int m = 0; m < 4; ++m) { const int row = row0 + ai * HALF + m * 16; const float r = rs[ai][m], rr = O8 ? r * r * 4.0f : r * r, rn = r * -1.4426950408889634f; f32x4 o[2];
#pragma unroll
                for (int n = 0; n < 2; ++n)
#pragma unroll
                    for (int j = 0; j < 4; ++j) { float tg; asm("v_mul_f32 %0, %1, %2" : "=v"(tg) : "v"(acc[ai][0][m][n][j]), "v"(acc[ai][1][m][n][j]));
                        const float e = __builtin_amdgcn_exp2f(acc[ai][0][m][n][j] * rn); o[n][j] = tg * (rr * __builtin_amdgcn_rcpf(1.0f + e)); }
                if constexpr (O8) { w8[m & 1].x = pk_fp8x4(o[0][0], o[0][1], o[0][2], o[0][3]); w8[m & 1].y = pk_fp8x4(o[1][0], o[1][1], o[1][2], o[1][3]);
                    if (m & 1) ST4U((GAS unsigned char*)Hv + ((unsigned)(row - 16 + (fq & 1) * 16) * ldh + u.pn * 128 + cw - 8 * (fq & 1))) = widen8(w8[0], w8[1]); }
                else ST4U((gbf_t)Hv + ((unsigned)row * ldh + u.pn * 128 + cw)) = pack8(o[0], o[1]); }
    }
};
struct EpiSwiglu8 {
    static constexpr bool HAS_MID = false; static constexpr int MID_T = -1; typedef PreNone Pre;
    Pre pre; GAS unsigned char* H; int ldh;
    __device__ __forceinline__ void mid(Acc&, const Unit&, int, int, int, int) const {}
    __device__ __forceinline__ void operator()(const Acc& acc, const Unit& u, int wr, int wc, int fr, int fq) const {
        float c256 = 256.0f; asm volatile("" : "+s"(c256));
        const int row0 = u.pm * BM + wr * 64 + fr + (fq & 1) * 16, cw = wc * 32 + 8 * (fq & ~1);
#pragma unroll
        for (int ai = 0; ai < 2; ++ai)
#pragma unroll
            for (int mp = 0; mp < 2; ++mp) { u32x2 w[2];
#pragma unroll
                for (int q = 0; q < 2; ++q) { const int m = 2 * mp + q; f32x4 o[2];
#pragma unroll
                    for (int n = 0; n < 2; ++n)
#pragma unroll
                        for (int j = 0; j < 4; ++j) { float tg; asm("v_mul_f32 %0, %1, %2" : "=v"(tg) : "v"(acc[ai][0][m][n][j]), "v"(acc[ai][1][m][n][j]));
                            const float e = __builtin_amdgcn_exp2f(acc[ai][0][m][n][j] * (-0.03125f * 1.4426950408889634f)); o[n][j] = tg * __builtin_amdgcn_rcpf(1.0f + e); }
                    w[q].x = pk_fp8x4_s(o[0][0], o[0][1], o[0][2], o[0][3], c256); w[q].y = pk_fp8x4_s(o[1][0], o[1][1], o[1][2], o[1][3], c256); }
                ST4U(H + ((unsigned)(row0 + ai * HALF + mp * 32) * ldh + u.pn * 128 + cw)) = widen8(w[0], w[1]); }
    }
};
constexpr int TAIL_ROWS = 9 * 256;
constexpr int TAIL_ROWS2 = 32 * 256;
struct EpiY {
    static constexpr bool HAS_MID = false; static constexpr int MID_T = -1; typedef PreNone Pre;
    Pre pre; gbf_t Y; float scale; gbf_t YP; int main_rows, slab_rows;
    __device__ __forceinline__ void mid(Acc&, const Unit&, int, int, int, int) const {}
    __device__ __forceinline__ void operator()(const Acc& acc, const Unit& u, int wr, int wc, int fr, int fq) const {
        const int row0 = u.pm * BM + wr * 64 + fr, col0 = u.pn * BM + wc * 32 + 8 * fq;
        if (u.part < 0) { GAS unsigned char* base = (GAS unsigned char*)Y + (unsigned)(row0 + (fq & 1) * 16) * DM + (col0 - 8 * (fq & 1)); const float s16 = scale * 16.0f;
#pragma unroll
            for (int ai = 0; ai < 2; ++ai)
#pragma unroll
                for (int mp = 0; mp < 2; ++mp)
#pragma unroll
                    for (int bj = 0; bj < 2; ++bj) { u32x2 w[2];
#pragma unroll
                        for (int q = 0; q < 2; ++q) { const f32x4 a = acc[ai][bj][2 * mp + q][0] * s16, b = acc[ai][bj][2 * mp + q][1] * s16; w[q].x = pk_fp8x4(a[0], a[1], a[2], a[3]); w[q].y = pk_fp8x4(b[0], b[1], b[2], b[3]); }
                        ST4U(base + ((unsigned)(ai * HALF + mp * 32) * DM + bj * HALF)) = widen8(w[0], w[1]); }
        } else { gbf_t base = YP + (unsigned)(u.part * slab_rows + row0 - main_rows) * DM;
#pragma unroll
            for (int ai = 0; ai < 2; ++ai)
#pragma unroll
                for (int m = 0; m < 4; ++m) { gbf_t rp = base + ((unsigned)(ai * HALF + m * 16) * DM + col0);
#pragma unroll
                    for (int bj = 0; bj < 2; ++bj) ST4U(rp + bj * HALF) = pack8(acc[ai][bj][m][0] * scale, acc[ai][bj][m][1] * scale); } }
    }
};

typedef int i32x4 __attribute__((ext_vector_type(4)));
typedef int i32x8 __attribute__((ext_vector_type(8)));
#ifndef SG_OUT
#define SG_MG 0
#define SG_OUT 0
#define SG_F2 0
#endif
#ifndef STAG_STEP
#define STAG_STEP 0
#endif
template <class Epi, class Sched, class KA, bool FP8 = false, bool VARK = false>
__device__ __forceinline__ void gemm_phase(LAS unsigned char* lds, const Gemm g, const Sched& S, const Epi& E, int wave_) {
    { const int grp = (S.c >> 3) % g.sg_n;
      if (g.sg_k > 0) { for (int q = 0; q < grp * g.sg_k; ++q) __builtin_amdgcn_s_sleep(100); } else if (STAG_STEP > 0) { for (int q = 0; q < grp; ++q) __builtin_amdgcn_s_sleep(STAG_STEP); } }
    int tid_ = hw_tid(wave_); asm volatile("" : "+v"(tid_));
    const int tid = tid_, wid = __builtin_amdgcn_readfirstlane(tid >> 6), lane = tid & 63, wr = wid >> 2, wc = wid & 3, fr = lane & 15, fq = lane >> 4;
    const int K = g.K, nt = K / BK;
    unsigned voffA[2], voffB[2];
#pragma unroll
    for (int i = 0; i < 2; ++i) { int R, C; stage_rc(tid * 16 + i * 8192, R, C); const int Rb = (R & ~31) + perm32(R & 31);
        voffA[i] = (unsigned)(R * g.lda + C) * 2u; voffB[i] = (unsigned)(Rb * g.ldb + C) * 2u; }
    const size_t kstep = (size_t)(BK * 2);
    const size_t hstepA = (size_t)HALF * g.lda * 2, hstepB = (size_t)HALF * g.ldb * 2;
    const size_t tstepA = 2 * hstepA, tstepB = 2 * hstepB;
    const unsigned ldsw = (unsigned)wid * 1024u, lds0 = (unsigned)(size_t)lds;
    const int aoff = lds_byte(wr * 64 + fr, fq * 8), boff = lds_byte(wc * 32 + fr, fq * 8);
#define PG8_SA(b, h) (((b) * 2 + (h)) * HTB)
#define PG8_SB(b, h) ((4 + (b) * 2 + (h)) * HTB)
#define PG8_STAGE(bufoff, gbase, voff) do { _Pragma("unroll") for (int _i = 0; _i < 2; ++_i) { unsigned _keep; \
        asm volatile("s_mov_b32 %0, m0\n\ts_mov_b32 m0, %3\n\ts_nop 0\n\tglobal_load_lds_dwordx4 %1, %2\n\ts_mov_b32 m0, %0" : "=&s"(_keep) : "v"((voff)[_i]), "s"(uni64(gbase)), "s"(lds0 + (unsigned)(bufoff) + ldsw + (unsigned)(_i * 8192)) : "memory"); } } while (0)
#define PG8_LDA(dst, b, h) do { _Pragma("unroll") for (int m = 0; m < 4; ++m) { if constexpr (FP8) dst##8[m] = __builtin_shufflevector(*(const LAS i32x4*)(lds + PG8_SA(b, h) + aoff + m * 2048), *(const LAS i32x4*)(lds + PG8_SA(b, h) + aoff + m * 2048 + 1024), 0, 1, 2, 3, 4, 5, 6, 7); \
        else { _Pragma("unroll") for (int k = 0; k < 2; ++k) dst[m][k] = *(const LAS bf16x8*)(lds + PG8_SA(b, h) + aoff + m * 2048 + k * 1024); } } } while (0)
#define PG8_LDB(dst, b, h) do { _Pragma("unroll") for (int n = 0; n < 2; ++n) { if constexpr (FP8) dst##8[n] = __builtin_shufflevector(*(const LAS i32x4*)(lds + PG8_SB(b, h) + boff + n * 2048), *(const LAS i32x4*)(lds + PG8_SB(b, h) + boff + n * 2048 + 1024), 0, 1, 2, 3, 4, 5, 6, 7); \
        else { _Pragma("unroll") for (int k = 0; k < 2; ++k) dst[n][k] = *(const LAS bf16x8*)(lds + PG8_SB(b, h) + boff + n * 2048 + k * 1024); } } } while (0)
#define PG8_MMA(ai, bj, At, Bt) do { __builtin_amdgcn_s_setprio(1); _Pragma("unroll") for (int m = 0; m < 4; ++m) _Pragma("unroll") for (int n = 0; n < 2; ++n) { \
        if constexpr (FP8) { acc[ai][bj][m][n] = __builtin_amdgcn_mfma_scale_f32_16x16x128_f8f6f4(Bt##8[n], At##8[m], acc[ai][bj][m][n], 0, 0, 0, 0, 0, 0); } \
        else { _Pragma("unroll") for (int k = 0; k < 2; ++k) acc[ai][bj][m][n] = __builtin_amdgcn_mfma_f32_16x16x32_bf16(Bt[n][k], At[m][k], acc[ai][bj][m][n], 0, 0, 0); } } \
        __builtin_amdgcn_s_setprio(0); } while (0)
#define PG8_WAIT_V(n) asm volatile("s_waitcnt vmcnt(" #n ")" ::: "memory")
#define PG8_WAIT_L(n) asm volatile("s_waitcnt lgkmcnt(" #n ")" ::: "memory")
#define PG8_BAR __builtin_amdgcn_s_barrier()
#define PG8_SCHED __builtin_amdgcn_sched_barrier(0)
    Unit cur, nxt; int ui = 0;
    if (!S.next(0, cur)) return;
    Acc acc;
    {
#pragma unroll
    for (int a = 0; a < 2; ++a)
#pragma unroll
        for (int b = 0; b < 2; ++b)
#pragma unroll
            for (int m = 0; m < 4; ++m)
#pragma unroll
                for (int n = 0; n < 2; ++n) acc[a][b][m][n] = (f32x4){0.f, 0.f, 0.f, 0.f}; }
    bf16x8 At[4][2], B0[2][2], B1[2][2];
    i32x8 At8[4], B08[2], B18[2];
    typedef const GAS char* gcc_t;
    gcc_t cA = (gcc_t)g.A + (size_t)cur.pm * tstepA; gcc_t cB = (gcc_t)g.Bt + (size_t)cur.pb * tstepB + (VARK ? (size_t)cur.kt0 * kstep : 0);
    {
        gcc_t a0 = cA + (size_t)KA::koff(cur, 0) * 2; gcc_t a1 = cA + (size_t)KA::koff(cur, 1) * 2;
        PG8_STAGE(PG8_SB(0, 0), cB, voffB); PG8_STAGE(PG8_SB(0, 1), cB + hstepB, voffB); PG8_STAGE(PG8_SA(0, 0), a0, voffA); PG8_STAGE(PG8_SA(0, 1), a0 + hstepA, voffA);
        if (wr == 1) PG8_BAR;
        PG8_WAIT_V(2); PG8_BAR;
        PG8_STAGE(PG8_SB(1, 0), cB + kstep, voffB); PG8_STAGE(PG8_SA(1, 0), a1, voffA); PG8_STAGE(PG8_SB(1, 1), cB + hstepB + kstep, voffB);
        PG8_WAIT_V(6); PG8_BAR;
    }
    for (;;) {
        const bool has_next = S.next(ui + 1, nxt);
        if (!has_next) nxt = cur;
        gcc_t nA = has_next ? (gcc_t)g.A + (size_t)nxt.pm * tstepA : cA; gcc_t nB = has_next ? (gcc_t)g.Bt + (size_t)nxt.pb * tstepB + (VARK ? (size_t)nxt.kt0 * kstep : 0) : cB;
        const int ntc = VARK ? cur.ntu : nt;
#pragma unroll 1
        for (int t = 0; t < ntc; t += 2) {
            const bool last = (t == ntc - 2);
            gcc_t a1 = cA + (size_t)KA::koff(cur, t + 1) * 2;
            gcc_t a2 = last ? nA + (size_t)KA::koff(nxt, 0) * 2 : cA + (size_t)KA::koff(cur, t + 2) * 2;
            gcc_t a3 = last ? nA + (size_t)KA::koff(nxt, 1) * 2 : cA + (size_t)KA::koff(cur, t + 3) * 2;
            gcc_t b2 = last ? nB : cB + (size_t)(t + 2) * kstep; gcc_t b3 = b2 + kstep;
            if constexpr (Epi::HAS_MID) { if (t == Epi::MID_T) { const int te = hw_tid(wave_); E.mid(acc, cur, wr, wc, te & 15, (te >> 4) & 3); } }
            if constexpr (Epi::Pre::HAS_PRE) { if (t == 0) E.pre.issue(cur, hw_tid(wave_), wid); if (t == 2) E.pre.finish(hw_tid(wave_)); }
            PG8_LDB(B0, 0, 0); PG8_LDB(B1, 0, 1); PG8_SCHED; PG8_LDA(At, 0, 0); PG8_STAGE(PG8_SA(1, 1), a1 + hstepA, voffA);
            PG8_WAIT_V(8); PG8_WAIT_L(0); PG8_BAR; PG8_MMA(0, 0, At, B0); PG8_MMA(0, 1, At, B1); PG8_BAR; PG8_SCHED;
            PG8_LDA(At, 0, 1); PG8_STAGE(PG8_SB(0, 0), b2, voffB); PG8_STAGE(PG8_SB(0, 1), b2 + hstepB, voffB); PG8_STAGE(PG8_SA(0, 0), a2, voffA);
            PG8_WAIT_V(8); PG8_WAIT_L(0); PG8_BAR; PG8_MMA(1, 0, At, B0); PG8_MMA(1, 1, At, B1); PG8_BAR; PG8_SCHED;
            PG8_LDB(B0, 1, 0); PG8_LDB(B1, 1, 1); PG8_SCHED; PG8_LDA(At, 1, 0); PG8_STAGE(PG8_SA(0, 1), a2 + hstepA, voffA);
            PG8_WAIT_V(8); PG8_WAIT_L(0); PG8_BAR; PG8_MMA(0, 0, At, B0); PG8_MMA(0, 1, At, B1); PG8_BAR; PG8_SCHED;
            PG8_LDA(At, 1, 1); PG8_STAGE(PG8_SB(1, 0), b3, voffB); PG8_STAGE(PG8_SB(1, 1), b3 + hstepB, voffB); PG8_STAGE(PG8_SA(1, 0), a3, voffA);
            PG8_WAIT_V(8); PG8_WAIT_L(0); PG8_BAR; PG8_MMA(1, 0, At, B0); PG8_MMA(1, 1, At, B1); PG8_BAR; PG8_SCHED;
        }
        if (wr == 0) PG8_BAR;
        { const int te = hw_tid(wave_); E(acc, cur, wr, wc, te & 15, (te >> 4) & 3); }
        if (!has_next) break;
        const LAS char* zp = (const LAS char*)(lds + RING_BYTES + 12288) + (hw_tid(wave_) & 63) * 16;
#pragma unroll
        for (int a = 0; a < 2; ++a)
#pragma unroll
            for (int b = 0; b < 2; ++b)
#pragma unroll
                for (int m = 0; m < 4; ++m)
#pragma unroll
                    for (int n = 0; n < 2; ++n) acc[a][b][m][n] = *(const LAS f32x4*)(zp + (((a * 2 + b) * 4 + m) * 2 + n) * 16);
        cur = nxt; cA = nA; cB = nB; ++ui;
        if (wr == 1) PG8_BAR;
    }
    PG8_WAIT_V(0);
    PG8_BAR;
#undef PG8_SA
#undef PG8_SB
#undef PG8_STAGE
#undef PG8_LDA
#undef PG8_LDB
#undef PG8_MMA
#undef PG8_WAIT_V
#undef PG8_WAIT_L
#undef PG8_BAR
#undef PG8_SCHED
}
}

#define XB_TMO      128
#define XB_XCNT(j)  (256  + 64 * (j))
#define XB_XSUB(j)  (1280 + 64 * (j))
#define XB_XGEN(j)  (2304 + 64 * (j))
#define XB_TOP      3328
#define XB_TOPGEN   3392
#define XCD_BAR_WORDS 3456
#define XB_SPIN_CAP (1u << 18)
__device__ __forceinline__ unsigned xb_ld(gu32* p)              { return __hip_atomic_load(p, __ATOMIC_RELAXED, __HIP_MEMORY_SCOPE_AGENT); }
__device__ __forceinline__ unsigned xb_add(gu32* p, unsigned v) { return __hip_atomic_fetch_add(p, v, __ATOMIC_RELAXED, __HIP_MEMORY_SCOPE_AGENT); }
__device__ __forceinline__ unsigned xb_xcc_id() { return (unsigned)__builtin_amdgcn_s_getreg((3 << 11) | 20) & 0xFu; }
#define XB_SPIN(cond, bar) do { unsigned _sp = 0; while (cond) { __builtin_amdgcn_s_sleep(1); \
    if ((++_sp & 255u) == 0u) { if (xb_ld(&(bar)[XB_TMO])) break; if (_sp > XB_SPIN_CAP) { (void)xb_add(&(bar)[XB_TMO], 1u); break; } } } } while (0)
struct XcdBarrier { gu32* bar; unsigned x; volatile LAS unsigned* st; };
__device__ __forceinline__ XcdBarrier xcd_barrier_post(gu32* bar, volatile LAS unsigned* st, int tid) {
    XcdBarrier b; b.bar = bar; b.x = xb_xcc_id(); b.st = st;
    if (tid == 0) (void)xb_add(&bar[XB_XCNT(b.x)], 1u);
    return b;
}
__device__ __forceinline__ void xcd_barrier_complete(gu32* bar, unsigned x, unsigned& nloc, unsigned& nx) {
    const unsigned G = gridDim.x * gridDim.y * gridDim.z;
    unsigned sum, cnt, mine, sp = 0u;
    for (;;) {
        sum = 0u; cnt = 0u; mine = 0u;
#pragma unroll
        for (unsigned j = 0; j < 16; ++j) { const unsigned c = xb_ld(&bar[XB_XCNT(j)]); sum += c; cnt += (c > 0u) ? 1u : 0u; mine = (j == x) ? c : mine; }
        if (sum == G) break;
        __builtin_amdgcn_s_sleep(1);
        if ((++sp & 255u) == 0u) { if (xb_ld(&bar[XB_TMO])) break; if (sp > XB_SPIN_CAP) { (void)xb_add(&bar[XB_TMO], 1u); break; } }
    }
    nloc = mine > 0u ? mine : 1u; nx = cnt > 0u ? cnt : 1u;
}
__device__ __forceinline__ void xcd_barrier(const XcdBarrier& b, int tid) {
    asm volatile("s_waitcnt vmcnt(0)" ::: "memory");
    __syncthreads();
    if (tid == 0) {
        gu32* bar = b.bar;
        __builtin_amdgcn_s_waitcnt(0);
        unsigned nloc = b.st[0], nx = b.st[1];
        if (nloc == 0u) { xcd_barrier_complete(bar, b.x, nloc, nx); b.st[0] = nloc; b.st[1] = nx; }
        const unsigned old = xb_add(&bar[XB_XSUB(b.x)], 1u);
        const unsigned gen = old / nloc;
        if (old + 1u == (gen + 1u) * nloc) {
            __builtin_amdgcn_fence(__ATOMIC_RELEASE, "agent");
            asm volatile("s_waitcnt vmcnt(0)" ::: "memory");
            const unsigned og = xb_add(&bar[XB_TOP], 1u);
            const unsigned tg = og / nx;
            if (og + 1u == (tg + 1u) * nx) xb_add(&bar[XB_TOPGEN], 1u);
            else XB_SPIN(xb_ld(&bar[XB_TOPGEN]) == tg, bar);
            __builtin_amdgcn_fence(__ATOMIC_ACQUIRE, "agent");
            asm volatile("s_waitcnt vmcnt(0)" ::: "memory");
        } else {
            XB_SPIN(xb_ld(&bar[XB_TOPGEN]) == gen, bar);
            __builtin_amdgcn_fence(__ATOMIC_ACQUIRE, "agent");
            asm volatile("s_waitcnt vmcnt(0)" ::: "memory");
        }
    }
    __syncthreads();
}

struct Args { const float* in[20]; float* out; unsigned char* ws; int ph_lo, ph_hi; };
enum { I_X = 0, I_MIXN, I_WIN, I_CDW, I_CDWB, I_CLNG, I_CLNB, I_WCO, I_WPOOL, I_PSC, I_WOUT, I_FFNN, I_DG, I_DU, I_DD, I_RW, I_MG, I_MU, I_MD, I_FIN };

typedef const float* cfp_t;
typedef __attribute__((address_space(4))) const char* kptr_t;
struct Frame {
    LAS unsigned char* lds;
    kptr_t kp; gf_t out; GAS unsigned char* ws;
    int tid, lane, wave, G, bid;
};
struct InPtrs { kptr_t kp;
    __device__ __forceinline__ explicit InPtrs(const Frame& F) : kp(F.kp) { asm volatile("" : "+s"(kp)); }
    __device__ __forceinline__ gcf_t operator[](int k) const { return (gcf_t)((__attribute__((address_space(4))) const cfp_t*)kp)[k]; } };
__device__ __forceinline__ gbf_t wsb(const Frame& F, size_t off) { return (gbf_t)(F.ws + off); }
__device__ __forceinline__ gf_t wsf(const Frame& F, size_t off) { return (gf_t)(F.ws + off); }
__device__ __forceinline__ gu_t wsu(const Frame& F, size_t off) { return (gu_t)(F.ws + off); }


__device__ __forceinline__ float rdl(float v, int l) { return __int_as_float(__builtin_amdgcn_readlane(__float_as_int(v), l)); }
template <bool FP8>
__device__ __forceinline__ void cvt_item(gcf_t W, int N, int k0, int n0, GAS void* dstv, int ldd, int drow0, int dcol0, gcf_t sk, gcf_t sn, float mul, LAS unsigned* scr, int lane) {
    const float sN = (sn ? sn[n0 + lane] : 1.0f) * mul;
    gcf_t src = W + (size_t)k0 * N + n0 + lane;
    gcf_t skp = sk ? sk + k0 : src; const float g0 = skp[lane], g1 = FP8 ? skp[64 + lane] : 0.f; (void)g1;
    if constexpr (!FP8) {
        gbf_t dst = (gbf_t)dstv;
#pragma unroll
        for (int h = 0; h < 2; ++h) { float v[32];
#pragma unroll
            for (int i = 0; i < 32; ++i) v[i] = src[(size_t)(32 * h + i) * N];
#pragma unroll
            for (int i = 0; i < 16; ++i) { float a = v[2 * i], b = v[2 * i + 1]; if (sk) { a *= rdl(g0, 32 * h + 2 * i); b *= rdl(g0, 32 * h + 2 * i + 1); }
                scr[lane * 33 + 16 * h + i] = cvt_pk_bf16(a * sN, b * sN); } }
    } else {
#pragma unroll
        for (int h = 0; h < 4; ++h) { float v[32]; const float gh = h < 2 ? g0 : g1; const int gb = 32 * (h & 1);
#pragma unroll
            for (int i = 0; i < 32; ++i) v[i] = src[(size_t)(32 * h + i) * N];
#pragma unroll
            for (int i = 0; i < 8; ++i) { float a = v[4 * i], b = v[4 * i + 1], c = v[4 * i + 2], d = v[4 * i + 3];
                if (sk) { a *= rdl(gh, gb + 4 * i); b *= rdl(gh, gb + 4 * i + 1); c *= rdl(gh, gb + 4 * i + 2); d *= rdl(gh, gb + 4 * i + 3); }
                int w = __builtin_amdgcn_cvt_pk_fp8_f32(a * sN, b * sN, 0, false); w = __builtin_amdgcn_cvt_pk_fp8_f32(c * sN, d * sN, w, true);
                scr[lane * 33 + 8 * h + i] = (unsigned)w; } }
    }
    LDS_WAIT(); asm volatile("" ::: "memory");
    {
        GAS unsigned char* dst = (GAS unsigned char*)dstv; const int c = lane & 7; const int esz = FP8 ? 1 : 2;
#pragma unroll
        for (int q = 0; q < 8; ++q) { const int j = (lane >> 3) + 8 * q; const LAS unsigned* s = scr + j * 33 + 4 * c;
            u32x4 o; o.x = s[0]; o.y = s[1]; o.z = s[2]; o.w = s[3];
            ST4U(dst + ((size_t)(drow0 + j) * ldd + dcol0 + k0) * esz + 16 * c) = o; }
    }
    LDS_WAIT(); asm volatile("" ::: "memory");
}
__device__ __forceinline__ int gu_row(int n0, int up) { return 256 * (n0 >> 7) + (n0 & 127) + 128 * up; }
__device__ __forceinline__ int win_row(int n0) {
    if (n0 < 512) return gu_row(n0, 0);
    if (n0 < 1024) return gu_row(n0 - 512, 1);
    if (n0 < 1536) return n0;
    if (n0 < 2560) return 1536 + gu_row(n0 - 1536, 0);
    return 1536 + gu_row(n0 - 2560, 1);
}
constexpr int IT_WIN = 16 * 56, IT_WCO = 8 * 16, IT_WPOOL = 2 * 4, IT_WOUT = 16 * 16, IT_DGU = 16 * 44, IT_DD = 44 * 16;
constexpr int NIT_A = DEPTH * IT_WIN, NIT_B = DEPTH * IT_WCO, NIT_C = DEPTH * 4 * IT_WPOOL, NIT_D = DEPTH * IT_WOUT, NIT_E = 2 * IT_DGU, NIT_E3 = 2 * IT_DD;
constexpr int NIT_PRO = (2 * IT_WIN + IT_WIN) + NIT_B + NIT_C + (2 * IT_WOUT + IT_WOUT) + (2 * IT_DGU + IT_DD) + (IT_DGU + IT_DD / 2);
constexpr int IT_MGU = 8 * 56, IT_MD = 28 * 16, NIT_MOE = NEXP * (2 * IT_MGU + IT_MD);
__device__ __forceinline__ void cvt_pro_item(const Frame& F, const InPtrs& IN, int r, LAS unsigned* scr) {
    if (r < 2 * IT_WIN) { const int L = r / IT_WIN, q = r % IT_WIN, kb = q / 56, nb = q % 56;
        cvt_item<false>(IN[I_WIN] + (size_t)L * DM * IN_COLS, IN_COLS, kb * 64, nb * 64, wsb(F, WS_WIN) + (size_t)L * IN_COLS * DM, DM, win_row(nb * 64), 0, IN[I_MIXN] + L * DM, nullptr, 1.0f, scr, F.lane); return; } r -= 2 * IT_WIN;
    if (r < IT_WIN) { const int L = 2 + r / (IT_WIN / 2), q = r % (IT_WIN / 2), kb = q / 56, nb = q % 56;
        cvt_item<true>(IN[I_WIN] + (size_t)L * DM * IN_COLS, IN_COLS, kb * 128, nb * 64, F.ws + WS_WIN8 + (size_t)(L - 2) * IN_COLS * DM, DM, win_row(nb * 64), 0, IN[I_MIXN] + L * DM, nullptr, 32.0f, scr, F.lane); return; } r -= IT_WIN;
    if (r < NIT_B) { const int L = r / IT_WCO, q = r % IT_WCO, kb = q / 16, nb = q % 16;
        cvt_item<false>(IN[I_WCO] + (size_t)L * CONV_DIM * DM, DM, kb * 64, nb * 64, wsb(F, WS_WM) + (size_t)L * DM * 640, 640, nb * 64, 0, nullptr, nullptr, 1.0f, scr, F.lane); return; } r -= NIT_B;
    if (r < NIT_C) { const int Lg = r / IT_WPOOL, q = r % IT_WPOOL, kb = q / 4, nb = q % 4, L = Lg >> 2, g = Lg & 3;
        cvt_item<false>(IN[I_WPOOL] + (size_t)Lg * 128 * 256, 256, kb * 64, nb * 64, wsb(F, WS_WM) + (size_t)L * DM * 640, 640, 256 * g + nb * 64, 512, nullptr, IN[I_PSC] + L * DM + 256 * g, 1.0f, scr, F.lane); return; } r -= NIT_C;
    if (r < 2 * IT_WOUT) { const int L = r / IT_WOUT, q = r % IT_WOUT, kb = q / 16, nb = q % 16;
        cvt_item<false>(IN[I_WOUT] + (size_t)L * DM * DM, DM, kb * 64, nb * 64, wsb(F, WS_WOUT) + (size_t)L * DM * DM, DM, nb * 64, 0, nullptr, nullptr, 1.0f, scr, F.lane); return; } r -= 2 * IT_WOUT;
    if (r < IT_WOUT) { const int L = 2 + r / (IT_WOUT / 2), q = r % (IT_WOUT / 2), kb = q / 16, nb = q % 16;
        cvt_item<true>(IN[I_WOUT] + (size_t)L * DM * DM, DM, kb * 128, nb * 64, F.ws + WS_WOUT + (size_t)L * DM * DM * 2, DM, nb * 64, 0, nullptr, nullptr, 32.0f, scr, F.lane); return; } r -= IT_WOUT;
    if (r < 2 * IT_DGU) { const int up = r / IT_DGU, q = r % IT_DGU, kb = q / 44, nb = q % 44;
        cvt_item<false>((up ? IN[I_DU] : IN[I_DG]), DFF, kb * 64, nb * 64, wsb(F, WS_DGU), DM, gu_row(nb * 64, up), 0, IN[I_FFNN], nullptr, 1.0f, scr, F.lane); return; } r -= 2 * IT_DGU;
    if (r < IT_DD) { const int kb = r / 16, nb = r % 16;
        cvt_item<false>(IN[I_DD], DM, kb * 64, nb * 64, wsb(F, WS_DD), DFF, nb * 64, 0, nullptr, nullptr, 1.0f, scr, F.lane); return; } r -= IT_DD;
    if (r < IT_DGU) { const int up = r / (IT_DGU / 2), q = r % (IT_DGU / 2), kb = q / 44, nb = q % 44;
        cvt_item<true>((up ? IN[I_DU] : IN[I_DG]) + (size_t)DM * DFF, DFF, kb * 128, nb * 64, F.ws + WS_DGU8, DM, gu_row(nb * 64, up), 0, IN[I_FFNN] + 2 * DM, nullptr, 32.0f, scr, F.lane); return; } r -= IT_DGU;
    { const int kb = r / 16, nb = r % 16;
        cvt_item<true>(IN[I_DD] + (size_t)DFF * DM, DM, kb * 128, nb * 64, F.ws + WS_DD8, DFF, nb * 64, 0, nullptr, nullptr, 64.0f, scr, F.lane); }
}
__device__ __forceinline__ void cvt_moe_item(const Frame& F, const InPtrs& IN, int r, LAS unsigned* scr) {
    const int ie = r / (2 * IT_MGU + IT_MD), i = ie >> 3; int q = r % (2 * IT_MGU + IT_MD);
    if (q < 2 * IT_MGU) { const int up = q / IT_MGU; q %= IT_MGU; const int kb = q / 56, nb = q % 56;
        cvt_item<true>((up ? IN[I_MU] : IN[I_MG]) + (size_t)ie * DM * DFFE, DFFE, kb * 128, nb * 64, F.ws + WS_MGU + (size_t)ie * 2 * DFFE * DM, DM, gu_row(nb * 64, up), 0, IN[I_FFNN] + (2 * i + 1) * DM, nullptr, 32.0f, scr, F.lane); return; }
    q -= 2 * IT_MGU; { const int kb = q / 16, nb = q % 16;
        cvt_item<true>(IN[I_MD] + (size_t)ie * DFFE * DM, DM, kb * 128, nb * 64, F.ws + WS_MD + (size_t)ie * DM * DFFE, DFFE, nb * 64, 0, nullptr, nullptr, 64.0f, scr, F.lane); }
}
__device__ __forceinline__ void cvt_moe_layers(const Frame& F) {
    LAS unsigned* scr = (LAS unsigned*)(F.lds + F.wave * 8448);
    const int gw = F.bid * NWAVES + F.wave, NGW = F.G * NWAVES;
    const InPtrs IN(F);
    for (int it = gw; it < 2 * NIT_MOE; it += NGW) cvt_moe_item(F, IN, it, scr);
}

__device__ __forceinline__ void p_prologue(const Frame& F) {
    LAS unsigned* scr = (LAS unsigned*)(F.lds + F.wave * 8448);
    const int gw = F.bid * NWAVES + F.wave, NGW = F.G * NWAVES;
    const InPtrs IN(F);
    for (int it = gw; it < NIT_PRO; it += NGW) cvt_pro_item(F, IN, it, scr);
    gcf_t x = IN[I_X]; gbf_t xb = wsb(F, WS_XB); gf_t ssq4 = wsf(F, WS_SSQ4);
    for (int t0 = gw * 4; t0 < NTOK; t0 += NGW * 4) {
        f32x4 v[4][4];
#pragma unroll
        for (int q = 0; q < 4; ++q)
#pragma unroll
            for (int j = 0; j < 4; ++j) v[q][j] = *((const GAS f32x4*)(x + (size_t)(t0 + q) * DM) + F.lane + 64 * j);
#pragma unroll
        for (int q = 0; q < 4; ++q) { GAS u32x2* o = (GAS u32x2*)(xb + (size_t)(t0 + q) * DM) + F.lane; float ss = 0.f;
#pragma unroll
            for (int j = 0; j < 4; ++j) { const f32x4 w4 = v[q][j]; ss += (w4[0] * w4[0] + w4[1] * w4[1]) + (w4[2] * w4[2] + w4[3] * w4[3]); u32x2 w; w.x = cvt_pk_bf16(w4[0], w4[1]); w.y = cvt_pk_bf16(w4[2], w4[3]); o[64 * j] = w; }
            ss = wave_sum_l(ss, F.lane);
            if (F.lane < 4) ssq4[(size_t)F.lane * NTOK + t0 + q] = F.lane == 0 ? ss : 0.f; }
    }
    cvt_moe_layers(F);
}

__device__ __forceinline__ float bf1(bf16_t v) { return __uint_as_float((unsigned)v << 16); }
__device__ __forceinline__ bf16_t f2bf(float f) { return (bf16_t)(cvt_pk_bf16(f, 0.f) & 0xffffu); }
template <int CTRL> __device__ __forceinline__ float dppx(float v) { return __int_as_float(__builtin_amdgcn_update_dpp(0, __float_as_int(v), CTRL, 0xf, 0xf, true)); }
__device__ __forceinline__ void p_cp(const Frame& F, int L) {
    const int ch = F.tid, lane = F.lane, wv = F.wave;
    const GAS char* Ub = (const GAS char*)(F.ws + WS_U); const GAS char* Pb = (const GAS char*)(F.ws + WS_P); GAS char* Sb = (GAS char*)(F.ws + WS_SD);
    const unsigned ch2 = (unsigned)ch * 2u, lane16 = (unsigned)lane * 16u, lds0 = (unsigned)(size_t)F.lds;
    constexpr unsigned CP_IN = 0u, CP_OUT = 65536u, CP_HIST = 65536u;
#define CP_DMA(gptr, ldsoff) do { unsigned keep_; asm volatile("s_mov_b32 %0, m0\n\ts_mov_b32 m0, %3\n\ts_nop 0\n\tglobal_load_lds_dwordx4 %1, %2\n\ts_mov_b32 m0, %0" : "=&s"(keep_) : "v"(lane16), "s"(pg8::uni64((const GAS char*)(gptr))), "s"(lds0 + (unsigned)(ldsoff)) : "memory"); } while (0)
#define CP_ST16(gptr, voff, val) (*(GAS u32x4*)((GAS char*)(gptr) + (voff)) = (val))
#define LDSU16(off) ((unsigned)*(const LAS unsigned short*)(F.lds + (off)))
#define LDW(ptr, row) (*(const GAS float*)((const GAS char*)(ptr) + ((unsigned)(row) * (CONV_DIM * 4u) + ch2 * 2u)))
    const InPtrs IN(F);
    LAS float* red = (LAS float*)(F.lds + STAB_OFF);
    const int idx = ((lane >> 3) & 1) + 2 * ((lane >> 2) & 1) + 4 * ((lane >> 1) & 1) + 8 * (lane & 1);
    const bool b0 = lane & 1, b1 = lane & 2, b2 = lane & 4, b3 = lane & 8;
    const int g = F.wave >> 1, win = 2 << g;
    for (int chunk = F.bid; chunk < NTOK / 128; chunk += F.G) {
        const int r0 = chunk * 128, ts0 = r0 & (SEQ - 1);
        const unsigned hmask = ts0 != 0 ? 0xffffffffu : 0u; const int rh = ts0 != 0 ? r0 : r0 + 32;
#pragma unroll
        for (int k = 0; k < 6; ++k) { const int sidx = wv + 8 * k; const int pr = sidx - 30 < 14 ? sidx - 30 : 14;
            const GAS char* src = sidx < 30 ? Ub + (unsigned)(rh - 30 + sidx) * 1024u : Pb + (unsigned)(rh - 15 + pr) * 1024u;
            CP_DMA(src, CP_HIST + (unsigned)sidx * 1024u); }
#pragma unroll
        for (int q = 0; q < 2; ++q) { CP_DMA(Ub + (unsigned)(r0 + 8 * q + wv) * 1024u, CP_IN + (unsigned)q * 16384u + (unsigned)wv * 1024u); CP_DMA(Pb + (unsigned)(r0 + 8 * q + wv) * 1024u, CP_IN + (unsigned)q * 16384u + (unsigned)(8 + wv) * 1024u); }
        float w[CONV_W];
#pragma unroll
        for (int j = 0; j < CONV_W; ++j) w[j] = LDW(IN[I_CDW], L * CONV_W + j);
        const float cb = LDW(IN[I_CDWB], L), lg = LDW(IN[I_CLNG], L), lb = LDW(IN[I_CLNB], L);
        asm volatile("s_waitcnt vmcnt(0)" ::: "memory"); __syncthreads();
        {
            float cb_ = cb, lg_ = lg, lb_ = lb;
#pragma unroll
            for (int j = 0; j < CONV_W; ++j) asm volatile("" : "+v"(w[j]));
            asm volatile("" : "+v"(cb_), "+v"(lg_), "+v"(lb_)); (void)cb_; (void)lg_; (void)lb_; }
        float u[38];
#pragma unroll
        for (int i = 0; i < 30; ++i) u[i] = __uint_as_float((LDSU16(CP_HIST + (unsigned)i * 1024u + ch2) << 16) & hmask);
        float plast, h2[2], h4[4], h8[8];
        { float ph[15], T2[15], T4[13];
#pragma unroll
          for (int i = 0; i < 15; ++i) ph[i] = __uint_as_float((LDSU16(CP_HIST + (unsigned)(30 + i) * 1024u + ch2) << 16) & hmask);
#pragma unroll
          for (int k = 1; k <= 14; ++k) T2[k] = ph[15 - k] + ph[14 - k];
#pragma unroll
          for (int k = 1; k <= 12; ++k) T4[k] = T2[k] + T2[k + 2];
          h2[0] = T2[2]; h2[1] = T2[1];
#pragma unroll
          for (int o = 0; o < 4; ++o) h4[o] = T4[4 - o];
#pragma unroll
          for (int o = 0; o < 8; ++o) h8[o] = T4[8 - o] + T4[12 - o];
          plast = ph[14]; }
#define CP_SUBBLOCK(sb, BUF) do { \
            const int rb = r0 + 8 * (sb), sn = (sb) + 2 < 16 ? (sb) + 2 : 15; \
            const unsigned stg = CP_IN + (unsigned)((sb) & 3) * 16384u, stn = CP_IN + (unsigned)(((sb) + 2) & 3) * 16384u, outw = CP_OUT + (unsigned)((sb) & 1) * 16384u, outr = CP_OUT + (unsigned)(((sb) + 1) & 1) * 16384u; \
            asm volatile("s_waitcnt vmcnt(4) lgkmcnt(0)" ::: "memory"); \
            __builtin_amdgcn_s_barrier(); asm volatile("" ::: "memory");     \
            if ((sb) > 0) { const LAS char* orow = (const LAS char*)(F.lds + outr + (unsigned)wv * 2048u + lane16); const u32x4 o0 = *(const LAS u32x4*)orow, o1 = *(const LAS u32x4*)(orow + 1024); \
                GAS char* drow = Sb + (unsigned)(rb - 8 + wv) * 2048u; CP_ST16(drow, lane16, o0); CP_ST16(drow, lane16 + 1024u, o1); } \
            CP_DMA(Ub + (unsigned)(r0 + 8 * sn + wv) * 1024u, stn + (unsigned)wv * 1024u); CP_DMA(Pb + (unsigned)(r0 + 8 * sn + wv) * 1024u, stn + (unsigned)(8 + wv) * 1024u); \
            float pc[8]; \
            _Pragma("unroll") for (int o = 0; o < 8; ++o) { u[30 + o] = __uint_as_float(LDSU16(stg + (unsigned)o * 1024u + ch2) << 16); pc[o] = __uint_as_float(LDSU16(stg + (unsigned)(8 + o) * 1024u + ch2) << 16); } \
            float v[8], a[16]; \
            _Pragma("unroll") for (int o = 0; o < 8; ++o) { float s_ = cb; \
                _Pragma("unroll") for (int j = 0; j < CONV_W; ++j) s_ += w[j] * u[o + j]; \
                v[o] = s_; a[o] = s_; a[8 + o] = s_ * s_; } \
            _Pragma("unroll") for (int i = 0; i < 8; ++i) { const float keep = b0 ? a[i + 8] : a[i], send = b0 ? a[i] : a[i + 8]; a[i] = keep + dppx<0xB1>(send); } \
            _Pragma("unroll") for (int i = 0; i < 4; ++i) { const float keep = b1 ? a[i + 4] : a[i], send = b1 ? a[i] : a[i + 4]; a[i] = keep + dppx<0x4E>(send); } \
            _Pragma("unroll") for (int i = 0; i < 2; ++i) { const float keep = b2 ? a[i + 2] : a[i], send = b2 ? a[i] : a[i + 2]; a[i] = keep + dppx<0x124>(send); } \
            { const float keep = b3 ? a[1] : a[0], send = b3 ? a[0] : a[1]; a[0] = keep + dppx<0x128>(send); } \
            a[0] += shx<16>(a[0], lane); a[0] += shx<32>(a[0], lane);       \
            LAS float* rb_ = red + (BUF) * 128; \
            if (lane < 16) rb_[idx * 8 + wv] = a[0]; \
              \
            { float sw[8]; \
              _Pragma("unroll") for (int o = 0; o < 8; ++o) sw[o] = pc[o] + (o ? pc[o > 0 ? o - 1 : 0] : plast); \
              plast = pc[7]; \
              if (g >= 1) { float t4[8]; \
                  _Pragma("unroll") for (int o = 0; o < 8; ++o) t4[o] = sw[o] + (o >= 2 ? sw[o >= 2 ? o - 2 : 0] : h2[o & 1]); \
                  h2[0] = sw[6]; h2[1] = sw[7]; \
                  _Pragma("unroll") for (int o = 0; o < 8; ++o) sw[o] = t4[o]; \
                  if (g >= 2) { float t8[8]; \
                      _Pragma("unroll") for (int o = 0; o < 8; ++o) t8[o] = t4[o] + (o >= 4 ? t4[o >= 4 ? o - 4 : 0] : h4[o & 3]); \
                      _Pragma("unroll") for (int o = 0; o < 4; ++o) h4[o] = t4[4 + o]; \
                      _Pragma("unroll") for (int o = 0; o < 8; ++o) sw[o] = t8[o]; \
                      if (g >= 3) { _Pragma("unroll") for (int o = 0; o < 8; ++o) { sw[o] = t8[o] + h8[o]; h8[o] = t8[o]; } } } } \
              _Pragma("unroll") for (int o = 0; o < 8; ++o) { const int ts = ts0 + 8 * (sb) + o; const float inv = __builtin_amdgcn_rcpf((float)((ts + 1) < win ? (ts + 1) : win)); \
                  *(LAS bf16_t*)(F.lds + outw + (unsigned)o * 2048u + ch2) = f2bf(sw[o] * inv - pc[o]); } } \
            LDS_WAIT(); __builtin_amdgcn_s_barrier(); asm volatile("" ::: "memory");     \
              \
            float mean_l, rstd_l; \
            { const LAS float* rp = rb_ + (lane & 7) * 8; const f32x4 s0 = *(const LAS f32x4*)(rp), s1 = *(const LAS f32x4*)(rp + 4), q0 = *(const LAS f32x4*)(rp + 64), q1 = *(const LAS f32x4*)(rp + 68); \
              mean_l = (((s0[0] + s0[1]) + (s0[2] + s0[3])) + ((s1[0] + s1[1]) + (s1[2] + s1[3]))) * (1.0f / CONV_DIM); \
              const float ex2 = (((q0[0] + q0[1]) + (q0[2] + q0[3])) + ((q1[0] + q1[1]) + (q1[2] + q1[3]))) * (1.0f / CONV_DIM); \
              rstd_l = __builtin_amdgcn_rsqf(__builtin_fmaxf(ex2 - mean_l * mean_l, 0.f) + LN_EPS); } \
            _Pragma("unroll") for (int o = 0; o < 8; ++o) { const float mean = rdl(mean_l, o), rstd = rdl(rstd_l, o); \
                const float y = (v[o] - mean) * rstd * lg + lb; \
                *(LAS bf16_t*)(F.lds + outw + (unsigned)o * 2048u + 1024u + ch2) = f2bf(y * __builtin_amdgcn_rcpf(1.0f + __builtin_amdgcn_exp2f(y * -1.4426950408889634f))); } \
            _Pragma("unroll") for (int i = 0; i < 30; ++i) u[i] = u[i + 8]; } while (0)
#pragma unroll 1
        for (int sb = 0; sb < 16; sb += 2) { CP_SUBBLOCK(sb, 0); CP_SUBBLOCK(sb + 1, 1); }
#undef CP_SUBBLOCK
        LDS_WAIT(); __builtin_amdgcn_s_barrier(); asm volatile("" ::: "memory");
        { const LAS char* orow = (const LAS char*)(F.lds + CP_OUT + 16384u + (unsigned)wv * 2048u + lane16); const u32x4 o0 = *(const LAS u32x4*)orow, o1 = *(const LAS u32x4*)(orow + 1024);
          GAS char* drow = Sb + (unsigned)(r0 + 120 + wv) * 2048u; CP_ST16(drow, lane16, o0); CP_ST16(drow, lane16 + 1024u, o1); }
        asm volatile("s_waitcnt vmcnt(0)" ::: "memory"); __syncthreads();
    }
#undef CP_DMA
#undef CP_ST16
#undef LDSU16
#undef LDW
}

__device__ __forceinline__ void p_r1(const Frame& F, int i, int L) {
    LAS float* rwT = (LAS float*)F.lds;
    LAS unsigned* cntw = (LAS unsigned*)(F.lds + 32768);
    gcbf_t x = wsb(F, WS_XB); const int lane = F.lane, w = F.wave;
    const InPtrs IN(F);
    for (int q = F.tid; q < 8192; q += NWAVES * 64) { const int k = q >> 3, e = q & 7; rwT[e * 1024 + k] = IN[I_RW][(size_t)(i * DM + k) * 8 + e] * IN[I_FFNN][L * DM + k]; }
    LDS_WAIT(); __syncthreads();
    gu_t toke = wsu(F, WS_TOKE); gf_t tokp = wsf(F, WS_TOKP); gf_t tokr = wsf(F, WS_TOKR); gu_t cnt = wsu(F, WS_CNT); gcf_t ssq4 = wsf(F, WS_SSQ4);
    const bool b0 = lane & 1, b1 = lane & 2, b2 = lane & 4;
    for (int chunk = F.bid; chunk < NTOK / 128; chunk += F.G) {
        unsigned c[8];
#pragma unroll
        for (int e = 0; e < 8; ++e) c[e] = 0u;
        u32x4 xn[2][2]; unsigned me_ = 0u; float mp_ = 0.f, mr_ = 0.f;
        float rstd_l; { const unsigned tq = (unsigned)(chunk * 128 + w * 16 + (lane & 15)); const float s01 = ssq4[tq] + ssq4[NTOK + tq], s23 = ssq4[2 * NTOK + tq] + ssq4[3 * NTOK + tq];
            rstd_l = __builtin_amdgcn_rsqf((s01 + s23) * (1.0f / DM) + RMS_EPS); }
#pragma unroll 1
        for (int tb = 0; tb < 16; tb += 4) {
        u32x4 xall[4][2];
#pragma unroll
        for (int q = 0; q < 4; ++q)
#pragma unroll
            for (int h = 0; h < 2; ++h) xall[q][h] = *((const GAS u32x4*)(x + (size_t)(chunk * 128 + w * 16 + tb + q) * DM) + lane + 64 * h);
        __builtin_amdgcn_sched_barrier(0);
#pragma unroll
        for (int t8 = 0; t8 < 4; t8 += 2) {
            const int tt = tb + t8, t0 = chunk * 128 + w * 16 + tt;
            xn[0][0] = xall[t8][0]; xn[0][1] = xall[t8][1]; xn[1][0] = xall[t8 + 1][0]; xn[1][1] = xall[t8 + 1][1];
            f32x4 xv[2][4]; float a[2][8];
#pragma unroll
            for (int q = 0; q < 2; ++q)
#pragma unroll
                for (int h = 0; h < 2; ++h) pg8::unpack8(xn[q][h], xv[q][2 * h], xv[q][2 * h + 1]);
#pragma unroll
            for (int e = 0; e < 8; ++e) { float s0 = 0.f, s1 = 0.f;
#pragma unroll
                for (int j = 0; j < 4; ++j) { const f32x4 wv = *(const LAS f32x4*)(rwT + e * 1024 + 512 * (j >> 1) + 8 * lane + 4 * (j & 1));
                    s0 += (xv[0][j][0] * wv[0] + xv[0][j][1] * wv[1]) + (xv[0][j][2] * wv[2] + xv[0][j][3] * wv[3]);
                    s1 += (xv[1][j][0] * wv[0] + xv[1][j][1] * wv[1]) + (xv[1][j][2] * wv[2] + xv[1][j][3] * wv[3]); }
                a[0][e] = s0; a[1][e] = s1; }
#pragma unroll
            for (int q2 = 0; q2 < 2; ++q2) {
                const int t = t0 + q2;
#pragma unroll
                for (int q = 0; q < 4; ++q) { const float keep = b0 ? a[q2][q + 4] : a[q2][q], send = b0 ? a[q2][q] : a[q2][q + 4]; a[q2][q] = keep + dppx<0xB1>(send); }
#pragma unroll
                for (int q = 0; q < 2; ++q) { const float keep = b1 ? a[q2][q + 2] : a[q2][q], send = b1 ? a[q2][q] : a[q2][q + 2]; a[q2][q] = keep + dppx<0x4E>(send); }
                { const float keep = b2 ? a[q2][1] : a[q2][0], send = b2 ? a[q2][0] : a[q2][1]; a[q2][0] = keep + dppx<0x124>(send); }
                float a0 = a[q2][0];
                a0 += dppx<0x128>(a0); a0 += shx<16>(a0, lane); a0 += shx<32>(a0, lane);
                float lg[8];
                const int ai_ = __float_as_int(a0);
                lg[0] = __int_as_float(__builtin_amdgcn_readlane(ai_, 0)); lg[1] = __int_as_float(__builtin_amdgcn_readlane(ai_, 4)); lg[2] = __int_as_float(__builtin_amdgcn_readlane(ai_, 2)); lg[3] = __int_as_float(__builtin_amdgcn_readlane(ai_, 6));
                lg[4] = __int_as_float(__builtin_amdgcn_readlane(ai_, 1)); lg[5] = __int_as_float(__builtin_amdgcn_readlane(ai_, 5)); lg[6] = __int_as_float(__builtin_amdgcn_readlane(ai_, 3)); lg[7] = __int_as_float(__builtin_amdgcn_readlane(ai_, 7));
                const float rstd = rdl(rstd_l, tt + q2);
                int e1 = 0; float l1 = lg[0];
#pragma unroll
                for (int e = 1; e < 8; ++e) if (lg[e] > l1) { l1 = lg[e]; e1 = e; }
                int e2 = -1; float l2 = 0.f;
#pragma unroll
                for (int e = 0; e < 8; ++e) if (e != e1 && (e2 < 0 || lg[e] > l2)) { l2 = lg[e]; e2 = e; }
                const float p1 = __builtin_amdgcn_rcpf(1.0f + __builtin_amdgcn_exp2f((l2 - l1) * rstd * 1.4426950408889634f));
                if (lane == tt + q2) { me_ = (unsigned)e1 | ((unsigned)e2 << 8); mp_ = p1; mr_ = rstd; }
#pragma unroll
                for (int e = 0; e < 8; ++e) c[e] += (e1 == e ? 1u : 0u) + (e2 == e ? 1u : 0u);
            }
        }
        }
        if (lane < 16) { const int t = chunk * 128 + w * 16 + lane; toke[t] = me_; tokp[t] = mp_; tokr[t] = mr_; }
        if (lane < 8) { unsigned v = c[0];
#pragma unroll
            for (int e = 1; e < 8; ++e) v = lane == e ? c[e] : v;
            cntw[w * 8 + lane] = v; }
        LDS_WAIT(); __syncthreads();
        if (F.tid < 8) { unsigned s = 0;
#pragma unroll
            for (int q = 0; q < 8; ++q) s += cntw[q * 8 + F.tid];
            cnt[chunk * 8 + F.tid] = s; }
        __syncthreads();
    }
}
__device__ __forceinline__ void p_r2(const Frame& F) {
    LAS unsigned* lc = (LAS unsigned*)F.lds;
    LAS unsigned* pre = lc + 2048;
    LAS unsigned* tslot = pre + 64;
    LAS unsigned* te = tslot + 256;
    gu_t cnt = wsu(F, WS_CNT); gu_t toke = wsu(F, WS_TOKE); gu_t slotof = wsu(F, WS_SLOTOF); gu_t panel = wsu(F, WS_PANEL);
    gcf_t tokr = wsf(F, WS_TOKR);
    GAS unsigned char* XG = F.ws + WS_XG; gcbf_t xs = wsb(F, WS_XB);
    for (int q = F.tid; q < 2048; q += NWAVES * 64) lc[q] = __hip_atomic_load(cnt + q, RLX_AGENT);
    LDS_WAIT(); __syncthreads();
    for (int chunk = F.bid; chunk < NTOK / 128; chunk += F.G) {
        {
            const int e = F.wave; unsigned tot = 0, before = 0;
#pragma unroll
            for (int q = 0; q < 4; ++q) { const int c = 4 * F.lane + q; const unsigned v = lc[c * 8 + e]; before += c < chunk ? v : 0u; tot += v; }
#define R2SUM(M) before += (unsigned)shx_i<M>((int)before, F.lane); tot += (unsigned)shx_i<M>((int)tot, F.lane);
            R2SUM(1) R2SUM(2) R2SUM(4) R2SUM(8) R2SUM(16) R2SUM(32)
#undef R2SUM
            if (F.lane == 0) { pre[e] = before; pre[16 + e] = tot; } }
        if (F.tid < 128) te[F.tid] = __hip_atomic_load(toke + chunk * 128 + F.tid, RLX_AGENT);
        LDS_WAIT(); __syncthreads();
        if (F.tid == 0) { unsigned seg = 0; for (int e = 0; e < 8; ++e) { pre[8 + e] = seg; seg += (pre[16 + e] + 255u) & ~255u; } pre[24] = seg >> 8; }
        LDS_WAIT(); __syncthreads();
        {
            const unsigned e = F.wave; unsigned slot = pre[8 + e] + pre[e];
#pragma unroll
            for (int h = 0; h < 2; ++h) { const int tt = 64 * h + F.lane; const unsigned ee = te[tt]; const bool f1 = (ee & 255u) == e, f2 = (ee >> 8) == e;
                const unsigned long long m = __ballot(f1 || f2); const unsigned pfx = __builtin_amdgcn_mbcnt_hi((unsigned)(m >> 32), __builtin_amdgcn_mbcnt_lo((unsigned)m, 0u));
                if (f1) tslot[2 * tt] = slot + pfx; else if (f2) tslot[2 * tt + 1] = slot + pfx;
                slot += (unsigned)__popcll(m); } }
        if (chunk == 0 && F.tid >= 64 && F.tid < 72) { const unsigned e = F.tid - 64; const unsigned p0 = pre[8 + e] >> 8, p1 = (pre[8 + e] + ((pre[16 + e] + 255u) & ~255u)) >> 8;
            for (unsigned p = p0; p < p1; ++p) panel[1 + p] = e;
            if (e == 0) panel[0] = pre[24]; }
        LDS_WAIT(); __syncthreads();
#pragma unroll 1
        for (int tt = 0; tt < 16; tt += 4) { u32x4 v[4][2]; float r[4]; unsigned s0[4], s1[4];
#pragma unroll
            for (int q = 0; q < 4; ++q) { const int tl = F.wave * 16 + tt + q, t = chunk * 128 + tl; s0[q] = tslot[2 * tl]; s1[q] = tslot[2 * tl + 1]; r[q] = tokr[t];
#pragma unroll
                for (int h = 0; h < 2; ++h) v[q][h] = *((const GAS u32x4*)(xs + (size_t)t * DM) + F.lane + 64 * h); }
#pragma unroll
            for (int q = 0; q < 4; ++q) { const int t = chunk * 128 + F.wave * 16 + tt + q;
                GAS u32x2* d0 = (GAS u32x2*)(XG + (size_t)s0[q] * DM) + F.lane; GAS u32x2* d1 = (GAS u32x2*)(XG + (size_t)s1[q] * DM) + F.lane;
#pragma unroll
                for (int h = 0; h < 2; ++h) { f32x4 a, b; pg8::unpack8(v[q][h], a, b); u32x2 w; w.x = pg8::pk_fp8x4(a[0] * r[q], a[1] * r[q], a[2] * r[q], a[3] * r[q]); w.y = pg8::pk_fp8x4(b[0] * r[q], b[1] * r[q], b[2] * r[q], b[3] * r[q]);
                    d0[64 * h] = w; d1[64 * h] = w; }
                (void)t; } }
        if (F.tid < 256) slotof[chunk * 256 + F.tid] = tslot[F.tid];
        __syncthreads();
    }
}
__device__ __forceinline__ void p_cb(const Frame& F, bool final_) {
    const int gw = F.bid * NWAVES + F.wave, NGW = F.G * NWAVES;
    const GAS unsigned* slotof = wsu(F, WS_SLOTOF); gcf_t tokp = wsf(F, WS_TOKP); gcbf_t Y = wsb(F, WS_Y);
    gbf_t xs = wsb(F, WS_XB); gf_t ssq4 = wsf(F, WS_SSQ4); const InPtrs IN(F); gcf_t gfin = IN[I_FIN];
    gcbf_t YP = wsb(F, WS_YP); int mainP, tailP, nsplit; pg8::MoeOrder2::split((int)__hip_atomic_load(wsu(F, WS_PANEL), RLX_AGENT), F.G, mainP, tailP, nsplit);
    mainP = __builtin_amdgcn_readfirstlane(mainP); nsplit = __builtin_amdgcn_readfirstlane(nsplit);
    const unsigned main_rows = (unsigned)mainP * 256u; const int slab_rows = nsplit == 7 ? pg8::TAIL_ROWS : pg8::TAIL_ROWS2;
    f32x4 gf[4];
#pragma unroll
    for (int j = 0; j < 4; ++j) gf[j] = final_ ? *((const GAS f32x4*)gfin + (128 * (j >> 1) + 2 * F.lane + (j & 1))) : (f32x4){0.f, 0.f, 0.f, 0.f};
    for (int t0 = gw * 4; t0 < NTOK; t0 += NGW * 4) {
        unsigned s0[4], s1[4]; float p1[4]; u32x4 xv[4][2]; u32x2 ya[4][2], yb[4][2];
#pragma unroll
        for (int q = 0; q < 4; ++q) { s0[q] = slotof[2 * (t0 + q)]; s1[q] = slotof[2 * (t0 + q) + 1]; p1[q] = tokp[t0 + q]; }
#pragma unroll
        for (int q = 0; q < 4; ++q)
#pragma unroll
            for (int h = 0; h < 2; ++h) { xv[q][h] = *((const GAS u32x4*)(xs + (size_t)(t0 + q) * DM) + F.lane + 64 * h);
                ya[q][h] = *((const GAS u32x2*)((const GAS unsigned char*)Y + (size_t)s0[q] * DM) + F.lane + 64 * h); yb[q][h] = *((const GAS u32x2*)((const GAS unsigned char*)Y + (size_t)s1[q] * DM) + F.lane + 64 * h); }
#pragma unroll
        for (int q = 0; q < 4; ++q) { const int t = t0 + q; const float pa = p1[q], pb = 1.0f - pa; f32x4 v[4]; float ss = 0.f;
#pragma unroll
            for (int h = 0; h < 2; ++h) { f32x4 x0, x1, a0, a1, b0, b1; pg8::unpack8(xv[q][h], x0, x1); pg8::unpack_fp8x8(ya[q][h], a0, a1); pg8::unpack_fp8x8(yb[q][h], b0, b1); a0 *= 0.0625f; a1 *= 0.0625f; b0 *= 0.0625f; b1 *= 0.0625f;
                if (s0[q] >= main_rows) { u32x4 cs[7];
#pragma unroll
                    for (int sp = 0; sp < 7; ++sp) cs[sp] = *((const GAS u32x4*)(YP + (size_t)((sp < nsplit ? sp : 0) * slab_rows + s0[q] - main_rows) * DM) + F.lane + 64 * h);
                    __builtin_amdgcn_sched_barrier(0);
                    a0 = (f32x4){0.f, 0.f, 0.f, 0.f}; a1 = a0;
#pragma unroll
                    for (int sp = 0; sp < 7; ++sp) { f32x4 c0, c1; pg8::unpack8(cs[sp], c0, c1); const float m = sp < nsplit ? 1.0f : 0.0f; a0 += c0 * m; a1 += c1 * m; } }
                if (s1[q] >= main_rows) { u32x4 cs[7];
#pragma unroll
                    for (int sp = 0; sp < 7; ++sp) cs[sp] = *((const GAS u32x4*)(YP + (size_t)((sp < nsplit ? sp : 0) * slab_rows + s1[q] - main_rows) * DM) + F.lane + 64 * h);
                    __builtin_amdgcn_sched_barrier(0);
                    b0 = (f32x4){0.f, 0.f, 0.f, 0.f}; b1 = b0;
#pragma unroll
                    for (int sp = 0; sp < 7; ++sp) { f32x4 c0, c1; pg8::unpack8(cs[sp], c0, c1); const float m = sp < nsplit ? 1.0f : 0.0f; b0 += c0 * m; b1 += c1 * m; } }
                v[2 * h] = x0 + pa * a0 + pb * b0; v[2 * h + 1] = x1 + pa * a1 + pb * b1; }
#pragma unroll
            for (int j = 0; j < 4; ++j) ss += (v[j][0] * v[j][0] + v[j][1] * v[j][1]) + (v[j][2] * v[j][2] + v[j][3] * v[j][3]);
            ss = wave_sum_l(ss, F.lane);
            if (final_) { const float rstd = __builtin_amdgcn_rsqf(ss * (1.0f / DM) + RMS_EPS); GAS f32x4* orow = (GAS f32x4*)(F.out + (size_t)t * DM);
#pragma unroll
                for (int j = 0; j < 4; ++j) { const int e4 = 128 * (j >> 1) + 2 * F.lane + (j & 1); orow[e4] = v[j] * rstd * gf[j]; }
            } else {
#pragma unroll
                for (int h = 0; h < 2; ++h) { *((GAS u32x4*)(xs + (size_t)t * DM) + F.lane + 64 * h) = pg8::pack8(v[2 * h], v[2 * h + 1]);
                    u32x2 w8; w8.x = pg8::pk_fp8x4(v[2 * h][0], v[2 * h][1], v[2 * h][2], v[2 * h][3]); w8.y = pg8::pk_fp8x4(v[2 * h + 1][0], v[2 * h + 1][1], v[2 * h + 1][2], v[2 * h + 1][3]);
                    *((GAS u32x2*)(F.ws + WS_XB8 + (size_t)t * DM) + F.lane + 64 * h) = w8; }
                if (F.lane < 4) ssq4[(size_t)F.lane * NTOK + t] = F.lane == 0 ? ss : 0.f;
            } }
    }
}

constexpr int N_PHASES = 1 + DEPTH * 4 + 2 * 2 + 2 * 5;
__global__ void __launch_bounds__(NWAVES * 64, 2) trunk_fwd(Args args) {
    extern __shared__ __attribute__((aligned(16))) unsigned char lds_raw[];
    Frame F;
    F.lds = (LAS unsigned char*)lds_raw;
    F.kp = (kptr_t)__builtin_amdgcn_kernarg_segment_ptr(); F.out = (gf_t)args.out; F.ws = (GAS unsigned char*)args.ws;
    F.tid = threadIdx.x; F.lane = F.tid & 63; F.wave = __builtin_amdgcn_readfirstlane(F.tid >> 6); F.G = gridDim.x; F.bid = blockIdx.x;
    volatile LAS unsigned* MISC = (volatile LAS unsigned*)(F.lds + MISC_OFF);
    for (int u = F.tid; u < (LDS_BYTES - LDSCTL_OFF) / 4; u += NWAVES * 64) ((LAS unsigned*)(F.lds + LDSCTL_OFF))[u] = 0u;
    __syncthreads();
    gu32* ctl = (gu32*)(args.ws + WS_CTL);
#if MK_PER_PHASE
    XcdBarrier bar; bar.bar = ctl + CW_BAR; bar.x = 0; bar.st = nullptr; (void)bar; (void)MISC;
#else
    XcdBarrier bar = xcd_barrier_post(ctl + CW_BAR, MISC + 8, F.tid);
#endif
#if MK_PER_PHASE
    const int lo = args.ph_lo, hi = args.ph_hi;
    int ph = 0;
#endif
#if MK_PER_PHASE
#define IN_PH() (ph >= lo && ph < hi)
#else
#define IN_PH() true
#endif
#if MK_PER_PHASE
#define SEAM() do { ++ph; } while (0)
#else
#define SEAM() do { XcdBarrier b2_ = bar; asm volatile("" : "+s"(b2_.bar), "+s"(b2_.x)); xcd_barrier(b2_, hw_tid(F.wave)); } while (0)
#endif
#define PHASE_FRAME(Fp) Frame Fp = F; Fp.tid = hw_tid(F.wave); asm volatile("" : "+s"(Fp.ws), "+s"(Fp.out), "+v"(Fp.tid), "+s"(Fp.G), "+s"(Fp.bid)); Fp.lane = Fp.tid & 63
#if MK_PER_PHASE
#define REPBAR() do { } while (0)
#else
#define REPBAR() do { XcdBarrier b3_ = bar; asm volatile("" : "+s"(b3_.bar), "+s"(b3_.x)); xcd_barrier(b3_, hw_tid(F.wave)); } while (0)
#endif
    LAS unsigned char* ring = F.lds;
    LAS float* rtab = (LAS float*)(F.lds + RTAB_OFF); LAS float* stab = (LAS float*)(F.lds + STAB_OFF); LAS float* rawt = (LAS float*)(F.lds + RAW_OFF);

    if (PHON(0) && IN_PH()) {
_Pragma("unroll 1") for (int rep_ = 0; rep_ < NREP(0); ++rep_) { if (rep_) REPBAR(); PHASE_FRAME(Fp); p_prologue(Fp); } }
    SEAM();
#pragma unroll 1
    for (int L = 0; L < DEPTH; ++L) {
        if (PHON(1) && IN_PH()) {
_Pragma("unroll 1") for (int rep_ = 0; rep_ < NREP(1); ++rep_) { if (rep_) REPBAR();
            PHASE_FRAME(Fp); gf_t ssq4 = wsf(Fp, WS_SSQ4); gbf_t xb = wsb(Fp, WS_XB); (void)ssq4; (void)xb;
            pg8::StaticOrder S; S.init(NTOK, IN_COLS, Fp.G, Fp.bid);
            if (L < 2) { pg8::Gemm g{xb, wsb(Fp, WS_WIN) + (size_t)L * IN_COLS * DM, DM, DM, DM};
                pg8::EpiIn E{pg8::PreSsq4{ssq4, rtab, rawt}, wsb(Fp, WS_U), wsb(Fp, WS_P), wsb(Fp, WS_RQ), wsb(Fp, WS_SGP), 1.0f};
                pg8::gemm_phase<pg8::EpiIn, pg8::StaticOrder, pg8::KPlain>(ring, g, S, E, Fp.wave); }
            else { pg8::Gemm g{wsb(Fp, WS_XB8), wsb(Fp, WS_WIN8 + (size_t)(L - 2) * IN_COLS * DM), DM / 2, DM / 2, DM / 2};
                pg8::EpiIn E{pg8::PreSsq4{ssq4, rtab, rawt}, wsb(Fp, WS_U), wsb(Fp, WS_P), wsb(Fp, WS_RQ), wsb(Fp, WS_SGP), 0.03125f};
                pg8::gemm_phase<pg8::EpiIn, pg8::StaticOrder, pg8::KPlain, true>(ring, g, S, E, Fp.wave); }
        } }
        SEAM();
#if (DUP_MASK >> 12) & 1
        if (IN_PH()) { REPBAR();
            PHASE_FRAME(Fp);
            pg8::Gemm g{wsb(Fp, WS_XB), wsb(Fp, WS_WIN) + (size_t)L * IN_COLS * DM, DM, DM, DM}; pg8::HotOrder S{7, 0};
            pg8::EpiY E{pg8::PreNone{}, wsb(Fp, WS_ACT + 330 * MiB), 1.0f, nullptr, 0, 0};
            pg8::gemm_phase<pg8::EpiY, pg8::HotOrder, pg8::KPlain>(ring, g, S, E, Fp.wave);
        }
#endif
        if (PHON(2) && IN_PH()) {
_Pragma("unroll 1") for (int rep_ = 0; rep_ < NREP(2); ++rep_) { if (rep_) REPBAR(); PHASE_FRAME(Fp); p_cp(Fp, L); } }
        SEAM();
        if (PHON(3) && IN_PH()) {
_Pragma("unroll 1") for (int rep_ = 0; rep_ < NREP(3); ++rep_) { if (rep_) REPBAR();
            PHASE_FRAME(Fp); gf_t ssq4 = wsf(Fp, WS_SSQ4); gbf_t xb = wsb(Fp, WS_XB); (void)ssq4; (void)xb;
            pg8::Gemm g{wsb(Fp, WS_SD), wsb(Fp, WS_WM) + (size_t)L * DM * 640, DM, 640, 640, 2, SG_MG}; pg8::StaticOrder S; S.init(NTOK, DM, Fp.G, Fp.bid);
            if (L < 2) { pg8::EpiMerge<false> E{pg8::PreNone{}, wsb(Fp, WS_RQ), wsb(Fp, WS_SGP), wsb(Fp, WS_MERGED)}; pg8::gemm_phase<pg8::EpiMerge<false>, pg8::StaticOrder, pg8::KMerge>(ring, g, S, E, Fp.wave); }
            else { pg8::EpiMerge<true> E{pg8::PreNone{}, wsb(Fp, WS_RQ), wsb(Fp, WS_SGP), wsb(Fp, WS_MERGED)}; pg8::gemm_phase<pg8::EpiMerge<true>, pg8::StaticOrder, pg8::KMerge>(ring, g, S, E, Fp.wave); }
        } }
        SEAM();
        if (PHON(4) && IN_PH()) { {
            PHASE_FRAME(Fp); gf_t ssq4 = wsf(Fp, WS_SSQ4); gbf_t xb = wsb(Fp, WS_XB); (void)ssq4; (void)xb;
            pg8::StaticOrder S; S.init(NTOK, DM, Fp.G, Fp.bid);
            if (L < 2) { pg8::Gemm g{wsb(Fp, WS_MERGED), wsb(Fp, WS_WOUT) + (size_t)L * DM * DM, DM, DM, DM, 2, SG_OUT};
                pg8::EpiRes E{pg8::PreNone{}, xb, ssq4, stab, 1.0f, nullptr};
                pg8::gemm_phase<pg8::EpiRes, pg8::StaticOrder, pg8::KPlain>(ring, g, S, E, Fp.wave); }
            else { pg8::Gemm g{wsb(Fp, WS_MERGED), wsb(Fp, WS_WOUT + (size_t)L * DM * DM * 2), DM / 2, DM / 2, DM / 2, 2, SG_OUT};
                pg8::EpiRes E{pg8::PreNone{}, xb, ssq4, stab, 0.03125f, L == 2 ? Fp.ws + WS_XB8 : (GAS unsigned char*)nullptr};
                pg8::gemm_phase<pg8::EpiRes, pg8::StaticOrder, pg8::KPlain, true>(ring, g, S, E, Fp.wave); }
        } }
        SEAM();
        if ((L & 1) == 0) {
            const int i = L >> 1;
            if (PHON(5) && IN_PH()) {
_Pragma("unroll 1") for (int rep_ = 0; rep_ < NREP(5); ++rep_) { if (rep_) REPBAR();
            PHASE_FRAME(Fp); gf_t ssq4 = wsf(Fp, WS_SSQ4); gbf_t xb = wsb(Fp, WS_XB); (void)ssq4; (void)xb;
                pg8::StaticOrder S; S.init(NTOK, 2 * DFF, Fp.G, Fp.bid);
                if (i == 0) { pg8::Gemm g{xb, wsb(Fp, WS_DGU), DM, DM, DM};
                    pg8::EpiSwiglu<pg8::PreSsq4, false> E{pg8::PreSsq4{ssq4, rtab, rawt}, wsb(Fp, WS_HMID), DFF};
                    pg8::gemm_phase<pg8::EpiSwiglu<pg8::PreSsq4, false>, pg8::StaticOrder, pg8::KPlain>(ring, g, S, E, Fp.wave); }
                else { pg8::Gemm g{wsb(Fp, WS_XB8), wsb(Fp, WS_DGU8), DM / 2, DM / 2, DM / 2};
                    pg8::EpiSwiglu<pg8::PreSsq4, true> E{pg8::PreSsq4{ssq4, rtab, rawt}, Fp.ws + WS_H8, DFF};
                    pg8::gemm_phase<pg8::EpiSwiglu<pg8::PreSsq4, true>, pg8::StaticOrder, pg8::KPlain, true>(ring, g, S, E, Fp.wave); }
            } }
            SEAM();
            if (PHON(6) && IN_PH()) {
            PHASE_FRAME(Fp); gf_t ssq4 = wsf(Fp, WS_SSQ4); gbf_t xb = wsb(Fp, WS_XB); (void)ssq4; (void)xb;
                pg8::StaticOrder S; S.init(NTOK, DM, Fp.G, Fp.bid);
                if (i == 0) { pg8::Gemm g{wsb(Fp, WS_HMID), wsb(Fp, WS_DD), DFF, DFF, DFF, 2, SG_F2};
                    pg8::EpiRes E{pg8::PreNone{}, xb, ssq4, stab, 1.0f, nullptr};
                    pg8::gemm_phase<pg8::EpiRes, pg8::StaticOrder, pg8::KPlain>(ring, g, S, E, Fp.wave); }
                else { pg8::Gemm g{wsb(Fp, WS_H8), wsb(Fp, WS_DD8), DFF / 2, DFF / 2, DFF / 2, 2, SG_F2};
                    pg8::EpiRes E{pg8::PreNone{}, xb, ssq4, stab, 1.0f / 256.0f, Fp.ws + WS_XB8};
                    pg8::gemm_phase<pg8::EpiRes, pg8::StaticOrder, pg8::KPlain, true>(ring, g, S, E, Fp.wave); }
            }
            SEAM();
        } else {
            const int i = L >> 1;
            if (PHON(7) && IN_PH()) {
_Pragma("unroll 1") for (int rep_ = 0; rep_ < NREP(7); ++rep_) { if (rep_) REPBAR(); PHASE_FRAME(Fp); p_r1(Fp, i, L); } }
            SEAM();
            if (PHON(8) && IN_PH()) {
_Pragma("unroll 1") for (int rep_ = 0; rep_ < NREP(8); ++rep_) { if (rep_) REPBAR(); PHASE_FRAME(Fp); p_r2(Fp); } }
            SEAM();
            if (PHON(9) && IN_PH()) {
_Pragma("unroll 1") for (int rep_ = 0; rep_ < NREP(9); ++rep_) { if (rep_) REPBAR();
            PHASE_FRAME(Fp); gf_t ssq4 = wsf(Fp, WS_SSQ4); gbf_t xb = wsb(Fp, WS_XB); (void)ssq4; (void)xb;
                LAS unsigned* ptab = (LAS unsigned*)(Fp.lds + PTAB_OFF);
                for (int q = Fp.tid; q < 512; q += NWAVES * 64) ptab[q] = __hip_atomic_load(wsu(Fp, WS_PANEL) + q, RLX_AGENT);
                LDS_WAIT(); __syncthreads();
                pg8::Gemm g{wsb(Fp, WS_XG), wsb(Fp, WS_MGU + (size_t)i * NEXP * 2 * DFFE * DM), DM / 2, DM / 2, DM / 2}; pg8::MoeOrder S; S.init(ptab, 2 * DFFE, Fp.G, Fp.bid);
                pg8::EpiSwiglu8 E{pg8::PreNone{}, Fp.ws + WS_HE, DFFE};
                pg8::gemm_phase<pg8::EpiSwiglu8, pg8::MoeOrder, pg8::KPlain, true>(ring, g, S, E, Fp.wave);
            } }
            SEAM();
            if (PHON(10) && IN_PH()) {
_Pragma("unroll 1") for (int rep_ = 0; rep_ < NREP(10); ++rep_) { if (rep_) REPBAR();
            PHASE_FRAME(Fp); gf_t ssq4 = wsf(Fp, WS_SSQ4); gbf_t xb = wsb(Fp, WS_XB); (void)ssq4; (void)xb;
                LAS unsigned* ptab = (LAS unsigned*)(Fp.lds + PTAB_OFF);
                for (int q = Fp.tid; q < 512; q += NWAVES * 64) ptab[q] = __hip_atomic_load(wsu(Fp, WS_PANEL) + q, RLX_AGENT);
                LDS_WAIT(); __syncthreads();
                pg8::Gemm g{wsb(Fp, WS_HE), wsb(Fp, WS_MD + (size_t)i * NEXP * DM * DFFE), DFFE / 2, DFFE / 2, DFFE / 2}; pg8::MoeOrder2 S; S.init(ptab, Fp.G, Fp.bid);
                pg8::EpiY E{pg8::PreNone{}, wsb(Fp, WS_Y), 1.0f / 256.0f, wsb(Fp, WS_YP), S.mainP * 256, S.S == 7 ? pg8::TAIL_ROWS : pg8::TAIL_ROWS2};
                pg8::gemm_phase<pg8::EpiY, pg8::MoeOrder2, pg8::KPlainV, true, true>(ring, g, S, E, Fp.wave);
            } }
            SEAM();
            if (PHON(11) && IN_PH()) { PHASE_FRAME(Fp); p_cb(Fp, L == DEPTH - 1); }
            if (L != DEPTH - 1) SEAM();
        }
    }
#undef IN_PH
#undef SEAM
}

extern "C" void kernel_launch(void* const* d_in, const int* in_sizes, int n_in, void* d_out, int out_size, void* d_ws, size_t ws_size, hipStream_t stream) {
    static int grid = 0;
    if (grid == 0) {
        if (n_in != 20 || in_sizes[0] != NTOK * DM || out_size != NTOK * DM || ws_size < WS_END2) { fprintf(stderr, "kernel_launch: unexpected shapes / workspace (%d inputs, ws %zu, need %zu)\n", n_in, ws_size, (size_t)WS_END2); grid = -1; return; }
        int dev = 0, cus = 0, per_cu = 0;
        if (hipGetDevice(&dev) != hipSuccess || hipDeviceGetAttribute(&cus, hipDeviceAttributeMultiprocessorCount, dev) != hipSuccess) { grid = -1; return; }
        if (hipFuncSetAttribute((const void*)trunk_fwd, hipFuncAttributeMaxDynamicSharedMemorySize, LDS_BYTES) != hipSuccess) { fprintf(stderr, "kernel_launch: hipFuncSetAttribute failed\n"); grid = -1; return; }
        if (hipOccupancyMaxActiveBlocksPerMultiprocessor(&per_cu, (const void*)trunk_fwd, NWAVES * 64, LDS_BYTES) != hipSuccess || per_cu < 1) { fprintf(stderr, "kernel_launch: occupancy query says %d blocks per CU\n", per_cu); grid = -1; (void)hipGetLastError(); return; }
        grid = cus;
    }
    if (grid < 0) return;
    if (hipMemsetAsync((char*)d_ws + WS_CTL, 0, CTL_ZERO_BYTES, stream) != hipSuccess) return;
    Args a{};
    for (int i = 0; i < 20; ++i) a.in[i] = (const float*)d_in[i];
    a.out = (float*)d_out; a.ws = (unsigned char*)d_ws;
#if MK_PER_PHASE
    for (int p = 0; p < N_PHASES; ++p) { a.ph_lo = p; a.ph_hi = p + 1; hipLaunchKernelGGL(trunk_fwd, dim3(grid), dim3(NWAVES * 64), LDS_BYTES, stream, a); }
#else
    a.ph_lo = 0; a.ph_hi = N_PHASES;
    hipLaunchKernelGGL(trunk_fwd, dim3(grid), dim3(NWAVES * 64), LDS_BYTES, stream, a);
#endif
}
```

```cpp
#include <hip/hip_runtime.h>
#include <cstdio>
#include <cstdint>

#ifndef PH_MASK
#define PH_MASK 0xFFF
#endif
#define PHON(b) ((PH_MASK >> (b)) & 1)
#ifndef DUP_MASK
#define DUP_MASK 0
#endif
#define NREP(b) (((DUP_MASK >> (b)) & 1) ? 2 : 1)
#ifndef MK_PER_PHASE
#define MK_PER_PHASE 0
#endif

#define LAS __attribute__((address_space(3)))
#define GAS __attribute__((address_space(1)))
typedef unsigned short bf16_t;
typedef short bf16x8 __attribute__((ext_vector_type(8)));
typedef float f32x4 __attribute__((ext_vector_type(4)));
typedef float f32x2 __attribute__((ext_vector_type(2)));
typedef unsigned u32x4 __attribute__((ext_vector_type(4)));
typedef unsigned u32x2 __attribute__((ext_vector_type(2)));
typedef GAS unsigned gu32;
typedef GAS bf16_t* gbf_t; typedef const GAS bf16_t* gcbf_t; typedef GAS float* gf_t; typedef const GAS float* gcf_t; typedef GAS unsigned* gu_t;
#define ST4U(p) (*(GAS u32x4*)(p))
#define LD4U(p) (*(const GAS u32x4*)(p))
#define ST4F(p) (*(GAS f32x4*)(p))
#define LD4F(p) (*(const GAS f32x4*)(p))
#define RLX_AGENT __ATOMIC_RELAXED, __HIP_MEMORY_SCOPE_AGENT

constexpr int NTOK = 32768, DM = 1024, SEQ = 8192, DEPTH = 4;
constexpr int CONV_DIM = 512, CONV_W = 31;
constexpr int IN_COLS = 3584;
constexpr int DFF = 2816, NEXP = 8, DFFE = 3584;
constexpr int NSLOT = 2 * NTOK + NEXP * 256;
constexpr float RMS_EPS = 1e-6f, LN_EPS = 1e-5f;
constexpr int NWAVES = 8;

constexpr size_t MiB = 1u << 20;
constexpr size_t WS_CTL = 0, CTL_ZERO_BYTES = 65536;
constexpr size_t WS_SSQ4 = 1 * MiB;
constexpr size_t WS_TOKE = 3 * MiB;
constexpr size_t WS_TOKP = WS_TOKE + 131072;
constexpr size_t WS_TOKR = WS_TOKP + 131072;
constexpr size_t WS_SLOTOF = WS_TOKR + 131072;
constexpr size_t WS_CNT = WS_SLOTOF + 262144;
constexpr size_t WS_PANEL = WS_CNT + 8192;
constexpr size_t WS_RSLOT = WS_PANEL + 4096;
constexpr size_t WS_WIN = 6 * MiB;
constexpr size_t WS_WM = 34 * MiB;
constexpr size_t WS_WOUT = 39 * MiB;
constexpr size_t WS_DGU = 47 * MiB;
constexpr size_t WS_DD = 69 * MiB;
constexpr size_t WS_MGU = 80 * MiB;
constexpr size_t WS_MD = 192 * MiB;
constexpr size_t WS_XB = 248 * MiB;
constexpr size_t WS_ACT = 312 * MiB;
constexpr size_t WS_U = WS_ACT;
constexpr size_t WS_P = WS_ACT + 32 * MiB;
constexpr size_t WS_RQ = WS_ACT + 64 * MiB;
constexpr size_t WS_SGP = WS_ACT + 128 * MiB;
constexpr size_t WS_SD = WS_ACT + 192 * MiB;
constexpr size_t WS_MERGED = WS_ACT + 256 * MiB;
constexpr size_t WS_HMID = WS_ACT;
constexpr size_t WS_XG = WS_ACT;
constexpr size_t WS_Y = WS_ACT + 66 * MiB;
constexpr size_t WS_HE = WS_ACT + 198 * MiB;
constexpr size_t WS_H8 = WS_ACT;
constexpr size_t WS_YP = WS_ACT + 464 * MiB;
constexpr size_t WS_END = WS_ACT + 594 * MiB;
constexpr size_t WS_XB8 = WS_ACT + 432 * MiB;
constexpr size_t WS_WIN8 = 20 * MiB;
constexpr size_t WS_DGU8 = 58 * MiB;
constexpr size_t WS_DD8 = 75 * MiB;
constexpr size_t WS_END2 = WS_END;
static_assert(WS_WIN + (size_t)2 * IN_COLS * DM * 2 <= WS_WIN8 && WS_WIN8 + (size_t)2 * IN_COLS * DM <= WS_WM && WS_DGU + (size_t)2 * DFF * DM * 2 <= WS_DGU8 && WS_DGU8 + (size_t)2 * DFF * DM <= WS_DD && WS_DD + (size_t)DM * DFF * 2 <= WS_DD8 && WS_DD8 + (size_t)DM * DFF <= WS_MGU && WS_XB8 + (size_t)NTOK * DM <= WS_END && WS_HE + (size_t)NSLOT * DFFE <= WS_XB8, "d_ws map (fp8 copies)");
static_assert((size_t)NSLOT * DM <= 66 * MiB && (size_t)NSLOT * DM * 2 <= 132 * MiB && WS_HE + (size_t)NSLOT * DFFE <= WS_END && (size_t)2 * NEXP * 2 * DFFE * DM <= 112 * MiB && (size_t)2 * NEXP * DFFE * DM <= 56 * MiB, "d_ws map");

constexpr int CW_BAR = 4096;

constexpr int RING_BYTES = 131072;
constexpr int LDSCTL_OFF = RING_BYTES, MISC_OFF = LDSCTL_OFF + 320, PTAB_OFF = LDSCTL_OFF + 1024;
constexpr int RTAB_OFF = LDSCTL_OFF + 3072, STAB_OFF = LDSCTL_OFF + 4096, RAW_OFF = LDSCTL_OFF + 8192;
constexpr int LDS_BYTES = 147456;

__device__ __forceinline__ unsigned cvt_pk_bf16(float lo, float hi) { unsigned r; asm volatile("v_cvt_pk_bf16_f32 %0, %1, %2" : "=v"(r) : "v"(lo), "v"(hi)); return r; }
__device__ __forceinline__ float bf_lo(unsigned w) { return __uint_as_float(w << 16); }
__device__ __forceinline__ float bf_hi(unsigned w) { return __uint_as_float(w & 0xffff0000u); }
__device__ __forceinline__ float fast_exp(float x) { return __builtin_amdgcn_exp2f(x * 1.4426950408889634f); }
__device__ __forceinline__ float clamp30(float x) { return __builtin_fminf(__builtin_fmaxf(x, -30.f), 30.f); }
__device__ __forceinline__ float sigmoidf_(float x) { return __builtin_amdgcn_rcpf(1.0f + fast_exp(-clamp30(x))); }
__device__ __forceinline__ int hw_tid(int wave) { unsigned ones = ~0u; asm volatile("" : "+s"(ones));
    return wave * 64 + (int)__builtin_amdgcn_mbcnt_hi(ones, __builtin_amdgcn_mbcnt_lo(ones, 0u)); }
template <int M> __device__ __forceinline__ int shx_i(int v, int lane) {
    if constexpr (M < 32) return __builtin_amdgcn_ds_swizzle(v, (M << 10) | 0x1F);
    else return __builtin_amdgcn_ds_bpermute((lane ^ 32) << 2, v);
}
template <int M> __device__ __forceinline__ float shx(float v, int lane) { return __int_as_float(shx_i<M>(__float_as_int(v), lane)); }
__device__ __forceinline__ float wave_sum_l(float v, int lane) { v += shx<1>(v, lane); v += shx<2>(v, lane); v += shx<4>(v, lane); v += shx<8>(v, lane); v += shx<16>(v, lane); v += shx<32>(v, lane); return v; }
#define LDS_WAIT() asm volatile("s_waitcnt lgkmcnt(0)" ::: "memory")
#define VM_WAIT() asm volatile("s_waitcnt vmcnt(0)" ::: "memory")

namespace pg8 {
constexpr int BM = 256, BK = 64, HALF = 128, HTB = HALF * BK * 2, STAGE_BYTES = 8 * HTB, NXCD = 8, WGM = 8;
__host__ __device__ __forceinline__ int lds_byte(int r, int c) { const int st = (r >> 4) * 2 + (c >> 5), rr = r & 15, cc = c & 31, ob = rr * 64 + cc * 2; return st * 1024 + (ob ^ (((ob >> 9) & 1) << 5)); }
__host__ __device__ __forceinline__ void stage_rc(int b, int& R, int& C) { const int st = b / 1024, sb = b % 1024, swz = sb ^ (((sb >> 9) & 1) << 5); R = (st >> 1) * 16 + swz / 64; C = (st & 1) * 32 + (swz % 64) / 2; }
__host__ __device__ __forceinline__ int perm32(int rho) { const int n = rho >> 4, i = rho & 15; return 8 * (i >> 2) + 4 * n + (i & 3); }

struct Unit { int pm, pn, pb; int kt0 = 0, ntu = 0, part = -1; };
struct Gemm { gcbf_t A; gcbf_t Bt; int lda, ldb, K; int sg_n = 4, sg_k = 0; };

struct KPlain { static __device__ __forceinline__ int koff(const Unit&, int t) { return t * BK; } };
struct KPlainV { static __device__ __forceinline__ int koff(const Unit& u, int t) { return (u.kt0 + t) * BK; } };
struct KMerge { static __device__ __forceinline__ int koff(const Unit& u, int t) { return t < 8 ? 512 + t * BK : u.pn * 128 + (t - 8) * BK; } };

struct StaticOrder {
    int nM, nN, nwg, G, c;
    __device__ __forceinline__ void init(int M, int N, int G_, int c_) { nM = M / BM; nN = N / BM; nwg = nM * nN; G = G_; c = c_; }
    __device__ __forceinline__ bool next(int i, Unit& u) const {
        const long L = (long)i * G + c; if (i > 0 && L >= nwg) return false;
        int wgid = (int)L; { const int q = nwg / NXCD, r = nwg % NXCD, xcd = wgid % NXCD, off = wgid / NXCD; wgid = (xcd < r ? xcd * (q + 1) : r * (q + 1) + (xcd - r) * q) + off; }
        const int nig = WGM * nN, gid = wgid / nig, fm = gid * WGM, gsz = (nM - fm) < WGM ? (nM - fm) : WGM;
        u.pm = __builtin_amdgcn_readfirstlane(fm + ((wgid % nig) % gsz)); u.pn = __builtin_amdgcn_readfirstlane((wgid % nig) / gsz); u.pb = u.pn; return true;
    }
};
struct HotOrder { int NU; int c; __device__ __forceinline__ bool next(int i, Unit& u) const { if (i >= NU) return false; u.pm = 0; u.pn = 0; u.pb = 0; return true; } };
struct MoeOrder {
    int nM, nN, nwg, G, c; const LAS unsigned* ptab;
    __device__ __forceinline__ void init(const LAS unsigned* pt, int N, int G_, int c_) { ptab = pt; nM = __builtin_amdgcn_readfirstlane((int)pt[0]); nN = N / BM; nwg = nM * nN; G = G_; c = c_; }
    __device__ __forceinline__ bool next(int i, Unit& u) const {
        const long L = (long)i * G + c; if (i > 0 && L >= nwg) return false;
        int wgid = (int)L; { const int q = nwg / NXCD, r = nwg % NXCD, xcd = wgid % NXCD, off = wgid / NXCD; wgid = (xcd < r ? xcd * (q + 1) : r * (q + 1) + (xcd - r) * q) + off; }
        const int nig = WGM * nN, gid = wgid / nig, fm = gid * WGM, gsz = (nM - fm) < WGM ? (nM - fm) : WGM;
        u.pm = __builtin_amdgcn_readfirstlane(fm + ((wgid % nig) % gsz)); u.pn = __builtin_amdgcn_readfirstlane((wgid % nig) / gsz);
        u.pb = __builtin_amdgcn_readfirstlane((int)ptab[1 + u.pm]) * nN + u.pn; return true;
    }
};

struct MoeOrder2 {
    int nM, mainP, tailP, S, Um, nwg, G, c; const LAS unsigned* ptab;
    static __device__ __forceinline__ void split(int nM_, int G_, int& mainP_, int& tailP_, int& S_) {
        tailP_ = (G_ % 4 == 0) ? nM_ % (G_ / 4) : 0; S_ = tailP_ == 0 ? 1 : (28 * tailP_ <= G_ ? 7 : (8 * tailP_ <= G_ ? 2 : 1));
        if (S_ == 1) tailP_ = 0; mainP_ = nM_ - tailP_; }
    __device__ __forceinline__ void init(const LAS unsigned* pt, int G_, int c_) { ptab = pt; nM = __builtin_amdgcn_readfirstlane((int)pt[0]); G = G_; c = c_; split(nM, G, mainP, tailP, S); mainP = __builtin_amdgcn_readfirstlane(mainP); tailP = __builtin_amdgcn_readfirstlane(tailP); S = __builtin_amdgcn_readfirstlane(S); Um = mainP * 4; nwg = Um + tailP * 4 * S; }
    __device__ __forceinline__ bool next(int i, Unit& u) const {
        const long L = (long)i * G + c; if (i > 0 && L >= nwg) return false;
        if (L < Um) { int wgid = (int)L; { const int q = Um / NXCD, r = Um % NXCD, xcd = wgid % NXCD, off = wgid / NXCD; wgid = (xcd < r ? xcd * (q + 1) : r * (q + 1) + (xcd - r) * q) + off; }
            const int nig = WGM * 4, gid = wgid / nig, fm = gid * WGM, gsz = (mainP - fm) < WGM ? (mainP - fm) : WGM;
            u.pm = __builtin_amdgcn_readfirstlane(fm + ((wgid % nig) % gsz)); u.pn = __builtin_amdgcn_readfirstlane((wgid % nig) / gsz); u.kt0 = 0; u.ntu = 28; u.part = -1; }
        else { const int q = (int)L - Um, j = q / S, sp = q % S; u.pm = __builtin_amdgcn_readfirstlane(mainP + j / 4); u.pn = __builtin_amdgcn_readfirstlane(j % 4); u.ntu = __builtin_amdgcn_readfirstlane(28 / S); u.kt0 = __builtin_amdgcn_readfirstlane(sp * (28 / S)); u.part = __builtin_amdgcn_readfirstlane(sp); }
        u.pb = __builtin_amdgcn_readfirstlane((int)ptab[1 + u.pm]) * 4 + u.pn; return true;
    }
};

typedef f32x4 Acc[2][2][4][2];

__device__ __forceinline__ u32x4 pack8(const f32x4 v0, const f32x4 v1) { u32x4 w; w.x = cvt_pk_bf16(v0[0], v0[1]); w.y = cvt_pk_bf16(v0[2], v0[3]); w.z = cvt_pk_bf16(v1[0], v1[1]); w.w = cvt_pk_bf16(v1[2], v1[3]); return w; }
__device__ __forceinline__ void unpack8(const u32x4 w, f32x4& v0, f32x4& v1) { v0 = (f32x4){bf_lo(w.x), bf_hi(w.x), bf_lo(w.y), bf_hi(w.y)}; v1 = (f32x4){bf_lo(w.z), bf_hi(w.z), bf_lo(w.w), bf_hi(w.w)}; }

__device__ __forceinline__ unsigned long long uni64(const GAS char* p) { const unsigned long long v = (unsigned long long)p; const unsigned lo = __builtin_amdgcn_readfirstlane((unsigned)v), hi = __builtin_amdgcn_readfirstlane((unsigned)(v >> 32)); return ((unsigned long long)hi << 32) | lo; }
typedef short s16x2 __attribute__((ext_vector_type(2)));
__device__ __forceinline__ unsigned pk_fp8x4_s(float a, float b, float c, float d, float scale) { s16x2 w = {0, 0}; w = __builtin_amdgcn_cvt_scalef32_pk_fp8_f32(w, a, b, scale, false); w = __builtin_amdgcn_cvt_scalef32_pk_fp8_f32(w, c, d, scale, true); return __builtin_bit_cast(unsigned, w); }
__device__ __forceinline__ unsigned pk_fp8x4(float a, float b, float c, float d) { int w = __builtin_amdgcn_cvt_pk_fp8_f32(a, b, 0, false); w = __builtin_amdgcn_cvt_pk_fp8_f32(c, d, w, true); return (unsigned)w; }

__device__ __forceinline__ void unpack_fp8x8(const u32x2 w, f32x4& a, f32x4& b) {
    const f32x2 a0 = __builtin_amdgcn_cvt_pk_f32_fp8((int)w.x, false), a1 = __builtin_amdgcn_cvt_pk_f32_fp8((int)w.x, true), b0 = __builtin_amdgcn_cvt_pk_f32_fp8((int)w.y, false), b1 = __builtin_amdgcn_cvt_pk_f32_fp8((int)w.y, true);
    a = (f32x4){a0.x, a0.y, a1.x, a1.y}; b = (f32x4){b0.x, b0.y, b1.x, b1.y}; }

struct PreNone { static constexpr bool HAS_PRE = false;
    __device__ __forceinline__ void issue(const Unit&, int, int) const {}
    __device__ __forceinline__ void finish(int) const {} };
struct PreSsq4 { static constexpr bool HAS_PRE = true;
    gcf_t ssq4; LAS float* rtab; LAS float* raw;
    __device__ __forceinline__ void issue(const Unit& u, int tid, int wid) const {
        if (wid < 4) { int te = tid; asm volatile("" : "+v"(te)); const unsigned vo = (unsigned)te * 4u, l0 = (unsigned)(size_t)raw + (unsigned)wid * 256u;
#pragma unroll
            for (int k = 0; k < 4; ++k) { unsigned keep;
                asm volatile("s_mov_b32 %0, m0\n\ts_mov_b32 m0, %3\n\ts_nop 0\n\tglobal_load_lds_dword %1, %2\n\ts_mov_b32 m0, %0" : "=&s"(keep) : "v"(vo), "s"(uni64((const GAS char*)(ssq4 + u.pm * BM + k * NTOK))), "s"(l0 + (unsigned)k * 1024u) : "memory"); } } }
    __device__ __forceinline__ void finish(int tid) const {
        asm volatile("s_waitcnt vmcnt(16)" ::: "memory");
        int te = tid; asm volatile("" : "+v"(te));
        if (te < 256) { const unsigned la = (unsigned)(size_t)raw + (unsigned)te * 4u; float a, b, c, d;
            asm volatile("ds_read_b32 %0, %4\n\tds_read_b32 %1, %4 offset:1024\n\tds_read_b32 %2, %4 offset:2048\n\tds_read_b32 %3, %4 offset:3072\n\ts_waitcnt lgkmcnt(0)" : "=&v"(a), "=&v"(b), "=&v"(c), "=&v"(d) : "v"(la) : "memory");
            rtab[te] = __builtin_amdgcn_rsqf(((a + b) + (c + d)) * (1.0f / DM) + RMS_EPS); } } };
struct PreRow { static constexpr bool HAS_PRE = true;
    gcf_t rrow; LAS float* rtab; LAS float* raw;
    __device__ __forceinline__ void issue(const Unit& u, int tid, int wid) const {
        if (wid < 4) { int te = tid; asm volatile("" : "+v"(te)); const unsigned vo = (unsigned)te * 4u, l0 = (unsigned)(size_t)raw + (unsigned)wid * 256u; unsigned keep;
            asm volatile("s_mov_b32 %0, m0\n\ts_mov_b32 m0, %3\n\ts_nop 0\n\tglobal_load_lds_dword %1, %2\n\ts_mov_b32 m0, %0" : "=&s"(keep) : "v"(vo), "s"(uni64((const GAS char*)(rrow + u.pm * BM))), "s"(l0) : "memory"); } }
    __device__ __forceinline__ void finish(int tid) const {
        asm volatile("s_waitcnt vmcnt(16)" ::: "memory");
        int te = tid; asm volatile("" : "+v"(te));
        if (te < 256) { const unsigned la = (unsigned)(size_t)raw + (unsigned)te * 4u; float a;
            asm volatile("ds_read_b32 %0, %1\n\ts_waitcnt lgkmcnt(0)" : "=&v"(a) : "v"(la) : "memory");
            rtab[te] = a; } } };

struct EpiIn {
    static constexpr bool HAS_MID = false; static constexpr int MID_T = -1; typedef PreSsq4 Pre;
    Pre pre; gbf_t U, P, RQ, SGP; float ascale;
    __device__ __forceinline__ void mid(Acc&, const Unit&, int, int, int, int) const {}
    __device__ __forceinline__ void operator()(const Acc& acc, const Unit& u, int wr, int wc, int fr, int fq) const {
        const int rl0 = wr * 64 + fr, row0 = u.pm * BM + rl0, cw = wc * 32 + 8 * fq;
        float rs[2][4];
#pragma unroll
        for (int ai = 0; ai < 2; ++ai)
#pragma unroll
            for (int m = 0; m < 4; ++m) rs[ai][m] = pre.rtab[rl0 + ai * HALF + m * 16] * ascale;
        if (u.pn < 4) {
#pragma unroll
            for (int ai = 0; ai < 2; ++ai)
#pragma unroll
                for (int m = 0; m < 4; ++m) { const int row = row0 + ai * HALF + m * 16; const float r = rs[ai][m], rn = r * -1.4426950408889634f; f32x4 o[2];
#pragma unroll
                    for (int n = 0; n < 2; ++n)
#pragma unroll
                        for (int j = 0; j < 4; ++j) { const float a = acc[ai][0][m][n][j] * r, e = __builtin_amdgcn_exp2f(acc[ai][1][m][n][j] * rn); o[n][j] = a * __builtin_amdgcn_rcpf(1.0f + e); }
                    ST4U(U + ((unsigned)row * CONV_DIM + u.pn * 128 + cw)) = pack8(o[0], o[1]); }
        } else if (u.pn < 6) {
#pragma unroll
            for (int ai = 0; ai < 2; ++ai)
#pragma unroll
                for (int m = 0; m < 4; ++m) { const int row = row0 + ai * HALF + m * 16; const float r = rs[ai][m];
#pragma unroll
                    for (int bj = 0; bj < 2; ++bj) ST4U(P + ((unsigned)row * 512 + (u.pn - 4) * 256 + bj * HALF + cw)) = pack8(acc[ai][bj][m][0] * r, acc[ai][bj][m][1] * r); }
        } else {
#pragma unroll
            for (int ai = 0; ai < 2; ++ai)
#pragma unroll
                for (int m = 0; m < 4; ++m) { const int row = row0 + ai * HALF + m * 16; const float rn = rs[ai][m] * -1.4426950408889634f; unsigned qc[2][4], qp[2][4];
#pragma unroll
                    for (int n = 0; n < 2; ++n)
#pragma unroll
                        for (int j = 0; j < 4; ++j) { const float ec = __builtin_amdgcn_exp2f(acc[ai][0][m][n][j] * rn), ep = __builtin_amdgcn_exp2f(acc[ai][1][m][n][j] * rn);
                            qc[n][j] = __float_as_uint(__builtin_fmaf(__builtin_amdgcn_rcpf(1.0f + ec), 255.0f, 8388608.0f));
                            qp[n][j] = __float_as_uint(__builtin_fmaxf(__builtin_amdgcn_rcpf(1.0f + ep) * 255.0f, 1.0f) + 8388608.0f); }
                    const unsigned off = (unsigned)row * DM + (u.pn - 6) * 128 + cw;
                    u32x4 wq;
#pragma unroll
                    for (int d = 0; d < 4; ++d) { const int n = d >> 1, j = 2 * (d & 1);
                        wq[d] = __builtin_amdgcn_perm(__builtin_amdgcn_perm(qp[n][j + 1], qc[n][j + 1], 0x0c0c0400u), __builtin_amdgcn_perm(qp[n][j], qc[n][j], 0x0c0c0400u), 0x05040100u); }
                    ST4U((GAS unsigned char*)RQ + 2u * off) = wq; }
        }
    }
};
__device__ __forceinline__ u32x4 widen8(u32x2 a, u32x2 b) {
    const auto rx = __builtin_amdgcn_permlane16_swap(a.x, b.x, false, false), ry = __builtin_amdgcn_permlane16_swap(a.y, b.y, false, false);
    u32x4 o; o.x = rx[0]; o.y = ry[0]; o.z = rx[1]; o.w = ry[1]; return o; }
__device__ __forceinline__ void unpack_gates(const u32x4 w, f32x4& c0, f32x4& c1, f32x4& p0, f32x4& p1) {
    c0 = (f32x4){(float)(w.x & 255u), (float)((w.x >> 16) & 255u), (float)(w.y & 255u), (float)((w.y >> 16) & 255u)}; p0 = (f32x4){(float)((w.x >> 8) & 255u), (float)(w.x >> 24), (float)((w.y >> 8) & 255u), (float)(w.y >> 24)};
    c1 = (f32x4){(float)(w.z & 255u), (float)((w.z >> 16) & 255u), (float)(w.w & 255u), (float)((w.w >> 16) & 255u)}; p1 = (f32x4){(float)((w.z >> 8) & 255u), (float)(w.z >> 24), (float)((w.w >> 8) & 255u), (float)(w.w >> 24)}; }
template <bool F8  > struct EpiMerge {
    static constexpr bool HAS_MID = true; static constexpr int MID_T = 8; typedef PreNone Pre;
    Pre pre; gcbf_t RQ, SGP; gbf_t MG;
    __device__ __forceinline__ void mid(Acc& acc, const Unit& u, int wr, int wc, int fr, int fq) const {
        const int row0 = u.pm * BM + wr * 64 + fr, col0 = u.pn * BM + wc * 32 + 8 * fq;
        u32x4 wg_[2][4][2];
#pragma unroll
        for (int ai = 0; ai < 2; ++ai)
#pragma unroll
            for (int m = 0; m < 4; ++m)
#pragma unroll
                for (int bj = 0; bj < 2; ++bj) wg_[ai][m][bj] = LD4U((const GAS unsigned char*)RQ + 2u * ((unsigned)(row0 + ai * HALF + m * 16) * DM + col0 + bj * HALF));
        __builtin_amdgcn_sched_barrier(0);
#pragma unroll
        for (int ai = 0; ai < 2; ++ai)
#pragma unroll
            for (int m = 0; m < 4; ++m)
#pragma unroll
                for (int bj = 0; bj < 2; ++bj) { f32x4 c0, c1, p0, p1; unpack_gates(wg_[ai][m][bj], c0, c1, p0, p1);
#pragma unroll
                    for (int j = 0; j < 4; ++j) { acc[ai][bj][m][0][j] *= c0[j] * __builtin_amdgcn_rcpf(p0[j]); acc[ai][bj][m][1][j] *= c1[j] * __builtin_amdgcn_rcpf(p1[j]); } }
    }
    __device__ __forceinline__ void operator()(const Acc& acc, const Unit& u, int wr, int wc, int fr, int fq) const {
        const int row0 = u.pm * BM + wr * 64 + fr, col0 = u.pn * BM + wc * 32 + 8 * fq;
        u32x4 w[2][4][2]; u32x2 o8[2][2]; (void)o8;
#pragma unroll
        for (int ai = 0; ai < 2; ++ai)
#pragma unroll
            for (int m = 0; m < 4; ++m)
#pragma unroll
                for (int bj = 0; bj < 2; ++bj) w[ai][m][bj] = LD4U((const GAS unsigned char*)RQ + 2u * ((unsigned)(row0 + ai * HALF + m * 16) * DM + col0 + bj * HALF));
        __builtin_amdgcn_sched_barrier(0);
#pragma unroll
        for (int ai = 0; ai < 2; ++ai)
#pragma unroll
            for (int m = 0; m < 4; ++m)
#pragma unroll
                for (int bj = 0; bj < 2; ++bj) { f32x4 c0, c1, s0, s1; unpack_gates(w[ai][m][bj], c0, c1, s0, s1); (void)c0; (void)c1; const f32x4 a = acc[ai][bj][m][0] * (s0 * (1.0f / 255.0f)), b = acc[ai][bj][m][1] * (s1 * (1.0f / 255.0f));
                    if constexpr (F8) { o8[m & 1][bj].x = pk_fp8x4(a[0], a[1], a[2], a[3]); o8[m & 1][bj].y = pk_fp8x4(b[0], b[1], b[2], b[3]);
                        if (m & 1) ST4U((GAS unsigned char*)MG + ((unsigned)(row0 + ai * HALF + (m - 1) * 16 + (fq & 1) * 16) * DM + (col0 - 8 * (fq & 1)) + bj * HALF)) = widen8(o8[0][bj], o8[1][bj]); }
                    else ST4U(MG + ((unsigned)(row0 + ai * HALF + m * 16) * DM + col0 + bj * HALF)) = pack8(a, b); }
    }
};
struct EpiRes {
    static constexpr bool HAS_MID = false; static constexpr int MID_T = -1; typedef PreNone Pre;
    Pre pre; gbf_t xs; gf_t ssq4; LAS float* stab; float scale; GAS unsigned char* xb8;
    __device__ __forceinline__ void mid(Acc&, const Unit&, int, int, int, int) const {}
    __device__ __forceinline__ void operator()(const Acc& acc, const Unit& u, int wr, int wc, int fr, int fq) const {
        const int rl0 = wr * 64 + fr, col0 = u.pn * BM + wc * 32 + 8 * fq;
        u32x4 xw[2][4][2]; u32x2 w8[2][2];
#pragma unroll
        for (int ai = 0; ai < 2; ++ai)
#pragma unroll
            for (int m = 0; m < 4; ++m)
#pragma unroll
                for (int bj = 0; bj < 2; ++bj) xw[ai][m][bj] = LD4U(xs + ((unsigned)(u.pm * BM + rl0 + ai * HALF + m * 16) * DM + col0 + bj * HALF));
#pragma unroll
        for (int ai = 0; ai < 2; ++ai)
#pragma unroll
            for (int m = 0; m < 4; ++m) { const int rl = rl0 + ai * HALF + m * 16; const unsigned off = (unsigned)(u.pm * BM + rl) * DM + col0; float ss = 0.f;
#pragma unroll
                for (int bj = 0; bj < 2; ++bj) { f32x4 x0, x1; unpack8(xw[ai][m][bj], x0, x1);
                    const f32x4 y0 = x0 + acc[ai][bj][m][0] * scale, y1 = x1 + acc[ai][bj][m][1] * scale;
                    ST4U(xs + off + bj * HALF) = pack8(y0, y1);
                    if (xb8) { w8[m & 1][bj].x = pk_fp8x4(y0[0], y0[1], y0[2], y0[3]); w8[m & 1][bj].y = pk_fp8x4(y1[0], y1[1], y1[2], y1[3]);
                        if (m & 1) ST4U(xb8 + ((unsigned)(u.pm * BM + rl - 16 + (fq & 1) * 16) * DM + (col0 - 8 * (fq & 1)) + bj * HALF)) = widen8(w8[0][bj], w8[1][bj]); }
                    ss += ((y0[0] * y0[0] + y0[1] * y0[1]) + (y0[2] * y0[2] + y0[3] * y0[3])) + ((y1[0] * y1[0] + y1[1] * y1[1]) + (y1[2] * y1[2] + y1[3] * y1[3])); }
                ss += shx<16>(ss, fq * 16 + fr); ss += shx<32>(ss, fq * 16 + fr);
                if (fq == 0) stab[rl * 4 + wc] = ss; }
        asm volatile("s_waitcnt lgkmcnt(0)" ::: "memory"); __builtin_amdgcn_s_barrier(); asm volatile("" ::: "memory");
        const int tid = (wr * 4 + wc) * 64 + fq * 16 + fr;
        if (tid < 256) { const f32x4 v = *(const LAS f32x4*)(stab + tid * 4); ssq4[(unsigned)(u.pn * NTOK + u.pm * BM + tid)] = (v[0] + v[1]) + (v[2] + v[3]); }
    }
};
template <class PRE, bool O8  > struct EpiSwiglu {
    static constexpr bool HAS_MID = false; static constexpr int MID_T = -1; typedef PRE Pre;
    Pre pre; GAS void* Hv; int ldh;
    __device__ __forceinline__ void mid(Acc&, const Unit&, int, int, int, int) const {}
    __device__ __forceinline__ void operator()(const Acc& acc, const Unit& u, int wr, int wc, int fr, int fq) const {
        const int rl0 = wr * 64 + fr, row0 = u.pm * BM + rl0, cw = wc * 32 + 8 * fq;
        float rs[2][4]; u32x2 w8[2]; (void)w8;
#pragma unroll
        for (int ai = 0; ai < 2; ++ai)
#pragma unroll
            for (int m = 0; m < 4; ++m) rs[ai][m] = pre.rtab[rl0 + ai * HALF + m * 16] * (O8 ? 0.03125f : 1.0f);
#pragma unroll
        for (int ai = 0; ai < 2; ++ai)
#pragma unroll
            for (int m = 0; m < 4; ++m) { const int row = row0 + ai * HALF + m * 16; const float r = rs[ai][m], rr = O8 ? r * r * 4.0f : r * r, rn = r * -1.4426950408889634f; f32x4 o[2];
#pragma unroll
                for (int n = 0; n < 2; ++n)
#pragma unroll
                    for (int j = 0; j < 4; ++j) { float tg; asm("v_mul_f32 %0, %1, %2" : "=v"(tg) : "v"(acc[ai][0][m][n][j]), "v"(acc[ai][1][m][n][j]));
                        const float e = __builtin_amdgcn_exp2f(acc[ai][0][m][n][j] * rn); o[n][j] = tg * (rr * __builtin_amdgcn_rcpf(1.0f + e)); }
                if constexpr (O8) { w8[m & 1].x = pk_fp8x4(o[0][0], o[0][1], o[0][2], o[0][3]); w8[m & 1].y = pk_fp8x4(o[1][0], o[1][1], o[1][2], o[1][3]);
                    if (m & 1) ST4U((GAS unsigned char*)Hv + ((unsigned)(row - 16 + (fq & 1) * 16) * ldh + u.pn * 128 + cw - 8 * (fq & 1))) = widen8(w8[0], w8[1]); }
                else ST4U((gbf_t)Hv + ((unsigned)row * ldh + u.pn * 128 + cw)) = pack8(o[0], o[1]); }
    }
};
struct EpiSwiglu8 {
    static constexpr bool HAS_MID = false; static constexpr int MID_T = -1; typedef PreNone Pre;
    Pre pre; GAS unsigned char* H; int ldh;
    __device__ __forceinline__ void mid(Acc&, const Unit&, int, int, int, int) const {}
    __device__ __forceinline__ void operator()(const Acc& acc, const Unit& u, int wr, int wc, int fr, int fq) const {
        float c256 = 256.0f; asm volatile("" : "+s"(c256));
        const int row0 = u.pm * BM + wr * 64 + fr + (fq & 1) * 16, cw = wc * 32 + 8 * (fq & ~1);
#pragma unroll
        for (int ai = 0; ai < 2; ++ai)
#pragma unroll
            for (int mp = 0; mp < 2; ++mp) { u32x2 w[2];
#pragma unroll
                for (int q = 0; q < 2; ++q) { const int m = 2 * mp + q; f32x4 o[2];
#pragma unroll
                    for (int n = 0; n < 2; ++n)
#pragma unroll
                        for (int j = 0; j < 4; ++j) { float tg; asm("v_mul_f32 %0, %1, %2" : "=v"(tg) : "v"(acc[ai][0][m][n][j]), "v"(acc[ai][1][m][n][j]));
                            const float e = __builtin_amdgcn_exp2f(acc[ai][0][m][n][j] * (-0.03125f * 1.4426950408889634f)); o[n][j] = tg * __builtin_amdgcn_rcpf(1.0f + e); }
                    w[q].x = pk_fp8x4_s(o[0][0], o[0][1], o[0][2], o[0][3], c256); w[q].y = pk_fp8x4_s(o[1][0], o[1][1], o[1][2], o[1][3], c256); }
                ST4U(H + ((unsigned)(row0 + ai * HALF + mp * 32) * ldh + u.pn * 128 + cw)) = widen8(w[0], w[1]); }
    }
};
constexpr int TAIL_ROWS = 9 * 256;
constexpr int TAIL_ROWS2 = 32 * 256;
struct EpiY {
    static constexpr bool HAS_MID = false; static constexpr int MID_T = -1; typedef PreNone Pre;
    Pre pre; gbf_t Y; float scale; gbf_t YP; int main_rows, slab_rows;
    __device__ __forceinline__ void mid(Acc&, const Unit&, int, int, int, int) const {}
    __device__ __forceinline__ void operator()(const Acc& acc, const Unit& u, int wr, int wc, int fr, int fq) const {
        const int row0 = u.pm * BM + wr * 64 + fr, col0 = u.pn * BM + wc * 32 + 8 * fq;
        if (u.part < 0) { GAS unsigned char* base = (GAS unsigned char*)Y + (unsigned)(row0 + (fq & 1) * 16) * DM + (col0 - 8 * (fq & 1)); const float s16 = scale * 16.0f;
#pragma unroll
            for (int ai = 0; ai < 2; ++ai)
#pragma unroll
                for (int mp = 0; mp < 2; ++mp)
#pragma unroll
                    for (int bj = 0; bj < 2; ++bj) { u32x2 w[2];
#pragma unroll
                        for (int q = 0; q < 2; ++q) { const f32x4 a = acc[ai][bj][2 * mp + q][0] * s16, b = acc[ai][bj][2 * mp + q][1] * s16; w[q].x = pk_fp8x4(a[0], a[1], a[2], a[3]); w[q].y = pk_fp8x4(b[0], b[1], b[2], b[3]); }
                        ST4U(base + ((unsigned)(ai * HALF + mp * 32) * DM + bj * HALF)) = widen8(w[0], w[1]); }
        } else { gbf_t base = YP + (unsigned)(u.part * slab_rows + row0 - main_rows) * DM;
#pragma unroll
            for (int ai = 0; ai < 2; ++ai)
#pragma unroll
                for (int m = 0; m < 4; ++m) { gbf_t rp = base + ((unsigned)(ai * HALF + m * 16) * DM + col0);
#pragma unroll
                    for (int bj = 0; bj < 2; ++bj) ST4U(rp + bj * HALF) = pack8(acc[ai][bj][m][0] * scale, acc[ai][bj][m][1] * scale); } }
    }
};

typedef int i32x4 __attribute__((ext_vector_type(4)));
typedef int i32x8 __attribute__((ext_vector_type(8)));
#ifndef SG_OUT
#define SG_MG 0
#define SG_OUT 0
#define SG_F2 0
#endif
#ifndef STAG_STEP
#define STAG_STEP 0
#endif
template <class Epi, class Sched, class KA, bool FP8 = false, bool VARK = false>
__device__ __forceinline__ void gemm_phase(LAS unsigned char* lds, const Gemm g, const Sched& S, const Epi& E, int wave_) {
    { const int grp = (S.c >> 3) % g.sg_n;
      if (g.sg_k > 0) { for (int q = 0; q < grp * g.sg_k; ++q) __builtin_amdgcn_s_sleep(100); } else if (STAG_STEP > 0) { for (int q = 0; q < grp; ++q) __builtin_amdgcn_s_sleep(STAG_STEP); } }
    int tid_ = hw_tid(wave_); asm volatile("" : "+v"(tid_));
    const int tid = tid_, wid = __builtin_amdgcn_readfirstlane(tid >> 6), lane = tid & 63, wr = wid >> 2, wc = wid & 3, fr = lane & 15, fq = lane >> 4;
    const int K = g.K, nt = K / BK;
    unsigned voffA[2], voffB[2];
#pragma unroll
    for (int i = 0; i < 2; ++i) { int R, C; stage_rc(tid * 16 + i * 8192, R, C); const int Rb = (R & ~31) + perm32(R & 31);
        voffA[i] = (unsigned)(R * g.lda + C) * 2u; voffB[i] = (unsigned)(Rb * g.ldb + C) * 2u; }
    const size_t kstep = (size_t)(BK * 2);
    const size_t hstepA = (size_t)HALF * g.lda * 2, hstepB = (size_t)HALF * g.ldb * 2;
    const size_t tstepA = 2 * hstepA, tstepB = 2 * hstepB;
    const unsigned ldsw = (unsigned)wid * 1024u, lds0 = (unsigned)(size_t)lds;
    const int aoff = lds_byte(wr * 64 + fr, fq * 8), boff = lds_byte(wc * 32 + fr, fq * 8);
#define PG8_SA(b, h) (((b) * 2 + (h)) * HTB)
#define PG8_SB(b, h) ((4 + (b) * 2 + (h)) * HTB)
#define PG8_STAGE(bufoff, gbase, voff) do { _Pragma("unroll") for (int _i = 0; _i < 2; ++_i) { unsigned _keep; \
        asm volatile("s_mov_b32 %0, m0\n\ts_mov_b32 m0, %3\n\ts_nop 0\n\tglobal_load_lds_dwordx4 %1, %2\n\ts_mov_b32 m0, %0" : "=&s"(_keep) : "v"((voff)[_i]), "s"(uni64(gbase)), "s"(lds0 + (unsigned)(bufoff) + ldsw + (unsigned)(_i * 8192)) : "memory"); } } while (0)
#define PG8_LDA(dst, b, h) do { _Pragma("unroll") for (int m = 0; m < 4; ++m) { if constexpr (FP8) dst##8[m] = __builtin_shufflevector(*(const LAS i32x4*)(lds + PG8_SA(b, h) + aoff + m * 2048), *(const LAS i32x4*)(lds + PG8_SA(b, h) + aoff + m * 2048 + 1024), 0, 1, 2, 3, 4, 5, 6, 7); \
        else { _Pragma("unroll") for (int k = 0; k < 2; ++k) dst[m][k] = *(const LAS bf16x8*)(lds + PG8_SA(b, h) + aoff + m * 2048 + k * 1024); } } } while (0)
#define PG8_LDB(dst, b, h) do { _Pragma("unroll") for (int n = 0; n < 2; ++n) { if constexpr (FP8) dst##8[n] = __builtin_shufflevector(*(const LAS i32x4*)(lds + PG8_SB(b, h) + boff + n * 2048), *(const LAS i32x4*)(lds + PG8_SB(b, h) + boff + n * 2048 + 1024), 0, 1, 2, 3, 4, 5, 6, 7); \
        else { _Pragma("unroll") for (int k = 0; k < 2; ++k) dst[n][k] = *(const LAS bf16x8*)(lds + PG8_SB(b, h) + boff + n * 2048 + k * 1024); } } } while (0)
#define PG8_MMA(ai, bj, At, Bt) do { __builtin_amdgcn_s_setprio(1); _Pragma("unroll") for (int m = 0; m < 4; ++m) _Pragma("unroll") for (int n = 0; n < 2; ++n) { \
        if constexpr (FP8) { acc[ai][bj][m][n] = __builtin_amdgcn_mfma_scale_f32_16x16x128_f8f6f4(Bt##8[n], At##8[m], acc[ai][bj][m][n], 0, 0, 0, 0, 0, 0); } \
        else { _Pragma("unroll") for (int k = 0; k < 2; ++k) acc[ai][bj][m][n] = __builtin_amdgcn_mfma_f32_16x16x32_bf16(Bt[n][k], At[m][k], acc[ai][bj][m][n], 0, 0, 0); } } \
        __builtin_amdgcn_s_setprio(0); } while (0)
#define PG8_WAIT_V(n) asm volatile("s_waitcnt vmcnt(" #n ")" ::: "memory")
#define PG8_WAIT_L(n) asm volatile("s_waitcnt lgkmcnt(" #n ")" ::: "memory")
#define PG8_BAR __builtin_amdgcn_s_barrier()
#define PG8_SCHED __builtin_amdgcn_sched_barrier(0)
    Unit cur, nxt; int ui = 0;
    if (!S.next(0, cur)) return;
    Acc acc;
    {
#pragma unroll
    for (int a = 0; a < 2; ++a)
#pragma unroll
        for (int b = 0; b < 2; ++b)
#pragma unroll
            for (int m = 0; m < 4; ++m)
#pragma unroll
                for (int n = 0; n < 2; ++n) acc[a][b][m][n] = (f32x4){0.f, 0.f, 0.f, 0.f}; }
    bf16x8 At[4][2], B0[2][2], B1[2][2];
    i32x8 At8[4], B08[2], B18[2];
    typedef const GAS char* gcc_t;
    gcc_t cA = (gcc_t)g.A + (size_t)cur.pm * tstepA; gcc_t cB = (gcc_t)g.Bt + (size_t)cur.pb * tstepB + (VARK ? (size_t)cur.kt0 * kstep : 0);
    {
        gcc_t a0 = cA + (size_t)KA::koff(cur, 0) * 2; gcc_t a1 = cA + (size_t)KA::koff(cur, 1) * 2;
        PG8_STAGE(PG8_SB(0, 0), cB, voffB); PG8_STAGE(PG8_SB(0, 1), cB + hstepB, voffB); PG8_STAGE(PG8_SA(0, 0), a0, voffA); PG8_STAGE(PG8_SA(0, 1), a0 + hstepA, voffA);
        if (wr == 1) PG8_BAR;
        PG8_WAIT_V(2); PG8_BAR;
        PG8_STAGE(PG8_SB(1, 0), cB + kstep, voffB); PG8_STAGE(PG8_SA(1, 0), a1, voffA); PG8_STAGE(PG8_SB(1, 1), cB + hstepB + kstep, voffB);
        PG8_WAIT_V(6); PG8_BAR;
    }
    for (;;) {
        const bool has_next = S.next(ui + 1, nxt);
        if (!has_next) nxt = cur;
        gcc_t nA = has_next ? (gcc_t)g.A + (size_t)nxt.pm * tstepA : cA; gcc_t nB = has_next ? (gcc_t)g.Bt + (size_t)nxt.pb * tstepB + (VARK ? (size_t)nxt.kt0 * kstep : 0) : cB;
        const int ntc = VARK ? cur.ntu : nt;
#pragma unroll 1
        for (int t = 0; t < ntc; t += 2) {
            const bool last = (t == ntc - 2);
            gcc_t a1 = cA + (size_t)KA::koff(cur, t + 1) * 2;
            gcc_t a2 = last ? nA + (size_t)KA::koff(nxt, 0) * 2 : cA + (size_t)KA::koff(cur, t + 2) * 2;
            gcc_t a3 = last ? nA + (size_t)KA::koff(nxt, 1) * 2 : cA + (size_t)KA::koff(cur, t + 3) * 2;
            gcc_t b2 = last ? nB : cB + (size_t)(t + 2) * kstep; gcc_t b3 = b2 + kstep;
            if constexpr (Epi::HAS_MID) { if (t == Epi::MID_T) { const int te = hw_tid(wave_); E.mid(acc, cur, wr, wc, te & 15, (te >> 4) & 3); } }
            if constexpr (Epi::Pre::HAS_PRE) { if (t == 0) E.pre.issue(cur, hw_tid(wave_), wid); if (t == 2) E.pre.finish(hw_tid(wave_)); }
            PG8_LDB(B0, 0, 0); PG8_LDB(B1, 0, 1); PG8_SCHED; PG8_LDA(At, 0, 0); PG8_STAGE(PG8_SA(1, 1), a1 + hstepA, voffA);
            PG8_WAIT_V(8); PG8_WAIT_L(0); PG8_BAR; PG8_MMA(0, 0, At, B0); PG8_MMA(0, 1, At, B1); PG8_BAR; PG8_SCHED;
            PG8_LDA(At, 0, 1); PG8_STAGE(PG8_SB(0, 0), b2, voffB); PG8_STAGE(PG8_SB(0, 1), b2 + hstepB, voffB); PG8_STAGE(PG8_SA(0, 0), a2, voffA);
            PG8_WAIT_V(8); PG8_WAIT_L(0); PG8_BAR; PG8_MMA(1, 0, At, B0); PG8_MMA(1, 1, At, B1); PG8_BAR; PG8_SCHED;
            PG8_LDB(B0, 1, 0); PG8_LDB(B1, 1, 1); PG8_SCHED; PG8_LDA(At, 1, 0); PG8_STAGE(PG8_SA(0, 1), a2 + hstepA, voffA);
            PG8_WAIT_V(8); PG8_WAIT_L(0); PG8_BAR; PG8_MMA(0, 0, At, B0); PG8_MMA(0, 1, At, B1); PG8_BAR; PG8_SCHED;
            PG8_LDA(At, 1, 1); PG8_STAGE(PG8_SB(1, 0), b3, voffB); PG8_STAGE(PG8_SB(1, 1), b3 + hstepB, voffB); PG8_STAGE(PG8_SA(1, 0), a3, voffA);
            PG8_WAIT_V(8); PG8_WAIT_L(0); PG8_BAR; PG8_MMA(1, 0, At, B0); PG8_MMA(1, 1, At, B1); PG8_BAR; PG8_SCHED;
        }
        if (wr == 0) PG8_BAR;
        { const int te = hw_tid(wave_); E(acc, cur, wr, wc, te & 15, (te >> 4) & 3); }
        if (!has_next) break;
        const LAS char* zp = (const LAS char*)(lds + RING_BYTES + 12288) + (hw_tid(wave_) & 63) * 16;
#pragma unroll
        for (int a = 0; a < 2; ++a)
#pragma unroll
            for (int b = 0; b < 2; ++b)
#pragma unroll
                for (int m = 0; m < 4; ++m)
#pragma unroll
                    for (int n = 0; n < 2; ++n) acc[a][b][m][n] = *(const LAS f32x4*)(zp + (((a * 2 + b) * 4 + m) * 2 + n) * 16);
        cur = nxt; cA = nA; cB = nB; ++ui;
        if (wr == 1) PG8_BAR;
    }
    PG8_WAIT_V(0);
    PG8_BAR;
#undef PG8_SA
#undef PG8_SB
#undef PG8_STAGE
#undef PG8_LDA
#undef PG8_LDB
#undef PG8_MMA
#undef PG8_WAIT_V
#undef PG8_WAIT_L
#undef PG8_BAR
#undef PG8_SCHED
}
}

#define XB_TMO      128
#define XB_XCNT(j)  (256  + 64 * (j))
#define XB_XSUB(j)  (1280 + 64 * (j))
#define XB_XGEN(j)  (2304 + 64 * (j))
#define XB_TOP      3328
#define XB_TOPGEN   3392
#define XCD_BAR_WORDS 3456
#define XB_SPIN_CAP (1u << 18)
__device__ __forceinline__ unsigned xb_ld(gu32* p)              { return __hip_atomic_load(p, __ATOMIC_RELAXED, __HIP_MEMORY_SCOPE_AGENT); }
__device__ __forceinline__ unsigned xb_add(gu32* p, unsigned v) { return __hip_atomic_fetch_add(p, v, __ATOMIC_RELAXED, __HIP_MEMORY_SCOPE_AGENT); }
__device__ __forceinline__ unsigned xb_xcc_id() { return (unsigned)__builtin_amdgcn_s_getreg((3 << 11) | 20) & 0xFu; }
#define XB_SPIN(cond, bar) do { unsigned _sp = 0; while (cond) { __builtin_amdgcn_s_sleep(1); \
    if ((++_sp & 255u) == 0u) { if (xb_ld(&(bar)[XB_TMO])) break; if (_sp > XB_SPIN_CAP) { (void)xb_add(&(bar)[XB_TMO], 1u); break; } } } } while (0)
struct XcdBarrier { gu32* bar; unsigned x; volatile LAS unsigned* st; };
__device__ __forceinline__ XcdBarrier xcd_barrier_post(gu32* bar, volatile LAS unsigned* st, int tid) {
    XcdBarrier b; b.bar = bar; b.x = xb_xcc_id(); b.st = st;
    if (tid == 0) (void)xb_add(&bar[XB_XCNT(b.x)], 1u);
    return b;
}
__device__ __forceinline__ void xcd_barrier_complete(gu32* bar, unsigned x, unsigned& nloc, unsigned& nx) {
    const unsigned G = gridDim.x * gridDim.y * gridDim.z;
    unsigned sum, cnt, mine, sp = 0u;
    for (;;) {
        sum = 0u; cnt = 0u; mine = 0u;
#pragma unroll
        for (unsigned j = 0; j < 16; ++j) { const unsigned c = xb_ld(&bar[XB_XCNT(j)]); sum += c; cnt += (c > 0u) ? 1u : 0u; mine = (j == x) ? c : mine; }
        if (sum == G) break;
        __builtin_amdgcn_s_sleep(1);
        if ((++sp & 255u) == 0u) { if (xb_ld(&bar[XB_TMO])) break; if (sp > XB_SPIN_CAP) { (void)xb_add(&bar[XB_TMO], 1u); break; } }
    }
    nloc = mine > 0u ? mine : 1u; nx = cnt > 0u ? cnt : 1u;
}
__device__ __forceinline__ void xcd_barrier(const XcdBarrier& b, int tid) {
    asm volatile("s_waitcnt vmcnt(0)" ::: "memory");
    __syncthreads();
    if (tid == 0) {
        gu32* bar = b.bar;
        __builtin_amdgcn_s_waitcnt(0);
        unsigned nloc = b.st[0], nx = b.st[1];
        if (nloc == 0u) { xcd_barrier_complete(bar, b.x, nloc, nx); b.st[0] = nloc; b.st[1] = nx; }
        const unsigned old = xb_add(&bar[XB_XSUB(b.x)], 1u);
        const unsigned gen = old / nloc;
        if (old + 1u == (gen + 1u) * nloc) {
            __builtin_amdgcn_fence(__ATOMIC_RELEASE, "agent");
            asm volatile("s_waitcnt vmcnt(0)" ::: "memory");
            const unsigned og = xb_add(&bar[XB_TOP], 1u);
            const unsigned tg = og / nx;
            if (og + 1u == (tg + 1u) * nx) xb_add(&bar[XB_TOPGEN], 1u);
            else XB_SPIN(xb_ld(&bar[XB_TOPGEN]) == tg, bar);
            __builtin_amdgcn_fence(__ATOMIC_ACQUIRE, "agent");
            asm volatile("s_waitcnt vmcnt(0)" ::: "memory");
        } else {
            XB_SPIN(xb_ld(&bar[XB_TOPGEN]) == gen, bar);
            __builtin_amdgcn_fence(__ATOMIC_ACQUIRE, "agent");
            asm volatile("s_waitcnt vmcnt(0)" ::: "memory");
        }
    }
    __syncthreads();
}

struct Args { const float* in[20]; float* out; unsigned char* ws; int ph_lo, ph_hi; };
enum { I_X = 0, I_MIXN, I_WIN, I_CDW, I_CDWB, I_CLNG, I_CLNB, I_WCO, I_WPOOL, I_PSC, I_WOUT, I_FFNN, I_DG, I_DU, I_DD, I_RW, I_MG, I_MU, I_MD, I_FIN };

typedef const float* cfp_t;
typedef __attribute__((address_space(4))) const char* kptr_t;
struct Frame {
    LAS unsigned char* lds;
    kptr_t kp; gf_t out; GAS unsigned char* ws;
    int tid, lane, wave, G, bid;
};
struct InPtrs { kptr_t kp;
    __device__ __forceinline__ explicit InPtrs(const Frame& F) : kp(F.kp) { asm volatile("" : "+s"(kp)); }
    __device__ __forceinline__ gcf_t operator[](int k) const { return (gcf_t)((__attribute__((address_space(4))) const cfp_t*)kp)[k]; } };
__device__ __forceinline__ gbf_t wsb(const Frame& F, size_t off) { return (gbf_t)(F.ws + off); }
__device__ __forceinline__ gf_t wsf(const Frame& F, size_t off) { return (gf_t)(F.ws + off); }
__device__ __forceinline__ gu_t wsu(const Frame& F, size_t off) { return (gu_t)(F.ws + off); }


__device__ __forceinline__ float rdl(float v, int l) { return __int_as_float(__builtin_amdgcn_readlane(__float_as_int(v), l)); }
template <bool FP8>
__device__ __forceinline__ void cvt_item(gcf_t W, int N, int k0, int n0, GAS void* dstv, int ldd, int drow0, int dcol0, gcf_t sk, gcf_t sn, float mul, LAS unsigned* scr, int lane) {
    const float sN = (sn ? sn[n0 + lane] : 1.0f) * mul;
    gcf_t src = W + (size_t)k0 * N + n0 + lane;
    gcf_t skp = sk ? sk + k0 : src; const float g0 = skp[lane], g1 = FP8 ? skp[64 + lane] : 0.f; (void)g1;
    if constexpr (!FP8) {
        gbf_t dst = (gbf_t)dstv;
#pragma unroll
        for (int h = 0; h < 2; ++h) { float v[32];
#pragma unroll
            for (int i = 0; i < 32; ++i) v[i] = src[(size_t)(32 * h + i) * N];
#pragma unroll
            for (int i = 0; i < 16; ++i) { float a = v[2 * i], b = v[2 * i + 1]; if (sk) { a *= rdl(g0, 32 * h + 2 * i); b *= rdl(g0, 32 * h + 2 * i + 1); }
                scr[lane * 33 + 16 * h + i] = cvt_pk_bf16(a * sN, b * sN); } }
    } else {
#pragma unroll
        for (int h = 0; h < 4; ++h) { float v[32]; const float gh = h < 2 ? g0 : g1; const int gb = 32 * (h & 1);
#pragma unroll
            for (int i = 0; i < 32; ++i) v[i] = src[(size_t)(32 * h + i) * N];
#pragma unroll
            for (int i = 0; i < 8; ++i) { float a = v[4 * i], b = v[4 * i + 1], c = v[4 * i + 2], d = v[4 * i + 3];
                if (sk) { a *= rdl(gh, gb + 4 * i); b *= rdl(gh, gb + 4 * i + 1); c *= rdl(gh, gb + 4 * i + 2); d *= rdl(gh, gb + 4 * i + 3); }
                int w = __builtin_amdgcn_cvt_pk_fp8_f32(a * sN, b * sN, 0, false); w = __builtin_amdgcn_cvt_pk_fp8_f32(c * sN, d * sN, w, true);
                scr[lane * 33 + 8 * h + i] = (unsigned)w; } }
    }
    LDS_WAIT(); asm volatile("" ::: "memory");
    {
        GAS unsigned char* dst = (GAS unsigned char*)dstv; const int c = lane & 7; const int esz = FP8 ? 1 : 2;
#pragma unroll
        for (int q = 0; q < 8; ++q) { const int j = (lane >> 3) + 8 * q; const LAS unsigned* s = scr + j * 33 + 4 * c;
            u32x4 o; o.x = s[0]; o.y = s[1]; o.z = s[2]; o.w = s[3];
            ST4U(dst + ((size_t)(drow0 + j) * ldd + dcol0 + k0) * esz + 16 * c) = o; }
    }
    LDS_WAIT(); asm volatile("" ::: "memory");
}
__device__ __forceinline__ int gu_row(int n0, int up) { return 256 * (n0 >> 7) + (n0 & 127) + 128 * up; }
__device__ __forceinline__ int win_row(int n0) {
    if (n0 < 512) return gu_row(n0, 0);
    if (n0 < 1024) return gu_row(n0 - 512, 1);
    if (n0 < 1536) return n0;
    if (n0 < 2560) return 1536 + gu_row(n0 - 1536, 0);
    return 1536 + gu_row(n0 - 2560, 1);
}
constexpr int IT_WIN = 16 * 56, IT_WCO = 8 * 16, IT_WPOOL = 2 * 4, IT_WOUT = 16 * 16, IT_DGU = 16 * 44, IT_DD = 44 * 16;
constexpr int NIT_A = DEPTH * IT_WIN, NIT_B = DEPTH * IT_WCO, NIT_C = DEPTH * 4 * IT_WPOOL, NIT_D = DEPTH * IT_WOUT, NIT_E = 2 * IT_DGU, NIT_E3 = 2 * IT_DD;
constexpr int NIT_PRO = (2 * IT_WIN + IT_WIN) + NIT_B + NIT_C + (2 * IT_WOUT + IT_WOUT) + (2 * IT_DGU + IT_DD) + (IT_DGU + IT_DD / 2);
constexpr int IT_MGU = 8 * 56, IT_MD = 28 * 16, NIT_MOE = NEXP * (2 * IT_MGU + IT_MD);
__device__ __forceinline__ void cvt_pro_item(const Frame& F, const InPtrs& IN, int r, LAS unsigned* scr) {
    if (r < 2 * IT_WIN) { const int L = r / IT_WIN, q = r % IT_WIN, kb = q / 56, nb = q % 56;
        cvt_item<false>(IN[I_WIN] + (size_t)L * DM * IN_COLS, IN_COLS, kb * 64, nb * 64, wsb(F, WS_WIN) + (size_t)L * IN_COLS * DM, DM, win_row(nb * 64), 0, IN[I_MIXN] + L * DM, nullptr, 1.0f, scr, F.lane); return; } r -= 2 * IT_WIN;
    if (r < IT_WIN) { const int L = 2 + r / (IT_WIN / 2), q = r % (IT_WIN / 2), kb = q / 56, nb = q % 56;
        cvt_item<true>(IN[I_WIN] + (size_t)L * DM * IN_COLS, IN_COLS, kb * 128, nb * 64, F.ws + WS_WIN8 + (size_t)(L - 2) * IN_COLS * DM, DM, win_row(nb * 64), 0, IN[I_MIXN] + L * DM, nullptr, 32.0f, scr, F.lane); return; } r -= IT_WIN;
    if (r < NIT_B) { const int L = r / IT_WCO, q = r % IT_WCO, kb = q / 16, nb = q % 16;
        cvt_item<false>(IN[I_WCO] + (size_t)L * CONV_DIM * DM, DM, kb * 64, nb * 64, wsb(F, WS_WM) + (size_t)L * DM * 640, 640, nb * 64, 0, nullptr, nullptr, 1.0f, scr, F.lane); return; } r -= NIT_B;
    if (r < NIT_C) { const int Lg = r / IT_WPOOL, q = r % IT_WPOOL, kb = q / 4, nb = q % 4, L = Lg >> 2, g = Lg & 3;
        cvt_item<false>(IN[I_WPOOL] + (size_t)Lg * 128 * 256, 256, kb * 64, nb * 64, wsb(F, WS_WM) + (size_t)L * DM * 640, 640, 256 * g + nb * 64, 512, nullptr, IN[I_PSC] + L * DM + 256 * g, 1.0f, scr, F.lane); return; } r -= NIT_C;
    if (r < 2 * IT_WOUT) { const int L = r / IT_WOUT, q = r % IT_WOUT, kb = q / 16, nb = q % 16;
        cvt_item<false>(IN[I_WOUT] + (size_t)L * DM * DM, DM, kb * 64, nb * 64, wsb(F, WS_WOUT) + (size_t)L * DM * DM, DM, nb * 64, 0, nullptr, nullptr, 1.0f, scr, F.lane); return; } r -= 2 * IT_WOUT;
    if (r < IT_WOUT) { const int L = 2 + r / (IT_WOUT / 2), q = r % (IT_WOUT / 2), kb = q / 16, nb = q % 16;
        cvt_item<true>(IN[I_WOUT] + (size_t)L * DM * DM, DM, kb * 128, nb * 64, F.ws + WS_WOUT + (size_t)L * DM * DM * 2, DM, nb * 64, 0, nullptr, nullptr, 32.0f, scr, F.lane); return; } r -= IT_WOUT;
    if (r < 2 * IT_DGU) { const int up = r / IT_DGU, q = r % IT_DGU, kb = q / 44, nb = q % 44;
        cvt_item<false>((up ? IN[I_DU] : IN[I_DG]), DFF, kb * 64, nb * 64, wsb(F, WS_DGU), DM, gu_row(nb * 64, up), 0, IN[I_FFNN], nullptr, 1.0f, scr, F.lane); return; } r -= 2 * IT_DGU;
    if (r < IT_DD) { const int kb = r / 16, nb = r % 16;
        cvt_item<false>(IN[I_DD], DM, kb * 64, nb * 64, wsb(F, WS_DD), DFF, nb * 64, 0, nullptr, nullptr, 1.0f, scr, F.lane); return; } r -= IT_DD;
    if (r < IT_DGU) { const int up = r / (IT_DGU / 2), q = r % (IT_DGU / 2), kb = q / 44, nb = q % 44;
        cvt_item<true>((up ? IN[I_DU] : IN[I_DG]) + (size_t)DM * DFF, DFF, kb * 128, nb * 64, F.ws + WS_DGU8, DM, gu_row(nb * 64, up), 0, IN[I_FFNN] + 2 * DM, nullptr, 32.0f, scr, F.lane); return; } r -= IT_DGU;
    { const int kb = r / 16, nb = r % 16;
        cvt_item<true>(IN[I_DD] + (size_t)DFF * DM, DM, kb * 128, nb * 64, F.ws + WS_DD8, DFF, nb * 64, 0, nullptr, nullptr, 64.0f, scr, F.lane); }
}
__device__ __forceinline__ void cvt_moe_item(const Frame& F, const InPtrs& IN, int r, LAS unsigned* scr) {
    const int ie = r / (2 * IT_MGU + IT_MD), i = ie >> 3; int q = r % (2 * IT_MGU + IT_MD);
    if (q < 2 * IT_MGU) { const int up = q / IT_MGU; q %= IT_MGU; const int kb = q / 56, nb = q % 56;
        cvt_item<true>((up ? IN[I_MU] : IN[I_MG]) + (size_t)ie * DM * DFFE, DFFE, kb * 128, nb * 64, F.ws + WS_MGU + (size_t)ie * 2 * DFFE * DM, DM, gu_row(nb * 64, up), 0, IN[I_FFNN] + (2 * i + 1) * DM, nullptr, 32.0f, scr, F.lane); return; }
    q -= 2 * IT_MGU; { const int kb = q / 16, nb = q % 16;
        cvt_item<true>(IN[I_MD] + (size_t)ie * DFFE * DM, DM, kb * 128, nb * 64, F.ws + WS_MD + (size_t)ie * DM * DFFE, DFFE, nb * 64, 0, nullptr, nullptr, 64.0f, scr, F.lane); }
}
__device__ __forceinline__ void cvt_moe_layers(const Frame& F) {
    LAS unsigned* scr = (LAS unsigned*)(F.lds + F.wave * 8448);
    const int gw = F.bid * NWAVES + F.wave, NGW = F.G * NWAVES;
    const InPtrs IN(F);
    for (int it = gw; it < 2 * NIT_MOE; it += NGW) cvt_moe_item(F, IN, it, scr);
}

__device__ __forceinline__ void p_prologue(const Frame& F) {
    LAS unsigned* scr = (LAS unsigned*)(F.lds + F.wave * 8448);
    const int gw = F.bid * NWAVES + F.wave, NGW = F.G * NWAVES;
    const InPtrs IN(F);
    for (int it = gw; it < NIT_PRO; it += NGW) cvt_pro_item(F, IN, it, scr);
    gcf_t x = IN[I_X]; gbf_t xb = wsb(F, WS_XB); gf_t ssq4 = wsf(F, WS_SSQ4);
    for (int t0 = gw * 4; t0 < NTOK; t0 += NGW * 4) {
        f32x4 v[4][4];
#pragma unroll
        for (int q = 0; q < 4; ++q)
#pragma unroll
            for (int j = 0; j < 4; ++j) v[q][j] = *((const GAS f32x4*)(x + (size_t)(t0 + q) * DM) + F.lane + 64 * j);
#pragma unroll
        for (int q = 0; q < 4; ++q) { GAS u32x2* o = (GAS u32x2*)(xb + (size_t)(t0 + q) * DM) + F.lane; float ss = 0.f;
#pragma unroll
            for (int j = 0; j < 4; ++j) { const f32x4 w4 = v[q][j]; ss += (w4[0] * w4[0] + w4[1] * w4[1]) + (w4[2] * w4[2] + w4[3] * w4[3]); u32x2 w; w.x = cvt_pk_bf16(w4[0], w4[1]); w.y = cvt_pk_bf16(w4[2], w4[3]); o[64 * j] = w; }
            ss = wave_sum_l(ss, F.lane);
            if (F.lane < 4) ssq4[(size_t)F.lane * NTOK + t0 + q] = F.lane == 0 ? ss : 0.f; }
    }
    cvt_moe_layers(F);
}

__device__ __forceinline__ float bf1(bf16_t v) { return __uint_as_float((unsigned)v << 16); }
__device__ __forceinline__ bf16_t f2bf(float f) { return (bf16_t)(cvt_pk_bf16(f, 0.f) & 0xffffu); }
template <int CTRL> __device__ __forceinline__ float dppx(float v) { return __int_as_float(__builtin_amdgcn_update_dpp(0, __float_as_int(v), CTRL, 0xf, 0xf, true)); }
__device__ __forceinline__ void p_cp(const Frame& F, int L) {
    const int ch = F.tid, lane = F.lane, wv = F.wave;
    const GAS char* Ub = (const GAS char*)(F.ws + WS_U); const GAS char* Pb = (const GAS char*)(F.ws + WS_P); GAS char* Sb = (GAS char*)(F.ws + WS_SD);
    const unsigned ch2 = (unsigned)ch * 2u, lane16 = (unsigned)lane * 16u, lds0 = (unsigned)(size_t)F.lds;
    constexpr unsigned CP_IN = 0u, CP_OUT = 65536u, CP_HIST = 65536u;
#define CP_DMA(gptr, ldsoff) do { unsigned keep_; asm volatile("s_mov_b32 %0, m0\n\ts_mov_b32 m0, %3\n\ts_nop 0\n\tglobal_load_lds_dwordx4 %1, %2\n\ts_mov_b32 m0, %0" : "=&s"(keep_) : "v"(lane16), "s"(pg8::uni64((const GAS char*)(gptr))), "s"(lds0 + (unsigned)(ldsoff)) : "memory"); } while (0)
#define CP_ST16(gptr, voff, val) (*(GAS u32x4*)((GAS char*)(gptr) + (voff)) = (val))
#define LDSU16(off) ((unsigned)*(const LAS unsigned short*)(F.lds + (off)))
#define LDW(ptr, row) (*(const GAS float*)((const GAS char*)(ptr) + ((unsigned)(row) * (CONV_DIM * 4u) + ch2 * 2u)))
    const InPtrs IN(F);
    LAS float* red = (LAS float*)(F.lds + STAB_OFF);
    const int idx = ((lane >> 3) & 1) + 2 * ((lane >> 2) & 1) + 4 * ((lane >> 1) & 1) + 8 * (lane & 1);
    const bool b0 = lane & 1, b1 = lane & 2, b2 = lane & 4, b3 = lane & 8;
    const int g = F.wave >> 1, win = 2 << g;
    for (int chunk = F.bid; chunk < NTOK / 128; chunk += F.G) {
        const int r0 = chunk * 128, ts0 = r0 & (SEQ - 1);
        const unsigned hmask = ts0 != 0 ? 0xffffffffu : 0u; const int rh = ts0 != 0 ? r0 : r0 + 32;
#pragma unroll
        for (int k = 0; k < 6; ++k) { const int sidx = wv + 8 * k; const int pr = sidx - 30 < 14 ? sidx - 30 : 14;
            const GAS char* src = sidx < 30 ? Ub + (unsigned)(rh - 30 + sidx) * 1024u : Pb + (unsigned)(rh - 15 + pr) * 1024u;
            CP_DMA(src, CP_HIST + (unsigned)sidx * 1024u); }
#pragma unroll
        for (int q = 0; q < 2; ++q) { CP_DMA(Ub + (unsigned)(r0 + 8 * q + wv) * 1024u, CP_IN + (unsigned)q * 16384u + (unsigned)wv * 1024u); CP_DMA(Pb + (unsigned)(r0 + 8 * q + wv) * 1024u, CP_IN + (unsigned)q * 16384u + (unsigned)(8 + wv) * 1024u); }
        float w[CONV_W];
#pragma unroll
        for (int j = 0; j < CONV_W; ++j) w[j] = LDW(IN[I_CDW], L * CONV_W + j);
        const float cb = LDW(IN[I_CDWB], L), lg = LDW(IN[I_CLNG], L), lb = LDW(IN[I_CLNB], L);
        asm volatile("s_waitcnt vmcnt(0)" ::: "memory"); __syncthreads();
        {
            float cb_ = cb, lg_ = lg, lb_ = lb;
#pragma unroll
            for (int j = 0; j < CONV_W; ++j) asm volatile("" : "+v"(w[j]));
            asm volatile("" : "+v"(cb_), "+v"(lg_), "+v"(lb_)); (void)cb_; (void)lg_; (void)lb_; }
        float u[38];
#pragma unroll
        for (int i = 0; i < 30; ++i) u[i] = __uint_as_float((LDSU16(CP_HIST + (unsigned)i * 1024u + ch2) << 16) & hmask);
        float plast, h2[2], h4[4], h8[8];
        { float ph[15], T2[15], T4[13];
#pragma unroll
          for (int i = 0; i < 15; ++i) ph[i] = __uint_as_float((LDSU16(CP_HIST + (unsigned)(30 + i) * 1024u + ch2) << 16) & hmask);
#pragma unroll
          for (int k = 1; k <= 14; ++k) T2[k] = ph[15 - k] + ph[14 - k];
#pragma unroll
          for (int k = 1; k <= 12; ++k) T4[k] = T2[k] + T2[k + 2];
          h2[0] = T2[2]; h2[1] = T2[1];
#pragma unroll
          for (int o = 0; o < 4; ++o) h4[o] = T4[4 - o];
#pragma unroll
          for (int o = 0; o < 8; ++o) h8[o] = T4[8 - o] + T4[12 - o];
          plast = ph[14]; }
#define CP_SUBBLOCK(sb, BUF) do { \
            const int rb = r0 + 8 * (sb), sn = (sb) + 2 < 16 ? (sb) + 2 : 15; \
            const unsigned stg = CP_IN + (unsigned)((sb) & 3) * 16384u, stn = CP_IN + (unsigned)(((sb) + 2) & 3) * 16384u, outw = CP_OUT + (unsigned)((sb) & 1) * 16384u, outr = CP_OUT + (unsigned)(((sb) + 1) & 1) * 16384u; \
            asm volatile("s_waitcnt vmcnt(4) lgkmcnt(0)" ::: "memory"); \
            __builtin_amdgcn_s_barrier(); asm volatile("" ::: "memory");     \
            if ((sb) > 0) { const LAS char* orow = (const LAS char*)(F.lds + outr + (unsigned)wv * 2048u + lane16); const u32x4 o0 = *(const LAS u32x4*)orow, o1 = *(const LAS u32x4*)(orow + 1024); \
                GAS char* drow = Sb + (unsigned)(rb - 8 + wv) * 2048u; CP_ST16(drow, lane16, o0); CP_ST16(drow, lane16 + 1024u, o1); } \
            CP_DMA(Ub + (unsigned)(r0 + 8 * sn + wv) * 1024u, stn + (unsigned)wv * 1024u); CP_DMA(Pb + (unsigned)(r0 + 8 * sn + wv) * 1024u, stn + (unsigned)(8 + wv) * 1024u); \
            float pc[8]; \
            _Pragma("unroll") for (int o = 0; o < 8; ++o) { u[30 + o] = __uint_as_float(LDSU16(stg + (unsigned)o * 1024u + ch2) << 16); pc[o] = __uint_as_float(LDSU16(stg + (unsigned)(8 + o) * 1024u + ch2) << 16); } \
            float v[8], a[16]; \
            _Pragma("unroll") for (int o = 0; o < 8; ++o) { float s_ = cb; \
                _Pragma("unroll") for (int j = 0; j < CONV_W; ++j) s_ += w[j] * u[o + j]; \
                v[o] = s_; a[o] = s_; a[8 + o] = s_ * s_; } \
            _Pragma("unroll") for (int i = 0; i < 8; ++i) { const float keep = b0 ? a[i + 8] : a[i], send = b0 ? a[i] : a[i + 8]; a[i] = keep + dppx<0xB1>(send); } \
            _Pragma("unroll") for (int i = 0; i < 4; ++i) { const float keep = b1 ? a[i + 4] : a[i], send = b1 ? a[i] : a[i + 4]; a[i] = keep + dppx<0x4E>(send); } \
            _Pragma("unroll") for (int i = 0; i < 2; ++i) { const float keep = b2 ? a[i + 2] : a[i], send = b2 ? a[i] : a[i + 2]; a[i] = keep + dppx<0x124>(send); } \
            { const float keep = b3 ? a[1] : a[0], send = b3 ? a[0] : a[1]; a[0] = keep + dppx<0x128>(send); } \
            a[0] += shx<16>(a[0], lane); a[0] += shx<32>(a[0], lane);       \
            LAS float* rb_ = red + (BUF) * 128; \
            if (lane < 16) rb_[idx * 8 + wv] = a[0]; \
              \
            { float sw[8]; \
              _Pragma("unroll") for (int o = 0; o < 8; ++o) sw[o] = pc[o] + (o ? pc[o > 0 ? o - 1 : 0] : plast); \
              plast = pc[7]; \
              if (g >= 1) { float t4[8]; \
                  _Pragma("unroll") for (int o = 0; o < 8; ++o) t4[o] = sw[o] + (o >= 2 ? sw[o >= 2 ? o - 2 : 0] : h2[o & 1]); \
                  h2[0] = sw[6]; h2[1] = sw[7]; \
                  _Pragma("unroll") for (int o = 0; o < 8; ++o) sw[o] = t4[o]; \
                  if (g >= 2) { float t8[8]; \
                      _Pragma("unroll") for (int o = 0; o < 8; ++o) t8[o] = t4[o] + (o >= 4 ? t4[o >= 4 ? o - 4 : 0] : h4[o & 3]); \
                      _Pragma("unroll") for (int o = 0; o < 4; ++o) h4[o] = t4[4 + o]; \
                      _Pragma("unroll") for (int o = 0; o < 8; ++o) sw[o] = t8[o]; \
                      if (g >= 3) { _Pragma("unroll") for (int o = 0; o < 8; ++o) { sw[o] = t8[o] + h8[o]; h8[o] = t8[o]; } } } } \
              _Pragma("unroll") for (int o = 0; o < 8; ++o) { const int ts = ts0 + 8 * (sb) + o; const float inv = __builtin_amdgcn_rcpf((float)((ts + 1) < win ? (ts + 1) : win)); \
                  *(LAS bf16_t*)(F.lds + outw + (unsigned)o * 2048u + ch2) = f2bf(sw[o] * inv - pc[o]); } } \
            LDS_WAIT(); __builtin_amdgcn_s_barrier(); asm volatile("" ::: "memory");     \
              \
            float mean_l, rstd_l; \
            { const LAS float* rp = rb_ + (lane & 7) * 8; const f32x4 s0 = *(const LAS f32x4*)(rp), s1 = *(const LAS f32x4*)(rp + 4), q0 = *(const LAS f32x4*)(rp + 64), q1 = *(const LAS f32x4*)(rp + 68); \
              mean_l = (((s0[0] + s0[1]) + (s0[2] + s0[3])) + ((s1[0] + s1[1]) + (s1[2] + s1[3]))) * (1.0f / CONV_DIM); \
              const float ex2 = (((q0[0] + q0[1]) + (q0[2] + q0[3])) + ((q1[0] + q1[1]) + (q1[2] + q1[3]))) * (1.0f / CONV_DIM); \
              rstd_l = __builtin_amdgcn_rsqf(__builtin_fmaxf(ex2 - mean_l * mean_l, 0.f) + LN_EPS); } \
            _Pragma("unroll") for (int o = 0; o < 8; ++o) { const float mean = rdl(mean_l, o), rstd = rdl(rstd_l, o); \
                const float y = (v[o] - mean) * rstd * lg + lb; \
                *(LAS bf16_t*)(F.lds + outw + (unsigned)o * 2048u + 1024u + ch2) = f2bf(y * __builtin_amdgcn_rcpf(1.0f + __builtin_amdgcn_exp2f(y * -1.4426950408889634f))); } \
            _Pragma("unroll") for (int i = 0; i < 30; ++i) u[i] = u[i + 8]; } while (0)
#pragma unroll 1
        for (int sb = 0; sb < 16; sb += 2) { CP_SUBBLOCK(sb, 0); CP_SUBBLOCK(sb + 1, 1); }
#undef CP_SUBBLOCK
        LDS_WAIT(); __builtin_amdgcn_s_barrier(); asm volatile("" ::: "memory");
        { const LAS char* orow = (const LAS char*)(F.lds + CP_OUT + 16384u + (unsigned)wv * 2048u + lane16); const u32x4 o0 = *(const LAS u32x4*)orow, o1 = *(const LAS u32x4*)(orow + 1024);
          GAS char* drow = Sb + (unsigned)(r0 + 120 + wv) * 2048u; CP_ST16(drow, lane16, o0); CP_ST16(drow, lane16 + 1024u, o1); }
        asm volatile("s_waitcnt vmcnt(0)" ::: "memory"); __syncthreads();
    }
#undef CP_DMA
#undef CP_ST16
#undef LDSU16
#undef LDW
}

__device__ __forceinline__ void p_r1(const Frame& F, int i, int L) {
    LAS u32x4* WH = (LAS u32x4*)F.lds; LAS u32x4* WL = (LAS u32x4*)(F.lds + 32768);
    LAS unsigned* cntw = (LAS unsigned*)(F.lds + 65536);
    gcbf_t x = wsb(F, WS_XB); const int lane = F.lane, w = F.wave;
    const InPtrs IN(F);
#pragma unroll 1
    for (int r = 0; r < 4; ++r) { const int idx = F.tid + r * (NWAVES * 64), s_ = idx >> 6, l_ = idx & 63, n = l_ & 15, k0 = 32 * s_ + 8 * (l_ >> 4);
        float wv[8];
        if (n < 8) { const f32x4 g0 = *(const GAS f32x4*)(IN[I_FFNN] + L * DM + k0), g1 = *(const GAS f32x4*)(IN[I_FFNN] + L * DM + k0 + 4);
#pragma unroll
            for (int j = 0; j < 8; ++j) wv[j] = IN[I_RW][(size_t)(i * DM + k0 + j) * 8 + n] * (j < 4 ? g0[j & 3] : g1[j & 3]); }
        else {
#pragma unroll
            for (int j = 0; j < 8; ++j) wv[j] = 0.f; }
        u32x4 hi, lo;
#pragma unroll
        for (int p = 0; p < 4; ++p) { const unsigned h = cvt_pk_bf16(wv[2 * p], wv[2 * p + 1]); hi[p] = h;
            lo[p] = cvt_pk_bf16(wv[2 * p] - bf_lo(h), wv[2 * p + 1] - bf_hi(h)); }
        WH[idx] = hi; WL[idx] = lo; }
    LDS_WAIT(); __syncthreads();
    gu_t toke = wsu(F, WS_TOKE); gf_t tokp = wsf(F, WS_TOKP); gf_t tokr = wsf(F, WS_TOKR); gu_t cnt = wsu(F, WS_CNT); gcf_t ssq4 = wsf(F, WS_SSQ4);
    for (int chunk = F.bid; chunk < NTOK / 128; chunk += F.G) {
        const int t0 = chunk * 128 + w * 16, tl = lane & 15, q = lane >> 4;
        float rstd; { const unsigned tq = (unsigned)(t0 + tl); const float s01 = ssq4[tq] + ssq4[NTOK + tq], s23 = ssq4[2 * NTOK + tq] + ssq4[3 * NTOK + tq];
            rstd = __builtin_amdgcn_rsqf((s01 + s23) * (1.0f / DM) + RMS_EPS); }
        const GAS char* xrow = (const GAS char*)(x + (size_t)(t0 + tl) * DM) + q * 16;
        f32x4 acc = (f32x4){0.f, 0.f, 0.f, 0.f};
#pragma unroll 1
        for (int sb = 0; sb < 32; sb += 8) { u32x4 xa[8];
#pragma unroll
            for (int s8 = 0; s8 < 8; ++s8) xa[s8] = *(const GAS u32x4*)(xrow + (sb + s8) * 64);
            __builtin_amdgcn_sched_barrier(0);
#pragma unroll
            for (int s8 = 0; s8 < 8; ++s8) { const u32x4 wh = WH[(sb + s8) * 64 + lane], wl = WL[(sb + s8) * 64 + lane];
                acc = __builtin_amdgcn_mfma_f32_16x16x32_bf16(__builtin_bit_cast(bf16x8, wh), __builtin_bit_cast(bf16x8, xa[s8]), acc, 0, 0, 0);
                acc = __builtin_amdgcn_mfma_f32_16x16x32_bf16(__builtin_bit_cast(bf16x8, wl), __builtin_bit_cast(bf16x8, xa[s8]), acc, 0, 0, 0); } }
        float lg[8];
#pragma unroll
        for (int r = 0; r < 4; ++r) { const float o = shx<16>(acc[r], lane); lg[r] = (q & 1) ? o : acc[r]; lg[4 + r] = (q & 1) ? acc[r] : o; }
        int e1 = 0; float l1 = lg[0];
#pragma unroll
        for (int e = 1; e < 8; ++e) if (lg[e] > l1) { l1 = lg[e]; e1 = e; }
        int e2 = -1; float l2 = 0.f;
#pragma unroll
        for (int e = 0; e < 8; ++e) if (e != e1 && (e2 < 0 || lg[e] > l2)) { l2 = lg[e]; e2 = e; }
        const float p1 = __builtin_amdgcn_rcpf(1.0f + __builtin_amdgcn_exp2f((l2 - l1) * rstd * 1.4426950408889634f));
        if (lane < 16) { const int t = t0 + lane; toke[t] = (unsigned)e1 | ((unsigned)e2 << 8); tokp[t] = p1; tokr[t] = rstd; }
        unsigned c[8];
#pragma unroll
        for (int e = 0; e < 8; ++e) c[e] = (unsigned)__popcll(__ballot(lane < 16 && e1 == e)) + (unsigned)__popcll(__ballot(lane < 16 && e2 == e));
        if (lane < 8) { unsigned v = c[0];
#pragma unroll
            for (int e = 1; e < 8; ++e) v = lane == e ? c[e] : v;
            cntw[w * 8 + lane] = v; }
        LDS_WAIT(); __syncthreads();
        if (F.tid < 8) { unsigned s = 0;
#pragma unroll
            for (int q2 = 0; q2 < 8; ++q2) s += cntw[q2 * 8 + F.tid];
            cnt[chunk * 8 + F.tid] = s; }
        __syncthreads();
    }
}
__device__ __forceinline__ void p_r2(const Frame& F) {
    LAS unsigned* lc = (LAS unsigned*)F.lds;
    LAS unsigned* pre = lc + 2048;
    LAS unsigned* tslot = pre + 64;
    LAS unsigned* te = tslot + 256;
    gu_t cnt = wsu(F, WS_CNT); gu_t toke = wsu(F, WS_TOKE); gu_t slotof = wsu(F, WS_SLOTOF); gu_t panel = wsu(F, WS_PANEL);
    gcf_t tokr = wsf(F, WS_TOKR);
    GAS unsigned char* XG = F.ws + WS_XG; gcbf_t xs = wsb(F, WS_XB);
    for (int q = F.tid; q < 2048; q += NWAVES * 64) lc[q] = __hip_atomic_load(cnt + q, RLX_AGENT);
    LDS_WAIT(); __syncthreads();
    for (int chunk = F.bid; chunk < NTOK / 128; chunk += F.G) {
        {
            const int e = F.wave; unsigned tot = 0, before = 0;
#pragma unroll
            for (int q = 0; q < 4; ++q) { const int c = 4 * F.lane + q; const unsigned v = lc[c * 8 + e]; before += c < chunk ? v : 0u; tot += v; }
#define R2SUM(M) before += (unsigned)shx_i<M>((int)before, F.lane); tot += (unsigned)shx_i<M>((int)tot, F.lane);
            R2SUM(1) R2SUM(2) R2SUM(4) R2SUM(8) R2SUM(16) R2SUM(32)
#undef R2SUM
            if (F.lane == 0) { pre[e] = before; pre[16 + e] = tot; } }
        if (F.tid < 128) te[F.tid] = __hip_atomic_load(toke + chunk * 128 + F.tid, RLX_AGENT);
        LDS_WAIT(); __syncthreads();
        if (F.tid == 0) { unsigned seg = 0; for (int e = 0; e < 8; ++e) { pre[8 + e] = seg; seg += (pre[16 + e] + 255u) & ~255u; } pre[24] = seg >> 8; }
        LDS_WAIT(); __syncthreads();
        {
            const unsigned e = F.wave; unsigned slot = pre[8 + e] + pre[e];
#pragma unroll
            for (int h = 0; h < 2; ++h) { const int tt = 64 * h + F.lane; const unsigned ee = te[tt]; const bool f1 = (ee & 255u) == e, f2 = (ee >> 8) == e;
                const unsigned long long m = __ballot(f1 || f2); const unsigned pfx = __builtin_amdgcn_mbcnt_hi((unsigned)(m >> 32), __builtin_amdgcn_mbcnt_lo((unsigned)m, 0u));
                if (f1) tslot[2 * tt] = slot + pfx; else if (f2) tslot[2 * tt + 1] = slot + pfx;
                slot += (unsigned)__popcll(m); } }
        if (chunk == 0 && F.tid >= 64 && F.tid < 72) { const unsigned e = F.tid - 64; const unsigned p0 = pre[8 + e] >> 8, p1 = (pre[8 + e] + ((pre[16 + e] + 255u) & ~255u)) >> 8;
            for (unsigned p = p0; p < p1; ++p) panel[1 + p] = e;
            if (e == 0) panel[0] = pre[24]; }
        LDS_WAIT(); __syncthreads();
#pragma unroll 1
        for (int tt = 0; tt < 16; tt += 4) { u32x4 v[4][2]; float r[4]; unsigned s0[4], s1[4];
#pragma unroll
            for (int q = 0; q < 4; ++q) { const int tl = F.wave * 16 + tt + q, t = chunk * 128 + tl; s0[q] = tslot[2 * tl]; s1[q] = tslot[2 * tl + 1]; r[q] = tokr[t];
#pragma unroll
                for (int h = 0; h < 2; ++h) v[q][h] = *((const GAS u32x4*)(xs + (size_t)t * DM) + F.lane + 64 * h); }
#pragma unroll
            for (int q = 0; q < 4; ++q) { const int t = chunk * 128 + F.wave * 16 + tt + q;
                GAS u32x2* d0 = (GAS u32x2*)(XG + (size_t)s0[q] * DM) + F.lane; GAS u32x2* d1 = (GAS u32x2*)(XG + (size_t)s1[q] * DM) + F.lane;
#pragma unroll
                for (int h = 0; h < 2; ++h) { f32x4 a, b; pg8::unpack8(v[q][h], a, b); u32x2 w; w.x = pg8::pk_fp8x4(a[0] * r[q], a[1] * r[q], a[2] * r[q], a[3] * r[q]); w.y = pg8::pk_fp8x4(b[0] * r[q], b[1] * r[q], b[2] * r[q], b[3] * r[q]);
                    d0[64 * h] = w; d1[64 * h] = w; }
                (void)t; } }
        if (F.tid < 256) slotof[chunk * 256 + F.tid] = tslot[F.tid];
        __syncthreads();
    }
}
__device__ __forceinline__ void p_cb(const Frame& F, bool final_) {
    const int gw = F.bid * NWAVES + F.wave, NGW = F.G * NWAVES;
    const GAS unsigned* slotof = wsu(F, WS_SLOTOF); gcf_t tokp = wsf(F, WS_TOKP); gcbf_t Y = wsb(F, WS_Y);
    gbf_t xs = wsb(F, WS_XB); gf_t ssq4 = wsf(F, WS_SSQ4); const InPtrs IN(F); gcf_t gfin = IN[I_FIN];
    gcbf_t YP = wsb(F, WS_YP); int mainP, tailP, nsplit; pg8::MoeOrder2::split((int)__hip_atomic_load(wsu(F, WS_PANEL), RLX_AGENT), F.G, mainP, tailP, nsplit);
    mainP = __builtin_amdgcn_readfirstlane(mainP); nsplit = __builtin_amdgcn_readfirstlane(nsplit);
    const unsigned main_rows = (unsigned)mainP * 256u; const int slab_rows = nsplit == 7 ? pg8::TAIL_ROWS : pg8::TAIL_ROWS2;
    f32x4 gf[4];
#pragma unroll
    for (int j = 0; j < 4; ++j) gf[j] = final_ ? *((const GAS f32x4*)gfin + (128 * (j >> 1) + 2 * F.lane + (j & 1))) : (f32x4){0.f, 0.f, 0.f, 0.f};
    for (int t0 = gw * 4; t0 < NTOK; t0 += NGW * 4) {
        unsigned s0[4], s1[4]; float p1[4]; u32x4 xv[4][2]; u32x2 ya[4][2], yb[4][2];
#pragma unroll
        for (int q = 0; q < 4; ++q) { s0[q] = slotof[2 * (t0 + q)]; s1[q] = slotof[2 * (t0 + q) + 1]; p1[q] = tokp[t0 + q]; }
#pragma unroll
        for (int q = 0; q < 4; ++q)
#pragma unroll
            for (int h = 0; h < 2; ++h) { xv[q][h] = *((const GAS u32x4*)(xs + (size_t)(t0 + q) * DM) + F.lane + 64 * h);
                ya[q][h] = *((const GAS u32x2*)((const GAS unsigned char*)Y + (size_t)s0[q] * DM) + F.lane + 64 * h); yb[q][h] = *((const GAS u32x2*)((const GAS unsigned char*)Y + (size_t)s1[q] * DM) + F.lane + 64 * h); }
#pragma unroll
        for (int q = 0; q < 4; ++q) { const int t = t0 + q; const float pa = p1[q], pb = 1.0f - pa; f32x4 v[4]; float ss = 0.f;
#pragma unroll
            for (int h = 0; h < 2; ++h) { f32x4 x0, x1, a0, a1, b0, b1; pg8::unpack8(xv[q][h], x0, x1); pg8::unpack_fp8x8(ya[q][h], a0, a1); pg8::unpack_fp8x8(yb[q][h], b0, b1); a0 *= 0.0625f; a1 *= 0.0625f; b0 *= 0.0625f; b1 *= 0.0625f;
                if (s0[q] >= main_rows) { u32x4 cs[7];
#pragma unroll
                    for (int sp = 0; sp < 7; ++sp) cs[sp] = *((const GAS u32x4*)(YP + (size_t)((sp < nsplit ? sp : 0) * slab_rows + s0[q] - main_rows) * DM) + F.lane + 64 * h);
                    __builtin_amdgcn_sched_barrier(0);
                    a0 = (f32x4){0.f, 0.f, 0.f, 0.f}; a1 = a0;
#pragma unroll
                    for (int sp = 0; sp < 7; ++sp) { f32x4 c0, c1; pg8::unpack8(cs[sp], c0, c1); const float m = sp < nsplit ? 1.0f : 0.0f; a0 += c0 * m; a1 += c1 * m; } }
                if (s1[q] >= main_rows) { u32x4 cs[7];
#pragma unroll
                    for (int sp = 0; sp < 7; ++sp) cs[sp] = *((const GAS u32x4*)(YP + (size_t)((sp < nsplit ? sp : 0) * slab_rows + s1[q] - main_rows) * DM) + F.lane + 64 * h);
                    __builtin_amdgcn_sched_barrier(0);
                    b0 = (f32x4){0.f, 0.f, 0.f, 0.f}; b1 = b0;
#pragma unroll
                    for (int sp = 0; sp < 7; ++sp) { f32x4 c0, c1; pg8::unpack8(cs[sp], c0, c1); const float m = sp < nsplit ? 1.0f : 0.0f; b0 += c0 * m; b1 += c1 * m; } }
                v[2 * h] = x0 + pa * a0 + pb * b0; v[2 * h + 1] = x1 + pa * a1 + pb * b1; }
#pragma unroll
            for (int j = 0; j < 4; ++j) ss += (v[j][0] * v[j][0] + v[j][1] * v[j][1]) + (v[j][2] * v[j][2] + v[j][3] * v[j][3]);
            ss = wave_sum_l(ss, F.lane);
            if (final_) { const float rstd = __builtin_amdgcn_rsqf(ss * (1.0f / DM) + RMS_EPS); GAS f32x4* orow = (GAS f32x4*)(F.out + (size_t)t * DM);
#pragma unroll
                for (int j = 0; j < 4; ++j) { const int e4 = 128 * (j >> 1) + 2 * F.lane + (j & 1); orow[e4] = v[j] * rstd * gf[j]; }
            } else {
#pragma unroll
                for (int h = 0; h < 2; ++h) { *((GAS u32x4*)(xs + (size_t)t * DM) + F.lane + 64 * h) = pg8::pack8(v[2 * h], v[2 * h + 1]);
                    u32x2 w8; w8.x = pg8::pk_fp8x4(v[2 * h][0], v[2 * h][1], v[2 * h][2], v[2 * h][3]); w8.y = pg8::pk_fp8x4(v[2 * h + 1][0], v[2 * h + 1][1], v[2 * h + 1][2], v[2 * h + 1][3]);
                    *((GAS u32x2*)(F.ws + WS_XB8 + (size_t)t * DM) + F.lane + 64 * h) = w8; }
                if (F.lane < 4) ssq4[(size_t)F.lane * NTOK + t] = F.lane == 0 ? ss : 0.f;
            } }
    }
}

constexpr int N_PHASES = 1 + DEPTH * 4 + 2 * 2 + 2 * 5;
__global__ void __launch_bounds__(NWAVES * 64, 2) trunk_fwd(Args args) {
    extern __shared__ __attribute__((aligned(16))) unsigned char lds_raw[];
    Frame F;
    F.lds = (LAS unsigned char*)lds_raw;
    F.kp = (kptr_t)__builtin_amdgcn_kernarg_segment_ptr(); F.out = (gf_t)args.out; F.ws = (GAS unsigned char*)args.ws;
    F.tid = threadIdx.x; F.lane = F.tid & 63; F.wave = __builtin_amdgcn_readfirstlane(F.tid >> 6); F.G = gridDim.x; F.bid = blockIdx.x;
    volatile LAS unsigned* MISC = (volatile LAS unsigned*)(F.lds + MISC_OFF);
    for (int u = F.tid; u < (LDS_BYTES - LDSCTL_OFF) / 4; u += NWAVES * 64) ((LAS unsigned*)(F.lds + LDSCTL_OFF))[u] = 0u;
    __syncthreads();
    gu32* ctl = (gu32*)(args.ws + WS_CTL);
#if MK_PER_PHASE
    XcdBarrier bar; bar.bar = ctl + CW_BAR; bar.x = 0; bar.st = nullptr; (void)bar; (void)MISC;
#else
    XcdBarrier bar = xcd_barrier_post(ctl + CW_BAR, MISC + 8, F.tid);
#endif
#if MK_PER_PHASE
    const int lo = args.ph_lo, hi = args.ph_hi;
    int ph = 0;
#endif
#if MK_PER_PHASE
#define IN_PH() (ph >= lo && ph < hi)
#else
#define IN_PH() true
#endif
#if MK_PER_PHASE
#define SEAM() do { ++ph; } while (0)
#else
#define SEAM() do { XcdBarrier b2_ = bar; asm volatile("" : "+s"(b2_.bar), "+s"(b2_.x)); xcd_barrier(b2_, hw_tid(F.wave)); } while (0)
#endif
#define PHASE_FRAME(Fp) Frame Fp = F; Fp.tid = hw_tid(F.wave); asm volatile("" : "+s"(Fp.ws), "+s"(Fp.out), "+v"(Fp.tid), "+s"(Fp.G), "+s"(Fp.bid)); Fp.lane = Fp.tid & 63
#if MK_PER_PHASE
#define REPBAR() do { } while (0)
#else
#define REPBAR() do { XcdBarrier b3_ = bar; asm volatile("" : "+s"(b3_.bar), "+s"(b3_.x)); xcd_barrier(b3_, hw_tid(F.wave)); } while (0)
#endif
    LAS unsigned char* ring = F.lds;
    LAS float* rtab = (LAS float*)(F.lds + RTAB_OFF); LAS float* stab = (LAS float*)(F.lds + STAB_OFF); LAS float* rawt = (LAS float*)(F.lds + RAW_OFF);

    if (PHON(0) && IN_PH()) {
_Pragma("unroll 1") for (int rep_ = 0; rep_ < NREP(0); ++rep_) { if (rep_) REPBAR(); PHASE_FRAME(Fp); p_prologue(Fp); } }
    SEAM();
#pragma unroll 1
    for (int L = 0; L < DEPTH; ++L) {
        if (PHON(1) && IN_PH()) {
_Pragma("unroll 1") for (int rep_ = 0; rep_ < NREP(1); ++rep_) { if (rep_) REPBAR();
            PHASE_FRAME(Fp); gf_t ssq4 = wsf(Fp, WS_SSQ4); gbf_t xb = wsb(Fp, WS_XB); (void)ssq4; (void)xb;
            pg8::StaticOrder S; S.init(NTOK, IN_COLS, Fp.G, Fp.bid);
            if (L < 2) { pg8::Gemm g{xb, wsb(Fp, WS_WIN) + (size_t)L * IN_COLS * DM, DM, DM, DM};
                pg8::EpiIn E{pg8::PreSsq4{ssq4, rtab, rawt}, wsb(Fp, WS_U), wsb(Fp, WS_P), wsb(Fp, WS_RQ), wsb(Fp, WS_SGP), 1.0f};
                pg8::gemm_phase<pg8::EpiIn, pg8::StaticOrder, pg8::KPlain>(ring, g, S, E, Fp.wave); }
            else { pg8::Gemm g{wsb(Fp, WS_XB8), wsb(Fp, WS_WIN8 + (size_t)(L - 2) * IN_COLS * DM), DM / 2, DM / 2, DM / 2};
                pg8::EpiIn E{pg8::PreSsq4{ssq4, rtab, rawt}, wsb(Fp, WS_U), wsb(Fp, WS_P), wsb(Fp, WS_RQ), wsb(Fp, WS_SGP), 0.03125f};
                pg8::gemm_phase<pg8::EpiIn, pg8::StaticOrder, pg8::KPlain, true>(ring, g, S, E, Fp.wave); }
        } }
        SEAM();
#if (DUP_MASK >> 12) & 1
        if (IN_PH()) { REPBAR();
            PHASE_FRAME(Fp);
            pg8::Gemm g{wsb(Fp, WS_XB), wsb(Fp, WS_WIN) + (size_t)L * IN_COLS * DM, DM, DM, DM}; pg8::HotOrder S{7, 0};
            pg8::EpiY E{pg8::PreNone{}, wsb(Fp, WS_ACT + 330 * MiB), 1.0f, nullptr, 0, 0};
            pg8::gemm_phase<pg8::EpiY, pg8::HotOrder, pg8::KPlain>(ring, g, S, E, Fp.wave);
        }
#endif
        if (PHON(2) && IN_PH()) {
_Pragma("unroll 1") for (int rep_ = 0; rep_ < NREP(2); ++rep_) { if (rep_) REPBAR(); PHASE_FRAME(Fp); p_cp(Fp, L); } }
        SEAM();
        if (PHON(3) && IN_PH()) {
_Pragma("unroll 1") for (int rep_ = 0; rep_ < NREP(3); ++rep_) { if (rep_) REPBAR();
            PHASE_FRAME(Fp); gf_t ssq4 = wsf(Fp, WS_SSQ4); gbf_t xb = wsb(Fp, WS_XB); (void)ssq4; (void)xb;
            pg8::Gemm g{wsb(Fp, WS_SD), wsb(Fp, WS_WM) + (size_t)L * DM * 640, DM, 640, 640, 2, SG_MG}; pg8::StaticOrder S; S.init(NTOK, DM, Fp.G, Fp.bid);
            if (L < 2) { pg8::EpiMerge<false> E{pg8::PreNone{}, wsb(Fp, WS_RQ), wsb(Fp, WS_SGP), wsb(Fp, WS_MERGED)}; pg8::gemm_phase<pg8::EpiMerge<false>, pg8::StaticOrder, pg8::KMerge>(ring, g, S, E, Fp.wave); }
            else { pg8::EpiMerge<true> E{pg8::PreNone{}, wsb(Fp, WS_RQ), wsb(Fp, WS_SGP), wsb(Fp, WS_MERGED)}; pg8::gemm_phase<pg8::EpiMerge<true>, pg8::StaticOrder, pg8::KMerge>(ring, g, S, E, Fp.wave); }
        } }
        SEAM();
        if (PHON(4) && IN_PH()) { {
            PHASE_FRAME(Fp); gf_t ssq4 = wsf(Fp, WS_SSQ4); gbf_t xb = wsb(Fp, WS_XB); (void)ssq4; (void)xb;
            pg8::StaticOrder S; S.init(NTOK, DM, Fp.G, Fp.bid);
            if (L < 2) { pg8::Gemm g{wsb(Fp, WS_MERGED), wsb(Fp, WS_WOUT) + (size_t)L * DM * DM, DM, DM, DM, 2, SG_OUT};
                pg8::EpiRes E{pg8::PreNone{}, xb, ssq4, stab, 1.0f, nullptr};
                pg8::gemm_phase<pg8::EpiRes, pg8::StaticOrder, pg8::KPlain>(ring, g, S, E, Fp.wave); }
            else { pg8::Gemm g{wsb(Fp, WS_MERGED), wsb(Fp, WS_WOUT + (size_t)L * DM * DM * 2), DM / 2, DM / 2, DM / 2, 2, SG_OUT};
                pg8::EpiRes E{pg8::PreNone{}, xb, ssq4, stab, 0.03125f, L == 2 ? Fp.ws + WS_XB8 : (GAS unsigned char*)nullptr};
                pg8::gemm_phase<pg8::EpiRes, pg8::StaticOrder, pg8::KPlain, true>(ring, g, S, E, Fp.wave); }
        } }
        SEAM();
        if ((L & 1) == 0) {
            const int i = L >> 1;
            if (PHON(5) && IN_PH()) {
_Pragma("unroll 1") for (int rep_ = 0; rep_ < NREP(5); ++rep_) { if (rep_) REPBAR();
            PHASE_FRAME(Fp); gf_t ssq4 = wsf(Fp, WS_SSQ4); gbf_t xb = wsb(Fp, WS_XB); (void)ssq4; (void)xb;
                pg8::StaticOrder S; S.init(NTOK, 2 * DFF, Fp.G, Fp.bid);
                if (i == 0) { pg8::Gemm g{xb, wsb(Fp, WS_DGU), DM, DM, DM};
                    pg8::EpiSwiglu<pg8::PreSsq4, false> E{pg8::PreSsq4{ssq4, rtab, rawt}, wsb(Fp, WS_HMID), DFF};
                    pg8::gemm_phase<pg8::EpiSwiglu<pg8::PreSsq4, false>, pg8::StaticOrder, pg8::KPlain>(ring, g, S, E, Fp.wave); }
                else { pg8::Gemm g{wsb(Fp, WS_XB8), wsb(Fp, WS_DGU8), DM / 2, DM / 2, DM / 2};
                    pg8::EpiSwiglu<pg8::PreSsq4, true> E{pg8::PreSsq4{ssq4, rtab, rawt}, Fp.ws + WS_H8, DFF};
                    pg8::gemm_phase<pg8::EpiSwiglu<pg8::PreSsq4, true>, pg8::StaticOrder, pg8::KPlain, true>(ring, g, S, E, Fp.wave); }
            } }
            SEAM();
            if (PHON(6) && IN_PH()) {
            PHASE_FRAME(Fp); gf_t ssq4 = wsf(Fp, WS_SSQ4); gbf_t xb = wsb(Fp, WS_XB); (void)ssq4; (void)xb;
                pg8::StaticOrder S; S.init(NTOK, DM, Fp.G, Fp.bid);
                if (i == 0) { pg8::Gemm g{wsb(Fp, WS_HMID), wsb(Fp, WS_DD), DFF, DFF, DFF, 2, SG_F2};
                    pg8::EpiRes E{pg8::PreNone{}, xb, ssq4, stab, 1.0f, nullptr};
                    pg8::gemm_phase<pg8::EpiRes, pg8::StaticOrder, pg8::KPlain>(ring, g, S, E, Fp.wave); }
                else { pg8::Gemm g{wsb(Fp, WS_H8), wsb(Fp, WS_DD8), DFF / 2, DFF / 2, DFF / 2, 2, SG_F2};
                    pg8::EpiRes E{pg8::PreNone{}, xb, ssq4, stab, 1.0f / 256.0f, Fp.ws + WS_XB8};
                    pg8::gemm_phase<pg8::EpiRes, pg8::StaticOrder, pg8::KPlain, true>(ring, g, S, E, Fp.wave); }
            }
            SEAM();
        } else {
            const int i = L >> 1;
            if (PHON(7) && IN_PH()) {
_Pragma("unroll 1") for (int rep_ = 0; rep_ < NREP(7); ++rep_) { if (rep_) REPBAR(); PHASE_FRAME(Fp); p_r1(Fp, i, L); } }
            SEAM();
            if (PHON(8) && IN_PH()) {
_Pragma("unroll 1") for (int rep_ = 0; rep_ < NREP(8); ++rep_) { if (rep_) REPBAR(); PHASE_FRAME(Fp); p_r2(Fp); } }
            SEAM();
            if (PHON(9) && IN_PH()) {
_Pragma("unroll 1") for (int rep_ = 0; rep_ < NREP(9); ++rep_) { if (rep_) REPBAR();
            PHASE_FRAME(Fp); gf_t ssq4 = wsf(Fp, WS_SSQ4); gbf_t xb = wsb(Fp, WS_XB); (void)ssq4; (void)xb;
                LAS unsigned* ptab = (LAS unsigned*)(Fp.lds + PTAB_OFF);
                for (int q = Fp.tid; q < 512; q += NWAVES * 64) ptab[q] = __hip_atomic_load(wsu(Fp, WS_PANEL) + q, RLX_AGENT);
                LDS_WAIT(); __syncthreads();
                pg8::Gemm g{wsb(Fp, WS_XG), wsb(Fp, WS_MGU + (size_t)i * NEXP * 2 * DFFE * DM), DM / 2, DM / 2, DM / 2}; pg8::MoeOrder S; S.init(ptab, 2 * DFFE, Fp.G, Fp.bid);
                pg8::EpiSwiglu8 E{pg8::PreNone{}, Fp.ws + WS_HE, DFFE};
                pg8::gemm_phase<pg8::EpiSwiglu8, pg8::MoeOrder, pg8::KPlain, true>(ring, g, S, E, Fp.wave);
            } }
            SEAM();
            if (PHON(10) && IN_PH()) {
_Pragma("unroll 1") for (int rep_ = 0; rep_ < NREP(10); ++rep_) { if (rep_) REPBAR();
            PHASE_FRAME(Fp); gf_t ssq4 = wsf(Fp, WS_SSQ4); gbf_t xb = wsb(Fp, WS_XB); (void)ssq4; (void)xb;
                LAS unsigned* ptab = (LAS unsigned*)(Fp.lds + PTAB_OFF);
                for (int q = Fp.tid; q < 512; q += NWAVES * 64) ptab[q] = __hip_atomic_load(wsu(Fp, WS_PANEL) + q, RLX_AGENT);
                LDS_WAIT(); __syncthreads();
                pg8::Gemm g{wsb(Fp, WS_HE), wsb(Fp, WS_MD + (size_t)i * NEXP * DM * DFFE), DFFE / 2, DFFE / 2, DFFE / 2}; pg8::MoeOrder2 S; S.init(ptab, Fp.G, Fp.bid);
                pg8::EpiY E{pg8::PreNone{}, wsb(Fp, WS_Y), 1.0f / 256.0f, wsb(Fp, WS_YP), S.mainP * 256, S.S == 7 ? pg8::TAIL_ROWS : pg8::TAIL_ROWS2};
                pg8::gemm_phase<pg8::EpiY, pg8::MoeOrder2, pg8::KPlainV, true, true>(ring, g, S, E, Fp.wave);
            } }
            SEAM();
            if (PHON(11) && IN_PH()) { PHASE_FRAME(Fp); p_cb(Fp, L == DEPTH - 1); }
            if (L != DEPTH - 1) SEAM();
        }
    }
#undef IN_PH
#undef SEAM
}

extern "C" void kernel_launch(void* const* d_in, const int* in_sizes, int n_in, void* d_out, int out_size, void* d_ws, size_t ws_size, hipStream_t stream) {
    static int grid = 0;
    if (grid == 0) {
        if (n_in != 20 || in_sizes[0] != NTOK * DM || out_size != NTOK * DM || ws_size < WS_END2) { fprintf(stderr, "kernel_launch: unexpected shapes / workspace (%d inputs, ws %zu, need %zu)\n", n_in, ws_size, (size_t)WS_END2); grid = -1; return; }
        int dev = 0, cus = 0, per_cu = 0;
        if (hipGetDevice(&dev) != hipSuccess || hipDeviceGetAttribute(&cus, hipDeviceAttributeMultiprocessorCount, dev) != hipSuccess) { grid = -1; return; }
        if (hipFuncSetAttribute((const void*)trunk_fwd, hipFuncAttributeMaxDynamicSharedMemorySize, LDS_BYTES) != hipSuccess) { fprintf(stderr, "kernel_launch: hipFuncSetAttribute failed\n"); grid = -1; return; }
        if (hipOccupancyMaxActiveBlocksPerMultiprocessor(&per_cu, (const void*)trunk_fwd, NWAVES * 64, LDS_BYTES) != hipSuccess || per_cu < 1) { fprintf(stderr, "kernel_launch: occupancy query says %d blocks per CU\n", per_cu); grid = -1; (void)hipGetLastError(); return; }
        grid = cus;
    }
    if (grid < 0) return;
    if (hipMemsetAsync((char*)d_ws + WS_CTL, 0, CTL_ZERO_BYTES, stream) != hipSuccess) return;
    Args a{};
    for (int i = 0; i < 20; ++i) a.in[i] = (const float*)d_in[i];
    a.out = (float*)d_out; a.ws = (unsigned char*)d_ws;
#if MK_PER_PHASE
    for (int p = 0; p < N_PHASES; ++p) { a.ph_lo = p; a.ph_hi = p + 1; hipLaunchKernelGGL(trunk_fwd, dim3(grid), dim3(NWAVES * 64), LDS_BYTES, stream, a); }
#else
    a.ph_lo = 0; a.ph_hi = N_PHASES;
    hipLaunchKernelGGL(trunk_fwd, dim3(grid), dim3(NWAVES * 64), LDS_BYTES, stream, a);
#endif
}
```

```cpp
#include <hip/hip_runtime.h>
#include <cstdio>
#include <cstdint>

#ifndef PH_MASK
#define PH_MASK 0xFFF
#endif
#define PHON(b) ((PH_MASK >> (b)) & 1)
#ifndef DUP_MASK
#define DUP_MASK 0
#endif
#define NREP(b) (((DUP_MASK >> (b)) & 1) ? 2 : 1)
#ifndef MK_PER_PHASE
#define MK_PER_PHASE 0
#endif

#define LAS __attribute__((address_space(3)))
#define GAS __attribute__((address_space(1)))
typedef unsigned short bf16_t;
typedef short bf16x8 __attribute__((ext_vector_type(8)));
typedef float f32x4 __attribute__((ext_vector_type(4)));
typedef float f32x2 __attribute__((ext_vector_type(2)));
typedef unsigned u32x4 __attribute__((ext_vector_type(4)));
typedef unsigned u32x2 __attribute__((ext_vector_type(2)));
typedef GAS unsigned gu32;
typedef GAS bf16_t* gbf_t; typedef const GAS bf16_t* gcbf_t; typedef GAS float* gf_t; typedef const GAS float* gcf_t; typedef GAS unsigned* gu_t;
#define ST4U(p) (*(GAS u32x4*)(p))
#define LD4U(p) (*(const GAS u32x4*)(p))
#define ST4F(p) (*(GAS f32x4*)(p))
#define LD4F(p) (*(const GAS f32x4*)(p))
#define RLX_AGENT __ATOMIC_RELAXED, __HIP_MEMORY_SCOPE_AGENT

constexpr int NTOK = 32768, DM = 1024, SEQ = 8192, DEPTH = 4;
constexpr int CONV_DIM = 512, CONV_W = 31;
constexpr int IN_COLS = 3584;
constexpr int DFF = 2816, NEXP = 8, DFFE = 3584;
constexpr int NSLOT = 2 * NTOK + NEXP * 256;
constexpr float RMS_EPS = 1e-6f, LN_EPS = 1e-5f;
constexpr int NWAVES = 8;

constexpr size_t MiB = 1u << 20;
constexpr size_t WS_CTL = 0, CTL_ZERO_BYTES = 65536;
constexpr size_t WS_SSQ4 = 1 * MiB;
constexpr size_t WS_TOKE = 3 * MiB;
constexpr size_t WS_TOKP = WS_TOKE + 131072;
constexpr size_t WS_TOKR = WS_TOKP + 131072;
constexpr size_t WS_SLOTOF = WS_TOKR + 131072;
constexpr size_t WS_CNT = WS_SLOTOF + 262144;
constexpr size_t WS_PANEL = WS_CNT + 8192;
constexpr size_t WS_RSLOT = WS_PANEL + 4096;
constexpr size_t WS_WIN = 6 * MiB;
constexpr size_t WS_WM = 34 * MiB;
constexpr size_t WS_WOUT = 39 * MiB;
constexpr size_t WS_DGU = 47 * MiB;
constexpr size_t WS_DD = 69 * MiB;
constexpr size_t WS_MGU = 80 * MiB;
constexpr size_t WS_MD = 192 * MiB;
constexpr size_t WS_XB = 248 * MiB;
constexpr size_t WS_ACT = 312 * MiB;
constexpr size_t WS_U = WS_ACT;
constexpr size_t WS_P = WS_ACT + 32 * MiB;
constexpr size_t WS_RQ = WS_ACT + 64 * MiB;
constexpr size_t WS_SGP = WS_ACT + 128 * MiB;
constexpr size_t WS_SD = WS_ACT + 192 * MiB;
constexpr size_t WS_MERGED = WS_ACT + 256 * MiB;
constexpr size_t WS_HMID = WS_ACT;
constexpr size_t WS_XG = WS_ACT;
constexpr size_t WS_Y = WS_ACT + 66 * MiB;
constexpr size_t WS_HE = WS_ACT + 198 * MiB;
constexpr size_t WS_H8 = WS_ACT;
constexpr size_t WS_YP = WS_ACT + 464 * MiB;
constexpr size_t WS_END = WS_ACT + 594 * MiB;
constexpr size_t WS_XB8 = WS_ACT + 432 * MiB;
constexpr size_t WS_WIN8 = 20 * MiB;
constexpr size_t WS_DGU8 = 58 * MiB;
constexpr size_t WS_DD8 = 75 * MiB;
constexpr size_t WS_END2 = WS_END;
static_assert(WS_WIN + (size_t)2 * IN_COLS * DM * 2 <= WS_WIN8 && WS_WIN8 + (size_t)2 * IN_COLS * DM <= WS_WM && WS_DGU + (size_t)2 * DFF * DM * 2 <= WS_DGU8 && WS_DGU8 + (size_t)2 * DFF * DM <= WS_DD && WS_DD + (size_t)DM * DFF * 2 <= WS_DD8 && WS_DD8 + (size_t)DM * DFF <= WS_MGU && WS_XB8 + (size_t)NTOK * DM <= WS_END && WS_HE + (size_t)NSLOT * DFFE <= WS_XB8, "d_ws map (fp8 copies)");
static_assert((size_t)NSLOT * DM <= 66 * MiB && (size_t)NSLOT * DM * 2 <= 132 * MiB && WS_HE + (size_t)NSLOT * DFFE <= WS_END && (size_t)2 * NEXP * 2 * DFFE * DM <= 112 * MiB && (size_t)2 * NEXP * DFFE * DM <= 56 * MiB, "d_ws map");

constexpr int CW_BAR = 4096;

constexpr int RING_BYTES = 131072;
constexpr int LDSCTL_OFF = RING_BYTES, MISC_OFF = LDSCTL_OFF + 320, PTAB_OFF = LDSCTL_OFF + 1024;
constexpr int RTAB_OFF = LDSCTL_OFF + 3072, STAB_OFF = LDSCTL_OFF + 4096, RAW_OFF = LDSCTL_OFF + 8192;
constexpr int LDS_BYTES = 147456;

__device__ __forceinline__ unsigned cvt_pk_bf16(float lo, float hi) { unsigned r; asm volatile("v_cvt_pk_bf16_f32 %0, %1, %2" : "=v"(r) : "v"(lo), "v"(hi)); return r; }
__device__ __forceinline__ float bf_lo(unsigned w) { return __uint_as_float(w << 16); }
__device__ __forceinline__ float bf_hi(unsigned w) { return __uint_as_float(w & 0xffff0000u); }
__device__ __forceinline__ float fast_exp(float x) { return __builtin_amdgcn_exp2f(x * 1.4426950408889634f); }
__device__ __forceinline__ float clamp30(float x) { return __builtin_fminf(__builtin_fmaxf(x, -30.f), 30.f); }
__device__ __forceinline__ float sigmoidf_(float x) { return __builtin_amdgcn_rcpf(1.0f + fast_exp(-clamp30(x))); }
__device__ __forceinline__ int hw_tid(int wave) { unsigned ones = ~0u; asm volatile("" : "+s"(ones));
    return wave * 64 + (int)__builtin_amdgcn_mbcnt_hi(ones, __builtin_amdgcn_mbcnt_lo(ones, 0u)); }
template <int M> __device__ __forceinline__ int shx_i(int v, int lane) {
    if constexpr (M < 32) return __builtin_amdgcn_ds_swizzle(v, (M << 10) | 0x1F);
    else return __builtin_amdgcn_ds_bpermute((lane ^ 32) << 2, v);
}
template <int M> __device__ __forceinline__ float shx(float v, int lane) { return __int_as_float(shx_i<M>(__float_as_int(v), lane)); }
__device__ __forceinline__ float wave_sum_l(float v, int lane) { v += shx<1>(v, lane); v += shx<2>(v, lane); v += shx<4>(v, lane); v += shx<8>(v, lane); v += shx<16>(v, lane); v += shx<32>(v, lane); return v; }
#define LDS_WAIT() asm volatile("s_waitcnt lgkmcnt(0)" ::: "memory")
#define VM_WAIT() asm volatile("s_waitcnt vmcnt(0)" ::: "memory")

namespace pg8 {
constexpr int BM = 256, BK = 64, HALF = 128, HTB = HALF * BK * 2, STAGE_BYTES = 8 * HTB, NXCD = 8, WGM = 8;
__host__ __device__ __forceinline__ int lds_byte(int r, int c) { const int st = (r >> 4) * 2 + (c >> 5), rr = r & 15, cc = c & 31, ob = rr * 64 + cc * 2; return st * 1024 + (ob ^ (((ob >> 9) & 1) << 5)); }
__host__ __device__ __forceinline__ void stage_rc(int b, int& R, int& C) { const int st = b / 1024, sb = b % 1024, swz = sb ^ (((sb >> 9) & 1) << 5); R = (st >> 1) * 16 + swz / 64; C = (st & 1) * 32 + (swz % 64) / 2; }
__host__ __device__ __forceinline__ int perm32(int rho) { const int n = rho >> 4, i = rho & 15; return 8 * (i >> 2) + 4 * n + (i & 3); }

struct Unit { int pm, pn, pb; int kt0 = 0, ntu = 0, part = -1; };
struct Gemm { gcbf_t A; gcbf_t Bt; int lda, ldb, K; int sg_n = 4, sg_k = 0; };

struct KPlain { static __device__ __forceinline__ int koff(const Unit&, int t) { return t * BK; } };
struct KPlainV { static __device__ __forceinline__ int koff(const Unit& u, int t) { return (u.kt0 + t) * BK; } };
struct KMerge { static __device__ __forceinline__ int koff(const Unit& u, int t) { return t < 8 ? 512 + t * BK : u.pn * 128 + (t - 8) * BK; } };

struct StaticOrder {
    int nM, nN, nwg, G, c;
    __device__ __forceinline__ void init(int M, int N, int G_, int c_) { nM = M / BM; nN = N / BM; nwg = nM * nN; G = G_; c = c_; }
    __device__ __forceinline__ bool next(int i, Unit& u) const {
        const long L = (long)i * G + c; if (i > 0 && L >= nwg) return false;
        int wgid = (int)L; { const int q = nwg / NXCD, r = nwg % NXCD, xcd = wgid % NXCD, off = wgid / NXCD; wgid = (xcd < r ? xcd * (q + 1) : r * (q + 1) + (xcd - r) * q) + off; }
        const int nig = WGM * nN, gid = wgid / nig, fm = gid * WGM, gsz = (nM - fm) < WGM ? (nM - fm) : WGM;
        u.pm = __builtin_amdgcn_readfirstlane(fm + ((wgid % nig) % gsz)); u.pn = __builtin_amdgcn_readfirstlane((wgid % nig) / gsz); u.pb = u.pn; return true;
    }
};
struct HotOrder { int NU; int c; __device__ __forceinline__ bool next(int i, Unit& u) const { if (i >= NU) return false; u.pm = 0; u.pn = 0; u.pb = 0; return true; } };
struct MoeOrder {
    int nM, nN, nwg, G, c; const LAS unsigned* ptab;
    __device__ __forceinline__ void init(const LAS unsigned* pt, int N, int G_, int c_) { ptab = pt; nM = __builtin_amdgcn_readfirstlane((int)pt[0]); nN = N / BM; nwg = nM * nN; G = G_; c = c_; }
    __device__ __forceinline__ bool next(int i, Unit& u) const {
        const long L = (long)i * G + c; if (i > 0 && L >= nwg) return false;
        int wgid = (int)L; { const int q = nwg / NXCD, r = nwg % NXCD, xcd = wgid % NXCD, off = wgid / NXCD; wgid = (xcd < r ? xcd * (q + 1) : r * (q + 1) + (xcd - r) * q) + off; }
        const int nig = WGM * nN, gid = wgid / nig, fm = gid * WGM, gsz = (nM - fm) < WGM ? (nM - fm) : WGM;
        u.pm = __builtin_amdgcn_readfirstlane(fm + ((wgid % nig) % gsz)); u.pn = __builtin_amdgcn_readfirstlane((wgid % nig) / gsz);
        u.pb = __builtin_amdgcn_readfirstlane((int)ptab[1 + u.pm]) * nN + u.pn; return true;
    }
};

struct MoeOrder2 {
    int nM, mainP, tailP, S, Um, nwg, G, c; const LAS unsigned* ptab;
    static __device__ __forceinline__ void split(int nM_, int G_, int& mainP_, int& tailP_, int& S_) {
        tailP_ = (G_ % 4 == 0) ? nM_ % (G_ / 4) : 0; S_ = tailP_ == 0 ? 1 : (28 * tailP_ <= G_ ? 7 : (8 * tailP_ <= G_ ? 2 : 1));
        if (S_ == 1) tailP_ = 0; mainP_ = nM_ - tailP_; }
    __device__ __forceinline__ void init(const LAS unsigned* pt, int G_, int c_) { ptab = pt; nM = __builtin_amdgcn_readfirstlane((int)pt[0]); G = G_; c = c_; split(nM, G, mainP, tailP, S); mainP = __builtin_amdgcn_readfirstlane(mainP); tailP = __builtin_amdgcn_readfirstlane(tailP); S = __builtin_amdgcn_readfirstlane(S); Um = mainP * 4; nwg = Um + tailP * 4 * S; }
    __device__ __forceinline__ bool next(int i, Unit& u) const {
        const long L = (long)i * G + c; if (i > 0 && L >= nwg) return false;
        if (L < Um) { int wgid = (int)L; { const int q = Um / NXCD, r = Um % NXCD, xcd = wgid % NXCD, off = wgid / NXCD; wgid = (xcd < r ? xcd * (q + 1) : r * (q + 1) + (xcd - r) * q) + off; }
            const int nig = WGM * 4, gid = wgid / nig, fm = gid * WGM, gsz = (mainP - fm) < WGM ? (mainP - fm) : WGM;
            u.pm = __builtin_amdgcn_readfirstlane(fm + ((wgid % nig) % gsz)); u.pn = __builtin_amdgcn_readfirstlane((wgid % nig) / gsz); u.kt0 = 0; u.ntu = 28; u.part = -1; }
        else { const int q = (int)L - Um, j = q / S, sp = q % S; u.pm = __builtin_amdgcn_readfirstlane(mainP + j / 4); u.pn = __builtin_amdgcn_readfirstlane(j % 4); u.ntu = __builtin_amdgcn_readfirstlane(28 / S); u.kt0 = __builtin_amdgcn_readfirstlane(sp * (28 / S)); u.part = __builtin_amdgcn_readfirstlane(sp); }
        u.pb = __builtin_amdgcn_readfirstlane((int)ptab[1 + u.pm]) * 4 + u.pn; return true;
    }
};

typedef f32x4 Acc[2][2][4][2];

__device__ __forceinline__ u32x4 pack8(const f32x4 v0, const f32x4 v1) { u32x4 w; w.x = cvt_pk_bf16(v0[0], v0[1]); w.y = cvt_pk_bf16(v0[2], v0[3]); w.z = cvt_pk_bf16(v1[0], v1[1]); w.w = cvt_pk_bf16(v1[2], v1[3]); return w; }
__device__ __forceinline__ void unpack8(const u32x4 w, f32x4& v0, f32x4& v1) { v0 = (f32x4){bf_lo(w.x), bf_hi(w.x), bf_lo(w.y), bf_hi(w.y)}; v1 = (f32x4){bf_lo(w.z), bf_hi(w.z), bf_lo(w.w), bf_hi(w.w)}; }

__device__ __forceinline__ unsigned long long uni64(const GAS char* p) { const unsigned long long v = (unsigned long long)p; const unsigned lo = __builtin_amdgcn_readfirstlane((unsigned)v), hi = __builtin_amdgcn_readfirstlane((unsigned)(v >> 32)); return ((unsigned long long)hi << 32) | lo; }
typedef short s16x2 __attribute__((ext_vector_type(2)));
__device__ __forceinline__ unsigned pk_fp8x4_s(float a, float b, float c, float d, float scale) { s16x2 w = {0, 0}; w = __builtin_amdgcn_cvt_scalef32_pk_fp8_f32(w, a, b, scale, false); w = __builtin_amdgcn_cvt_scalef32_pk_fp8_f32(w, c, d, scale, true); return __builtin_bit_cast(unsigned, w); }
__device__ __forceinline__ unsigned pk_fp8x4(float a, float b, float c, float d) { int w = __builtin_amdgcn_cvt_pk_fp8_f32(a, b, 0, false); w = __builtin_amdgcn_cvt_pk_fp8_f32(c, d, w, true); return (unsigned)w; }

__device__ __forceinline__ void unpack_fp8x8(const u32x2 w, f32x4& a, f32x4& b) {
    const f32x2 a0 = __builtin_amdgcn_cvt_pk_f32_fp8((int)w.x, false), a1 = __builtin_amdgcn_cvt_pk_f32_fp8((int)w.x, true), b0 = __builtin_amdgcn_cvt_pk_f32_fp8((int)w.y, false), b1 = __builtin_amdgcn_cvt_pk_f32_fp8((int)w.y, true);
    a = (f32x4){a0.x, a0.y, a1.x, a1.y}; b = (f32x4){b0.x, b0.y, b1.x, b1.y}; }

struct PreNone { static constexpr bool HAS_PRE = false;
    __device__ __forceinline__ void issue(const Unit&, int, int) const {}
    __device__ __forceinline__ void finish(int) const {} };
struct PreSsq4 { static constexpr bool HAS_PRE = true;
    gcf_t ssq4; LAS float* rtab; LAS float* raw;
    __device__ __forceinline__ void issue(const Unit& u, int tid, int wid) const {
        if (wid < 4) { int te = tid; asm volatile("" : "+v"(te)); const unsigned vo = (unsigned)te * 4u, l0 = (unsigned)(size_t)raw + (unsigned)wid * 256u;
#pragma unroll
            for (int k = 0; k < 4; ++k) { unsigned keep;
                asm volatile("s_mov_b32 %0, m0\n\ts_mov_b32 m0, %3\n\ts_nop 0\n\tglobal_load_lds_dword %1, %2\n\ts_mov_b32 m0, %0" : "=&s"(keep) : "v"(vo), "s"(uni64((const GAS char*)(ssq4 + u.pm * BM + k * NTOK))), "s"(l0 + (unsigned)k * 1024u) : "memory"); } } }
    __device__ __forceinline__ void finish(int tid) const {
        asm volatile("s_waitcnt vmcnt(16)" ::: "memory");
        int te = tid; asm volatile("" : "+v"(te));
        if (te < 256) { const unsigned la = (unsigned)(size_t)raw + (unsigned)te * 4u; float a, b, c, d;
            asm volatile("ds_read_b32 %0, %4\n\tds_read_b32 %1, %4 offset:1024\n\tds_read_b32 %2, %4 offset:2048\n\tds_read_b32 %3, %4 offset:3072\n\ts_waitcnt lgkmcnt(0)" : "=&v"(a), "=&v"(b), "=&v"(c), "=&v"(d) : "v"(la) : "memory");
            rtab[te] = __builtin_amdgcn_rsqf(((a + b) + (c + d)) * (1.0f / DM) + RMS_EPS); } } };
struct PreRow { static constexpr bool HAS_PRE = true;
    gcf_t rrow; LAS float* rtab; LAS float* raw;
    __device__ __forceinline__ void issue(const Unit& u, int tid, int wid) const {
        if (wid < 4) { int te = tid; asm volatile("" : "+v"(te)); const unsigned vo = (unsigned)te * 4u, l0 = (unsigned)(size_t)raw + (unsigned)wid * 256u; unsigned keep;
            asm volatile("s_mov_b32 %0, m0\n\ts_mov_b32 m0, %3\n\ts_nop 0\n\tglobal_load_lds_dword %1, %2\n\ts_mov_b32 m0, %0" : "=&s"(keep) : "v"(vo), "s"(uni64((const GAS char*)(rrow + u.pm * BM))), "s"(l0) : "memory"); } }
    __device__ __forceinline__ void finish(int tid) const {
        asm volatile("s_waitcnt vmcnt(16)" ::: "memory");
        int te = tid; asm volatile("" : "+v"(te));
        if (te < 256) { const unsigned la = (unsigned)(size_t)raw + (unsigned)te * 4u; float a;
            asm volatile("ds_read_b32 %0, %1\n\ts_waitcnt lgkmcnt(0)" : "=&v"(a) : "v"(la) : "memory");
            rtab[te] = a; } } };

struct EpiIn {
    static constexpr bool HAS_MID = false; static constexpr int MID_T = -1; typedef PreSsq4 Pre;
    Pre pre; gbf_t U, P, RQ, SGP; float ascale;
    __device__ __forceinline__ void mid(Acc&, const Unit&, int, int, int, int) const {}
    __device__ __forceinline__ void operator()(const Acc& acc, const Unit& u, int wr, int wc, int fr, int fq) const {
        const int rl0 = wr * 64 + fr, row0 = u.pm * BM + rl0, cw = wc * 32 + 8 * fq;
        float rs[2][4];
#pragma unroll
        for (int ai = 0; ai < 2; ++ai)
#pragma unroll
            for (int m = 0; m < 4; ++m) rs[ai][m] = pre.rtab[rl0 + ai * HALF + m * 16] * ascale;
        if (u.pn < 4) {
#pragma unroll
            for (int ai = 0; ai < 2; ++ai)
#pragma unroll
                for (int m = 0; m < 4; ++m) { const int row = row0 + ai * HALF + m * 16; const float r = rs[ai][m], rn = r * -1.4426950408889634f; f32x4 o[2];
#pragma unroll
                    for (int n = 0; n < 2; ++n)
#pragma unroll
                        for (int j = 0; j < 4; ++j) { const float a = acc[ai][0][m][n][j] * r, e = __builtin_amdgcn_exp2f(acc[ai][1][m][n][j] * rn); o[n][j] = a * __builtin_amdgcn_rcpf(1.0f + e); }
                    ST4U(U + ((unsigned)row * CONV_DIM + u.pn * 128 + cw)) = pack8(o[0], o[1]); }
        } else if (u.pn < 6) {
#pragma unroll
            for (int ai = 0; ai < 2; ++ai)
#pragma unroll
                for (int m = 0; m < 4; ++m) { const int row = row0 + ai * HALF + m * 16; const float r = rs[ai][m];
#pragma unroll
                    for (int bj = 0; bj < 2; ++bj) ST4U(P + ((unsigned)row * 512 + (u.pn - 4) * 256 + bj * HALF + cw)) = pack8(acc[ai][bj][m][0] * r, acc[ai][bj][m][1] * r); }
        } else {
#pragma unroll
            for (int ai = 0; ai < 2; ++ai)
#pragma unroll
                for (int m = 0; m < 4; ++m) { const int row = row0 + ai * HALF + m * 16; const float rn = rs[ai][m] * -1.4426950408889634f; unsigned qc[2][4], qp[2][4];
#pragma unroll
                    for (int n = 0; n < 2; ++n)
#pragma unroll
                        for (int j = 0; j < 4; ++j) { const float ec = __builtin_amdgcn_exp2f(acc[ai][0][m][n][j] * rn), ep = __builtin_amdgcn_exp2f(acc[ai][1][m][n][j] * rn);
                            qc[n][j] = __float_as_uint(__builtin_fmaf(__builtin_amdgcn_rcpf(1.0f + ec), 255.0f, 8388608.0f));
                            qp[n][j] = __float_as_uint(__builtin_fmaxf(__builtin_amdgcn_rcpf(1.0f + ep) * 255.0f, 1.0f) + 8388608.0f); }
                    const unsigned off = (unsigned)row * DM + (u.pn - 6) * 128 + cw;
                    u32x4 wq;
#pragma unroll
                    for (int d = 0; d < 4; ++d) { const int n = d >> 1, j = 2 * (d & 1);
                        wq[d] = __builtin_amdgcn_perm(__builtin_amdgcn_perm(qp[n][j + 1], qc[n][j + 1], 0x0c0c0400u), __builtin_amdgcn_perm(qp[n][j], qc[n][j], 0x0c0c0400u), 0x05040100u); }
                    ST4U((GAS unsigned char*)RQ + 2u * off) = wq; }
        }
    }
};
__device__ __forceinline__ u32x4 widen8(u32x2 a, u32x2 b) {
    const auto rx = __builtin_amdgcn_permlane16_swap(a.x, b.x, false, false), ry = __builtin_amdgcn_permlane16_swap(a.y, b.y, false, false);
    u32x4 o; o.x = rx[0]; o.y = ry[0]; o.z = rx[1]; o.w = ry[1]; return o; }
__device__ __forceinline__ void unpack_gates(const u32x4 w, f32x4& c0, f32x4& c1, f32x4& p0, f32x4& p1) {
    c0 = (f32x4){(float)(w.x & 255u), (float)((w.x >> 16) & 255u), (float)(w.y & 255u), (float)((w.y >> 16) & 255u)}; p0 = (f32x4){(float)((w.x >> 8) & 255u), (float)(w.x >> 24), (float)((w.y >> 8) & 255u), (float)(w.y >> 24)};
    c1 = (f32x4){(float)(w.z & 255u), (float)((w.z >> 16) & 255u), (float)(w.w & 255u), (float)((w.w >> 16) & 255u)}; p1 = (f32x4){(float)((w.z >> 8) & 255u), (float)(w.z >> 24), (float)((w.w >> 8) & 255u), (float)(w.w >> 24)}; }
template <bool F8  > struct EpiMerge {
    static constexpr bool HAS_MID = true; static constexpr int MID_T = 8; typedef PreNone Pre;
    Pre pre; gcbf_t RQ, SGP; gbf_t MG;
    __device__ __forceinline__ void mid(Acc& acc, const Unit& u, int wr, int wc, int fr, int fq) const {
        const int row0 = u.pm * BM + wr * 64 + fr, col0 = u.pn * BM + wc * 32 + 8 * fq;
        u32x4 wg_[2][4][2];
#pragma unroll
        for (int ai = 0; ai < 2; ++ai)
#pragma unroll
            for (int m = 0; m < 4; ++m)
#pragma unroll
                for (int bj = 0; bj < 2; ++bj) wg_[ai][m][bj] = LD4U((const GAS unsigned char*)RQ + 2u * ((unsigned)(row0 + ai * HALF + m * 16) * DM + col0 + bj * HALF));
        __builtin_amdgcn_sched_barrier(0);
#pragma unroll
        for (int ai = 0; ai < 2; ++ai)
#pragma unroll
            for (int m = 0; m < 4; ++m)
#pragma unroll
                for (int bj = 0; bj < 2; ++bj) { f32x4 c0, c1, p0, p1; unpack_gates(wg_[ai][m][bj], c0, c1, p0, p1);
#pragma unroll
                    for (int j = 0; j < 4; ++j) { acc[ai][bj][m][0][j] *= c0[j] * __builtin_amdgcn_rcpf(p0[j]); acc[ai][bj][m][1][j] *= c1[j] * __builtin_amdgcn_rcpf(p1[j]); } }
    }
    __device__ __forceinline__ void operator()(const Acc& acc, const Unit& u, int wr, int wc, int fr, int fq) const {
        const int row0 = u.pm * BM + wr * 64 + fr, col0 = u.pn * BM + wc * 32 + 8 * fq;
        u32x4 w[2][4][2]; u32x2 o8[2][2]; (void)o8;
#pragma unroll
        for (int ai = 0; ai < 2; ++ai)
#pragma unroll
            for (int m = 0; m < 4; ++m)
#pragma unroll
                for (int bj = 0; bj < 2; ++bj) w[ai][m][bj] = LD4U((const GAS unsigned char*)RQ + 2u * ((unsigned)(row0 + ai * HALF + m * 16) * DM + col0 + bj * HALF));
        __builtin_amdgcn_sched_barrier(0);
#pragma unroll
        for (int ai = 0; ai < 2; ++ai)
#pragma unroll
            for (int m = 0; m < 4; ++m)
#pragma unroll
                for (int bj = 0; bj < 2; ++bj) { f32x4 c0, c1, s0, s1; unpack_gates(w[ai][m][bj], c0, c1, s0, s1); (void)c0; (void)c1; const f32x4 a = acc[ai][bj][m][0] * (s0 * (1.0f / 255.0f)), b = acc[ai][bj][m][1] * (s1 * (1.0f / 255.0f));
                    if constexpr (F8) { o8[m & 1][bj].x = pk_fp8x4(a[0], a[1], a[2], a[3]); o8[m & 1][bj].y = pk_fp8x4(b[0], b[1], b[2], b[3]);
                        if (m & 1) ST4U((GAS unsigned char*)MG + ((unsigned)(row0 + ai * HALF + (m - 1) * 16 + (fq & 1) * 16) * DM + (col0 - 8 * (fq & 1)) + bj * HALF)) = widen8(o8[0][bj], o8[1][bj]); }
                    else ST4U(MG + ((unsigned)(row0 + ai * HALF + m * 16) * DM + col0 + bj * HALF)) = pack8(a, b); }
    }
};
struct EpiRes {
    static constexpr bool HAS_MID = false; static constexpr int MID_T = -1; typedef PreNone Pre;
    Pre pre; gbf_t xs; gf_t ssq4; LAS float* stab; float scale; GAS unsigned char* xb8;
    __device__ __forceinline__ void mid(Acc&, const Unit&, int, int, int, int) const {}
    __device__ __forceinline__ void operator()(const Acc& acc, const Unit& u, int wr, int wc, int fr, int fq) const {
        const int rl0 = wr * 64 + fr, col0 = u.pn * BM + wc * 32 + 8 * fq;
        u32x4 xw[2][4][2]; u32x2 w8[2][2];
#pragma unroll
        for (int ai = 0; ai < 2; ++ai)
#pragma unroll
            for (int m = 0; m < 4; ++m)
#pragma unroll
                for (int bj = 0; bj < 2; ++bj) xw[ai][m][bj] = LD4U(xs + ((unsigned)(u.pm * BM + rl0 + ai * HALF + m * 16) * DM + col0 + bj * HALF));
#pragma unroll
        for (int ai = 0; ai < 2; ++ai)
#pragma unroll
            for (int m = 0; m < 4; ++m) { const int rl = rl0 + ai * HALF + m * 16; const unsigned off = (unsigned)(u.pm * BM + rl) * DM + col0; float ss = 0.f;
#pragma unroll
                for (int bj = 0; bj < 2; ++bj) { f32x4 x0, x1; unpack8(xw[ai][m][bj], x0, x1);
                    const f32x4 y0 = x0 + acc[ai][bj][m][0] * scale, y1 = x1 + acc[ai][bj][m][1] * scale;
                    ST4U(xs + off + bj * HALF) = pack8(y0, y1);
                    if (xb8) { w8[m & 1][bj].x = pk_fp8x4(y0[0], y0[1], y0[2], y0[3]); w8[m & 1][bj].y = pk_fp8x4(y1[0], y1[1], y1[2], y1[3]);
                        if (m & 1) ST4U(xb8 + ((unsigned)(u.pm * BM + rl - 16 + (fq & 1) * 16) * DM + (col0 - 8 * (fq & 1)) + bj * HALF)) = widen8(w8[0][bj], w8[1][bj]); }
                    ss += ((y0[0] * y0[0] + y0[1] * y0[1]) + (y0[2] * y0[2] + y0[3] * y0[3])) + ((y1[0] * y1[0] + y1[1] * y1[1]) + (y1[2] * y1[2] + y1[3] * y1[3])); }
                ss += shx<16>(ss, fq * 16 + fr); ss += shx<32>(ss, fq * 16 + fr);
                if (fq == 0) stab[rl * 4 + wc] = ss; }
        asm volatile("s_waitcnt lgkmcnt(0)" ::: "memory"); __builtin_amdgcn_s_barrier(); asm volatile("" ::: "memory");
        const int tid = (wr * 4 + wc) * 64 + fq * 16 + fr;
        if (tid < 256) { const f32x4 v = *(const LAS f32x4*)(stab + tid * 4); ssq4[(unsigned)(u.pn * NTOK + u.pm * BM + tid)] = (v[0] + v[1]) + (v[2] + v[3]); }
    }
};
template <class PRE, bool O8  > struct EpiSwiglu {
    static constexpr bool HAS_MID = false; static constexpr int MID_T = -1; typedef PRE Pre;
    Pre pre; GAS void* Hv; int ldh;
    __device__ __forceinline__ void mid(Acc&, const Unit&, int, int, int, int) const {}
    __device__ __forceinline__ void operator()(const Acc& acc, const Unit& u, int wr, int wc, int fr, int fq) const {
        const int rl0 = wr * 64 + fr, row0 = u.pm * BM + rl0, cw = wc * 32 + 8 * fq;
        float rs[2][4]; u32x2 w8[2]; (void)w8;
#pragma unroll
        for (int ai = 0; ai < 2; ++ai)
#pragma unroll
            for (int m = 0; m < 4; ++m) rs[ai][m] = pre.rtab[rl0 + ai * HALF + m * 16] * (O8 ? 0.03125f : 1.0f);
#pragma unroll
        for (int ai = 0; ai < 2; ++ai)
#pragma unroll
            for (int m = 0; m < 4; ++m) { const int row = row0 + ai * HALF + m * 16; const float r = rs[ai][m], rr = O8 ? r * r * 4.0f : r * r, rn = r * -1.4426950408889634f; f32x4 o[2];
#pragma unroll
                for (int n = 0; n < 2; ++n)
#pragma unroll
                    for (int j = 0; j < 4; ++j) { float tg; asm("v_mul_f32 %0, %1, %2" : "=v"(tg) : "v"(acc[ai][0][m][n][j]), "v"(acc[ai][1][m][n][j]));
                        const float e = __builtin_amdgcn_exp2f(acc[ai][0][m][n][j] * rn); o[n][j] = tg * (rr * __builtin_amdgcn_rcpf(1.0f + e)); }
                if constexpr (O8) { w8[m & 1].x = pk_fp8x4(o[0][0], o[0][1], o[0][2], o[0][3]); w8[m & 1].y = pk_fp8x4(o[1][0], o[1][1], o[1][2], o[1][3]);
                    if (m & 1) ST4U((GAS unsigned char*)Hv + ((unsigned)(row - 16 + (fq & 1) * 16) * ldh + u.pn * 128 + cw - 8 * (fq & 1))) = widen8(w8[0], w8[1]); }
                else ST4U((gbf_t)Hv + ((unsigned)row * ldh + u.pn * 128 + cw)) = pack8(o[0], o[1]); }
    }
};
struct EpiSwiglu8 {
    static constexpr bool HAS_MID = false; static constexpr int MID_T = -1; typedef PreNone Pre;
    Pre pre; GAS unsigned char* H; int ldh;
    __device__ __forceinline__ void mid(Acc&, const Unit&, int, int, int, int) const {}
    __device__ __forceinline__ void operator()(const Acc& acc, const Unit& u, int wr, int wc, int fr, int fq) const {
        float c256 = 256.0f; asm volatile("" : "+s"(c256));
        const int row0 = u.pm * BM + wr * 64 + fr + (fq & 1) * 16, cw = wc * 32 + 8 * (fq & ~1);
#pragma unroll
        for (int ai = 0; ai < 2; ++ai)
#pragma unroll
            for (int mp = 0; mp < 2; ++mp) { u32x2 w[2];
#pragma unroll
                for (int q = 0; q < 2; ++q) { const int m = 2 * mp + q; f32x4 o[2];
#pragma unroll
                    for (int n = 0; n < 2; ++n)
#pragma unroll
                        for (int j = 0; j < 4; ++j) { float tg; asm("v_mul_f32 %0, %1, %2" : "=v"(tg) : "v"(acc[ai][0][m][n][j]), "v"(acc[ai][1][m][n][j]));
                            const float e = __builtin_amdgcn_exp2f(acc[ai][0][m][n][j] * (-0.03125f * 1.4426950408889634f)); o[n][j] = tg * __builtin_amdgcn_rcpf(1.0f + e); }
                    w[q].x = pk_fp8x4_s(o[0][0], o[0][1], o[0][2], o[0][3], c256); w[q].y = pk_fp8x4_s(o[1][0], o[1][1], o[1][2], o[1][3], c256); }
                ST4U(H + ((unsigned)(row0 + ai * HALF + mp * 32) * ldh + u.pn * 128 + cw)) = widen8(w[0], w[1]); }
    }
};
constexpr int TAIL_ROWS = 9 * 256;
constexpr int TAIL_ROWS2 = 32 * 256;
struct EpiY {
    static constexpr bool HAS_MID = false; static constexpr int MID_T = -1; typedef PreNone Pre;
    Pre pre; gbf_t Y; float scale; gbf_t YP; int main_rows, slab_rows;
    __device__ __forceinline__ void mid(Acc&, const Unit&, int, int, int, int) const {}
    __device__ __forceinline__ void operator()(const Acc& acc, const Unit& u, int wr, int wc, int fr, int fq) const {
        const int row0 = u.pm * BM + wr * 64 + fr, col0 = u.pn * BM + wc * 32 + 8 * fq;
        if (u.part < 0) { GAS unsigned char* base = (GAS unsigned char*)Y + (unsigned)(row0 + (fq & 1) * 16) * DM + (col0 - 8 * (fq & 1)); const float s16 = scale * 16.0f;
#pragma unroll
            for (int ai = 0; ai < 2; ++ai)
#pragma unroll
                for (int mp = 0; mp < 2; ++mp)
#pragma unroll
                    for (int bj = 0; bj < 2; ++bj) { u32x2 w[2];
#pragma unroll
                        for (int q = 0; q < 2; ++q) { const f32x4 a = acc[ai][bj][2 * mp + q][0] * s16, b = acc[ai][bj][2 * mp + q][1] * s16; w[q].x = pk_fp8x4(a[0], a[1], a[2], a[3]); w[q].y = pk_fp8x4(b[0], b[1], b[2], b[3]); }
                        ST4U(base + ((unsigned)(ai * HALF + mp * 32) * DM + bj * HALF)) = widen8(w[0], w[1]); }
        } else { gbf_t base = YP + (unsigned)(u.part * slab_rows + row0 - main_rows) * DM;
#pragma unroll
            for (int ai = 0; ai < 2; ++ai)
#pragma unroll
                for (int m = 0; m < 4; ++m) { gbf_t rp = base + ((unsigned)(ai * HALF + m * 16) * DM + col0);
#pragma unroll
                    for (int bj = 0; bj < 2; ++bj) ST4U(rp + bj * HALF) = pack8(acc[ai][bj][m][0] * scale, acc[ai][bj][m][1] * scale); } }
    }
};

typedef int i32x4 __attribute__((ext_vector_type(4)));
typedef int i32x8 __attribute__((ext_vector_type(8)));
#ifndef SG_OUT
#define SG_MG 0
#define SG_OUT 0
#define SG_F2 0
#endif
#ifndef STAG_STEP
#define STAG_STEP 0
#endif
template <class Epi, class Sched, class KA, bool FP8 = false, bool VARK = false>
__device__ __forceinline__ void gemm_phase(LAS unsigned char* lds, const Gemm g, const Sched& S, const Epi& E, int wave_) {
    { const int grp = (S.c >> 3) % g.sg_n;
      if (g.sg_k > 0) { for (int q = 0; q < grp * g.sg_k; ++q) __builtin_amdgcn_s_sleep(100); } else if (STAG_STEP > 0) { for (int q = 0; q < grp; ++q) __builtin_amdgcn_s_sleep(STAG_STEP); } }
    int tid_ = hw_tid(wave_); asm volatile("" : "+v"(tid_));
    const int tid = tid_, wid = __builtin_amdgcn_readfirstlane(tid >> 6), lane = tid & 63, wr = wid >> 2, wc = wid & 3, fr = lane & 15, fq = lane >> 4;
    const int K = g.K, nt = K / BK;
    unsigned voffA[2], voffB[2];
#pragma unroll
    for (int i = 0; i < 2; ++i) { int R, C; stage_rc(tid * 16 + i * 8192, R, C); const int Rb = (R & ~31) + perm32(R & 31);
        voffA[i] = (unsigned)(R * g.lda + C) * 2u; voffB[i] = (unsigned)(Rb * g.ldb + C) * 2u; }
    const size_t kstep = (size_t)(BK * 2);
    const size_t hstepA = (size_t)HALF * g.lda * 2, hstepB = (size_t)HALF * g.ldb * 2;
    const size_t tstepA = 2 * hstepA, tstepB = 2 * hstepB;
    const unsigned ldsw = (unsigned)wid * 1024u, lds0 = (unsigned)(size_t)lds;
    const int aoff = lds_byte(wr * 64 + fr, fq * 8), boff = lds_byte(wc * 32 + fr, fq * 8);
#define PG8_SA(b, h) (((b) * 2 + (h)) * HTB)
#define PG8_SB(b, h) ((4 + (b) * 2 + (h)) * HTB)
#define PG8_STAGE(bufoff, gbase, voff) do { _Pragma("unroll") for (int _i = 0; _i < 2; ++_i) { unsigned _keep; \
        asm volatile("s_mov_b32 %0, m0\n\ts_mov_b32 m0, %3\n\ts_nop 0\n\tglobal_load_lds_dwordx4 %1, %2\n\ts_mov_b32 m0, %0" : "=&s"(_keep) : "v"((voff)[_i]), "s"(uni64(gbase)), "s"(lds0 + (unsigned)(bufoff) + ldsw + (unsigned)(_i * 8192)) : "memory"); } } while (0)
#define PG8_LDA(dst, b, h) do { _Pragma("unroll") for (int m = 0; m < 4; ++m) { if constexpr (FP8) dst##8[m] = __builtin_shufflevector(*(const LAS i32x4*)(lds + PG8_SA(b, h) + aoff + m * 2048), *(const LAS i32x4*)(lds + PG8_SA(b, h) + aoff + m * 2048 + 1024), 0, 1, 2, 3, 4, 5, 6, 7); \
        else { _Pragma("unroll") for (int k = 0; k < 2; ++k) dst[m][k] = *(const LAS bf16x8*)(lds + PG8_SA(b, h) + aoff + m * 2048 + k * 1024); } } } while (0)
#define PG8_LDB(dst, b, h) do { _Pragma("unroll") for (int n = 0; n < 2; ++n) { if constexpr (FP8) dst##8[n] = __builtin_shufflevector(*(const LAS i32x4*)(lds + PG8_SB(b, h) + boff + n * 2048), *(const LAS i32x4*)(lds + PG8_SB(b, h) + boff + n * 2048 + 1024), 0, 1, 2, 3, 4, 5, 6, 7); \
        else { _Pragma("unroll") for (int k = 0; k < 2; ++k) dst[n][k] = *(const LAS bf16x8*)(lds + PG8_SB(b, h) + boff + n * 2048 + k * 1024); } } } while (0)
#define PG8_MMA(ai, bj, At, Bt) do { __builtin_amdgcn_s_setprio(1); _Pragma("unroll") for (int m = 0; m < 4; ++m) _Pragma("unroll") for (int n = 0; n < 2; ++n) { \
        if constexpr (FP8) { acc[ai][bj][m][n] = __builtin_amdgcn_mfma_scale_f32_16x16x128_f8f6f4(Bt##8[n], At##8[m], acc[ai][bj][m][n], 0, 0, 0, 0, 0, 0); } \
        else { _Pragma("unroll") for (int k = 0; k < 2; ++k) acc[ai][bj][m][n] = __builtin_amdgcn_mfma_f32_16x16x32_bf16(Bt[n][k], At[m][k], acc[ai][bj][m][n], 0, 0, 0); } } \
        __builtin_amdgcn_s_setprio(0); } while (0)
#define PG8_WAIT_V(n) asm volatile("s_waitcnt vmcnt(" #n ")" ::: "memory")
#define PG8_WAIT_L(n) asm volatile("s_waitcnt lgkmcnt(" #n ")" ::: "memory")
#define PG8_BAR __builtin_amdgcn_s_barrier()
#define PG8_SCHED __builtin_amdgcn_sched_barrier(0)
    Unit cur, nxt; int ui = 0;
    if (!S.next(0, cur)) return;
    Acc acc;
    {
#pragma unroll
    for (int a = 0; a < 2; ++a)
#pragma unroll
        for (int b = 0; b < 2; ++b)
#pragma unroll
            for (int m = 0; m < 4; ++m)
#pragma unroll
                for (int n = 0; n < 2; ++n) acc[a][b][m][n] = (f32x4){0.f, 0.f, 0.f, 0.f}; }
    bf16x8 At[4][2], B0[2][2], B1[2][2];
    i32x8 At8[4], B08[2], B18[2];
    typedef const GAS char* gcc_t;
    gcc_t cA = (gcc_t)g.A + (size_t)cur.pm * tstepA; gcc_t cB = (gcc_t)g.Bt + (size_t)cur.pb * tstepB + (VARK ? (size_t)cur.kt0 * kstep : 0);
    {
        gcc_t a0 = cA + (size_t)KA::koff(cur, 0) * 2; gcc_t a1 = cA + (size_t)KA::koff(cur, 1) * 2;
        PG8_STAGE(PG8_SB(0, 0), cB, voffB); PG8_STAGE(PG8_SB(0, 1), cB + hstepB, voffB); PG8_STAGE(PG8_SA(0, 0), a0, voffA); PG8_STAGE(PG8_SA(0, 1), a0 + hstepA, voffA);
        if (wr == 1) PG8_BAR;
        PG8_WAIT_V(2); PG8_BAR;
        PG8_STAGE(PG8_SB(1, 0), cB + kstep, voffB); PG8_STAGE(PG8_SA(1, 0), a1, voffA); PG8_STAGE(PG8_SB(1, 1), cB + hstepB + kstep, voffB);
        PG8_WAIT_V(6); PG8_BAR;
    }
    for (;;) {
        const bool has_next = S.next(ui + 1, nxt);
        if (!has_next) nxt = cur;
        gcc_t nA = has_next ? (gcc_t)g.A + (size_t)nxt.pm * tstepA : cA; gcc_t nB = has_next ? (gcc_t)g.Bt + (size_t)nxt.pb * tstepB + (VARK ? (size_t)nxt.kt0 * kstep : 0) : cB;
        const int ntc = VARK ? cur.ntu : nt;
#pragma unroll 1
        for (int t = 0; t < ntc; t += 2) {
            const bool last = (t == ntc - 2);
            gcc_t a1 = cA + (size_t)KA::koff(cur, t + 1) * 2;
            gcc_t a2 = last ? nA + (size_t)KA::koff(nxt, 0) * 2 : cA + (size_t)KA::koff(cur, t + 2) * 2;
            gcc_t a3 = last ? nA + (size_t)KA::koff(nxt, 1) * 2 : cA + (size_t)KA::koff(cur, t + 3) * 2;
            gcc_t b2 = last ? nB : cB + (size_t)(t + 2) * kstep; gcc_t b3 = b2 + kstep;
            if constexpr (Epi::HAS_MID) { if (t == Epi::MID_T) { const int te = hw_tid(wave_); E.mid(acc, cur, wr, wc, te & 15, (te >> 4) & 3); } }
            if constexpr (Epi::Pre::HAS_PRE) { if (t == 0) E.pre.issue(cur, hw_tid(wave_), wid); if (t == 2) E.pre.finish(hw_tid(wave_)); }
            PG8_LDB(B0, 0, 0); PG8_LDB(B1, 0, 1); PG8_SCHED; PG8_LDA(At, 0, 0); PG8_STAGE(PG8_SA(1, 1), a1 + hstepA, voffA);
            PG8_WAIT_V(8); PG8_WAIT_L(0); PG8_BAR; PG8_MMA(0, 0, At, B0); PG8_MMA(0, 1, At, B1); PG8_BAR; PG8_SCHED;
            PG8_LDA(At, 0, 1); PG8_STAGE(PG8_SB(0, 0), b2, voffB); PG8_STAGE(PG8_SB(0, 1), b2 + hstepB, voffB); PG8_STAGE(PG8_SA(0, 0), a2, voffA);
            PG8_WAIT_V(8); PG8_WAIT_L(0); PG8_BAR; PG8_MMA(1, 0, At, B0); PG8_MMA(1, 1, At, B1); PG8_BAR; PG8_SCHED;
            PG8_LDB(B0, 1, 0); PG8_LDB(B1, 1, 1); PG8_SCHED; PG8_LDA(At, 1, 0); PG8_STAGE(PG8_SA(0, 1), a2 + hstepA, voffA);
            PG8_WAIT_V(8); PG8_WAIT_L(0); PG8_BAR; PG8_MMA(0, 0, At, B0); PG8_MMA(0, 1, At, B1); PG8_BAR; PG8_SCHED;
            PG8_LDA(At, 1, 1); PG8_STAGE(PG8_SB(1, 0), b3, voffB); PG8_STAGE(PG8_SB(1, 1), b3 + hstepB, voffB); PG8_STAGE(PG8_SA(1, 0), a3, voffA);
            PG8_WAIT_V(8); PG8_WAIT_L(0); PG8_BAR; PG8_MMA(1, 0, At, B0); PG8_MMA(1, 1, At, B1); PG8_BAR; PG8_SCHED;
        }
        if (wr == 0) PG8_BAR;
        { const int te = hw_tid(wave_); E(acc, cur, wr, wc, te & 15, (te >> 4) & 3); }
        if (!has_next) break;
        const LAS char* zp = (const LAS char*)(lds + RING_BYTES + 12288) + (hw_tid(wave_) & 63) * 16;
#pragma unroll
        for (int a = 0; a < 2; ++a)
#pragma unroll
            for (int b = 0; b < 2; ++b)
#pragma unroll
                for (int m = 0; m < 4; ++m)
#pragma unroll
                    for (int n = 0; n < 2; ++n) acc[a][b][m][n] = *(const LAS f32x4*)(zp + (((a * 2 + b) * 4 + m) * 2 + n) * 16);
        cur = nxt; cA = nA; cB = nB; ++ui;
        if (wr == 1) PG8_BAR;
    }
    PG8_WAIT_V(0);
    PG8_BAR;
#undef PG8_SA
#undef PG8_SB
#undef PG8_STAGE
#undef PG8_LDA
#undef PG8_LDB
#undef PG8_MMA
#undef PG8_WAIT_V
#undef PG8_WAIT_L
#undef PG8_BAR
#undef PG8_SCHED
}
}

#define XB_TMO      128
#define XB_XCNT(j)  (256  + 64 * (j))
#define XB_XSUB(j)  (1280 + 64 * (j))
#define XB_XGEN(j)  (2304 + 64 * (j))
#define XB_TOP      3328
#define XB_TOPGEN   3392
#define XCD_BAR_WORDS 3456
#define XB_SPIN_CAP (1u << 18)
__device__ __forceinline__ unsigned xb_ld(gu32* p)              { return __hip_atomic_load(p, __ATOMIC_RELAXED, __HIP_MEMORY_SCOPE_AGENT); }
__device__ __forceinline__ unsigned xb_add(gu32* p, unsigned v) { return __hip_atomic_fetch_add(p, v, __ATOMIC_RELAXED, __HIP_MEMORY_SCOPE_AGENT); }
__device__ __forceinline__ unsigned xb_xcc_id() { return (unsigned)__builtin_amdgcn_s_getreg((3 << 11) | 20) & 0xFu; }
#define XB_SPIN(cond, bar) do { unsigned _sp = 0; while (cond) { __builtin_amdgcn_s_sleep(1); \
    if ((++_sp & 255u) == 0u) { if (xb_ld(&(bar)[XB_TMO])) break; if (_sp > XB_SPIN_CAP) { (void)xb_add(&(bar)[XB_TMO], 1u); break; } } } } while (0)
struct XcdBarrier { gu32* bar; unsigned x; volatile LAS unsigned* st; };
__device__ __forceinline__ XcdBarrier xcd_barrier_post(gu32* bar, volatile LAS unsigned* st, int tid) {
    XcdBarrier b; b.bar = bar; b.x = xb_xcc_id(); b.st = st;
    if (tid == 0) (void)xb_add(&bar[XB_XCNT(b.x)], 1u);
    return b;
}
__device__ __forceinline__ void xcd_barrier_complete(gu32* bar, unsigned x, unsigned& nloc, unsigned& nx) {
    const unsigned G = gridDim.x * gridDim.y * gridDim.z;
    unsigned sum, cnt, mine, sp = 0u;
    for (;;) {
        sum = 0u; cnt = 0u; mine = 0u;
#pragma unroll
        for (unsigned j = 0; j < 16; ++j) { const unsigned c = xb_ld(&bar[XB_XCNT(j)]); sum += c; cnt += (c > 0u) ? 1u : 0u; mine = (j == x) ? c : mine; }
        if (sum == G) break;
        __builtin_amdgcn_s_sleep(1);
        if ((++sp & 255u) == 0u) { if (xb_ld(&bar[XB_TMO])) break; if (sp > XB_SPIN_CAP) { (void)xb_add(&bar[XB_TMO], 1u); break; } }
    }
    nloc = mine > 0u ? mine : 1u; nx = cnt > 0u ? cnt : 1u;
}
__device__ __forceinline__ void xcd_barrier(const XcdBarrier& b, int tid) {
    asm volatile("s_waitcnt vmcnt(0)" ::: "memory");
    __syncthreads();
    if (tid == 0) {
        gu32* bar = b.bar;
        __builtin_amdgcn_s_waitcnt(0);
        unsigned nloc = b.st[0], nx = b.st[1];
        if (nloc == 0u) { xcd_barrier_complete(bar, b.x, nloc, nx); b.st[0] = nloc; b.st[1] = nx; }
        const unsigned old = xb_add(&bar[XB_XSUB(b.x)], 1u);
        const unsigned gen = old / nloc;
        if (old + 1u == (gen + 1u) * nloc) {
            __builtin_amdgcn_fence(__ATOMIC_RELEASE, "agent");
            asm volatile("s_waitcnt vmcnt(0)" ::: "memory");
            const unsigned og = xb_add(&bar[XB_TOP], 1u);
            const unsigned tg = og / nx;
            if (og + 1u == (tg + 1u) * nx) xb_add(&bar[XB_TOPGEN], 1u);
            else XB_SPIN(xb_ld(&bar[XB_TOPGEN]) == tg, bar);
            __builtin_amdgcn_fence(__ATOMIC_ACQUIRE, "agent");
            asm volatile("s_waitcnt vmcnt(0)" ::: "memory");
        } else {
            XB_SPIN(xb_ld(&bar[XB_TOPGEN]) == gen, bar);
            __builtin_amdgcn_fence(__ATOMIC_ACQUIRE, "agent");
            asm volatile("s_waitcnt vmcnt(0)" ::: "memory");
        }
    }
    __syncthreads();
}

struct Args { const float* in[20]; float* out; unsigned char* ws; int ph_lo, ph_hi; };
enum { I_X = 0, I_MIXN, I_WIN, I_CDW, I_CDWB, I_CLNG, I_CLNB, I_WCO, I_WPOOL, I_PSC, I_WOUT, I_FFNN, I_DG, I_DU, I_DD, I_RW, I_MG, I_MU, I_MD, I_FIN };

typedef const float* cfp_t;
typedef __attribute__((address_space(4))) const char* kptr_t;
struct Frame {
    LAS unsigned char* lds;
    kptr_t kp; gf_t out; GAS unsigned char* ws;
    int tid, lane, wave, G, bid;
};
struct InPtrs { kptr_t kp;
    __device__ __forceinline__ explicit InPtrs(const Frame& F) : kp(F.kp) { asm volatile("" : "+s"(kp)); }
    __device__ __forceinline__ gcf_t operator[](int k) const { return (gcf_t)((__attribute__((address_space(4))) const cfp_t*)kp)[k]; } };
__device__ __forceinline__ gbf_t wsb(const Frame& F, size_t off) { return (gbf_t)(F.ws + off); }
__device__ __forceinline__ gf_t wsf(const Frame& F, size_t off) { return (gf_t)(F.ws + off); }
__device__ __forceinline__ gu_t wsu(const Frame& F, size_t off) { return (gu_t)(F.ws + off); }


__device__ __forceinline__ float rdl(float v, int l) { return __int_as_float(__builtin_amdgcn_readlane(__float_as_int(v), l)); }
template <bool FP8>
__device__ __forceinline__ void cvt_item(gcf_t W, int N, int k0, int n0, GAS void* dstv, int ldd, int drow0, int dcol0, gcf_t sk, gcf_t sn, float mul, LAS unsigned* scr, int lane) {
    const float sN = (sn ? sn[n0 + lane] : 1.0f) * mul;
    gcf_t src = W + (size_t)k0 * N + n0 + lane;
    gcf_t skp = sk ? sk + k0 : src; const float g0 = skp[lane], g1 = FP8 ? skp[64 + lane] : 0.f; (void)g1;
    if constexpr (!FP8) {
        gbf_t dst = (gbf_t)dstv;
#pragma unroll
        for (int h = 0; h < 2; ++h) { float v[32];
#pragma unroll
            for (int i = 0; i < 32; ++i) v[i] = src[(size_t)(32 * h + i) * N];
#pragma unroll
            for (int i = 0; i < 16; ++i) { float a = v[2 * i], b = v[2 * i + 1]; if (sk) { a *= rdl(g0, 32 * h + 2 * i); b *= rdl(g0, 32 * h + 2 * i + 1); }
                scr[lane * 33 + 16 * h + i] = cvt_pk_bf16(a * sN, b * sN); } }
    } else {
#pragma unroll
        for (int h = 0; h < 4; ++h) { float v[32]; const float gh = h < 2 ? g0 : g1; const int gb = 32 * (h & 1);
#pragma unroll
            for (int i = 0; i < 32; ++i) v[i] = src[(size_t)(32 * h + i) * N];
#pragma unroll
            for (int i = 0; i < 8; ++i) { float a = v[4 * i], b = v[4 * i + 1], c = v[4 * i + 2], d = v[4 * i + 3];
                if (sk) { a *= rdl(gh, gb + 4 * i); b *= rdl(gh, gb + 4 * i + 1); c *= rdl(gh, gb + 4 * i + 2); d *= rdl(gh, gb + 4 * i + 3); }
                int w = __builtin_amdgcn_cvt_pk_fp8_f32(a * sN, b * sN, 0, false); w = __builtin_amdgcn_cvt_pk_fp8_f32(c * sN, d * sN, w, true);
                scr[lane * 33 + 8 * h + i] = (unsigned)w; } }
    }
    LDS_WAIT(); asm volatile("" ::: "memory");
    {
        GAS unsigned char* dst = (GAS unsigned char*)dstv; const int c = lane & 7; const int esz = FP8 ? 1 : 2;
#pragma unroll
        for (int q = 0; q < 8; ++q) { const int j = (lane >> 3) + 8 * q; const LAS unsigned* s = scr + j * 33 + 4 * c;
            u32x4 o; o.x = s[0]; o.y = s[1]; o.z = s[2]; o.w = s[3];
            ST4U(dst + ((size_t)(drow0 + j) * ldd + dcol0 + k0) * esz + 16 * c) = o; }
    }
    LDS_WAIT(); asm volatile("" ::: "memory");
}
__device__ __forceinline__ int gu_row(int n0, int up) { return 256 * (n0 >> 7) + (n0 & 127) + 128 * up; }
__device__ __forceinline__ int win_row(int n0) {
    if (n0 < 512) return gu_row(n0, 0);
    if (n0 < 1024) return gu_row(n0 - 512, 1);
    if (n0 < 1536) return n0;
    if (n0 < 2560) return 1536 + gu_row(n0 - 1536, 0);
    return 1536 + gu_row(n0 - 2560, 1);
}
constexpr int IT_WIN = 16 * 56, IT_WCO = 8 * 16, IT_WPOOL = 2 * 4, IT_WOUT = 16 * 16, IT_DGU = 16 * 44, IT_DD = 44 * 16;
constexpr int NIT_A = DEPTH * IT_WIN, NIT_B = DEPTH * IT_WCO, NIT_C = DEPTH * 4 * IT_WPOOL, NIT_D = DEPTH * IT_WOUT, NIT_E = 2 * IT_DGU, NIT_E3 = 2 * IT_DD;
constexpr int NIT_PRO = (2 * IT_WIN + IT_WIN) + NIT_B + NIT_C + (2 * IT_WOUT + IT_WOUT) + (2 * IT_DGU + IT_DD) + (IT_DGU + IT_DD / 2);
constexpr int IT_MGU = 8 * 56, IT_MD = 28 * 16, NIT_MOE = NEXP * (2 * IT_MGU + IT_MD);
__device__ __forceinline__ void cvt_pro_item(const Frame& F, const InPtrs& IN, int r, LAS unsigned* scr) {
    if (r < 2 * IT_WIN) { const int L = r / IT_WIN, q = r % IT_WIN, kb = q / 56, nb = q % 56;
        cvt_item<false>(IN[I_WIN] + (size_t)L * DM * IN_COLS, IN_COLS, kb * 64, nb * 64, wsb(F, WS_WIN) + (size_t)L * IN_COLS * DM, DM, win_row(nb * 64), 0, IN[I_MIXN] + L * DM, nullptr, 1.0f, scr, F.lane); return; } r -= 2 * IT_WIN;
    if (r < IT_WIN) { const int L = 2 + r / (IT_WIN / 2), q = r % (IT_WIN / 2), kb = q / 56, nb = q % 56;
        cvt_item<true>(IN[I_WIN] + (size_t)L * DM * IN_COLS, IN_COLS, kb * 128, nb * 64, F.ws + WS_WIN8 + (size_t)(L - 2) * IN_COLS * DM, DM, win_row(nb * 64), 0, IN[I_MIXN] + L * DM, nullptr, 32.0f, scr, F.lane); return; } r -= IT_WIN;
    if (r < NIT_B) { const int L = r / IT_WCO, q = r % IT_WCO, kb = q / 16, nb = q % 16;
        cvt_item<false>(IN[I_WCO] + (size_t)L * CONV_DIM * DM, DM, kb * 64, nb * 64, wsb(F, WS_WM) + (size_t)L * DM * 640, 640, nb * 64, 0, nullptr, nullptr, 1.0f, scr, F.lane); return; } r -= NIT_B;
    if (r < NIT_C) { const int Lg = r / IT_WPOOL, q = r % IT_WPOOL, kb = q / 4, nb = q % 4, L = Lg >> 2, g = Lg & 3;
        cvt_item<false>(IN[I_WPOOL] + (size_t)Lg * 128 * 256, 256, kb * 64, nb * 64, wsb(F, WS_WM) + (size_t)L * DM * 640, 640, 256 * g + nb * 64, 512, nullptr, IN[I_PSC] + L * DM + 256 * g, 1.0f, scr, F.lane); return; } r -= NIT_C;
    if (r < 2 * IT_WOUT) { const int L = r / IT_WOUT, q = r % IT_WOUT, kb = q / 16, nb = q % 16;
        cvt_item<false>(IN[I_WOUT] + (size_t)L * DM * DM, DM, kb * 64, nb * 64, wsb(F, WS_WOUT) + (size_t)L * DM * DM, DM, nb * 64, 0, nullptr, nullptr, 1.0f, scr, F.lane); return; } r -= 2 * IT_WOUT;
    if (r < IT_WOUT) { const int L = 2 + r / (IT_WOUT / 2), q = r % (IT_WOUT / 2), kb = q / 16, nb = q % 16;
        cvt_item<true>(IN[I_WOUT] + (size_t)L * DM * DM, DM, kb * 128, nb * 64, F.ws + WS_WOUT + (size_t)L * DM * DM * 2, DM, nb * 64, 0, nullptr, nullptr, 32.0f, scr, F.lane); return; } r -= IT_WOUT;
    if (r < 2 * IT_DGU) { const int up = r / IT_DGU, q = r % IT_DGU, kb = q / 44, nb = q % 44;
        cvt_item<false>((up ? IN[I_DU] : IN[I_DG]), DFF, kb * 64, nb * 64, wsb(F, WS_DGU), DM, gu_row(nb * 64, up), 0, IN[I_FFNN], nullptr, 1.0f, scr, F.lane); return; } r -= 2 * IT_DGU;
    if (r < IT_DD) { const int kb = r / 16, nb = r % 16;
        cvt_item<false>(IN[I_DD], DM, kb * 64, nb * 64, wsb(F, WS_DD), DFF, nb * 64, 0, nullptr, nullptr, 1.0f, scr, F.lane); return; } r -= IT_DD;
    if (r < IT_DGU) { const int up = r / (IT_DGU / 2), q = r % (IT_DGU / 2), kb = q / 44, nb = q % 44;
        cvt_item<true>((up ? IN[I_DU] : IN[I_DG]) + (size_t)DM * DFF, DFF, kb * 128, nb * 64, F.ws + WS_DGU8, DM, gu_row(nb * 64, up), 0, IN[I_FFNN] + 2 * DM, nullptr, 32.0f, scr, F.lane); return; } r -= IT_DGU;
    { const int kb = r / 16, nb = r % 16;
        cvt_item<true>(IN[I_DD] + (size_t)DFF * DM, DM, kb * 128, nb * 64, F.ws + WS_DD8, DFF, nb * 64, 0, nullptr, nullptr, 64.0f, scr, F.lane); }
}
__device__ __forceinline__ void cvt_moe_item(const Frame& F, const InPtrs& IN, int r, LAS unsigned* scr) {
    const int ie = r / (2 * IT_MGU + IT_MD), i = ie >> 3; int q = r % (2 * IT_MGU + IT_MD);
    if (q < 2 * IT_MGU) { const int up = q / IT_MGU; q %= IT_MGU; const int kb = q / 56, nb = q % 56;
        cvt_item<true>((up ? IN[I_MU] : IN[I_MG]) + (size_t)ie * DM * DFFE, DFFE, kb * 128, nb * 64, F.ws + WS_MGU + (size_t)ie * 2 * DFFE * DM, DM, gu_row(nb * 64, up), 0, IN[I_FFNN] + (2 * i + 1) * DM, nullptr, 32.0f, scr, F.lane); return; }
    q -= 2 * IT_MGU; { const int kb = q / 16, nb = q % 16;
        cvt_item<true>(IN[I_MD] + (size_t)ie * DFFE * DM, DM, kb * 128, nb * 64, F.ws + WS_MD + (size_t)ie * DM * DFFE, DFFE, nb * 64, 0, nullptr, nullptr, 64.0f, scr, F.lane); }
}
__device__ __forceinline__ void cvt_moe_layers(const Frame& F) {
    LAS unsigned* scr = (LAS unsigned*)(F.lds + F.wave * 8448);
    const int gw = F.bid * NWAVES + F.wave, NGW = F.G * NWAVES;
    const InPtrs IN(F);
    for (int it = gw; it < 2 * NIT_MOE; it += NGW) cvt_moe_item(F, IN, it, scr);
}

__device__ __forceinline__ void p_prologue(const Frame& F) {
    LAS unsigned* scr = (LAS unsigned*)(F.lds + F.wave * 8448);
    const int gw = F.bid * NWAVES + F.wave, NGW = F.G * NWAVES;
    const InPtrs IN(F);
    for (int it = gw; it < NIT_PRO; it += NGW) cvt_pro_item(F, IN, it, scr);
    gcf_t x = IN[I_X]; gbf_t xb = wsb(F, WS_XB); gf_t ssq4 = wsf(F, WS_SSQ4);
    for (int t0 = gw * 4; t0 < NTOK; t0 += NGW * 4) {
        f32x4 v[4][4];
#pragma unroll
        for (int q = 0; q < 4; ++q)
#pragma unroll
            for (int j = 0; j < 4; ++j) v[q][j] = *((const GAS f32x4*)(x + (size_t)(t0 + q) * DM) + F.lane + 64 * j);
#pragma unroll
        for (int q = 0; q < 4; ++q) { GAS u32x2* o = (GAS u32x2*)(xb + (size_t)(t0 + q) * DM) + F.lane; float ss = 0.f;
#pragma unroll
            for (int j = 0; j < 4; ++j) { const f32x4 w4 = v[q][j]; ss += (w4[0] * w4[0] + w4[1] * w4[1]) + (w4[2] * w4[2] + w4[3] * w4[3]); u32x2 w; w.x = cvt_pk_bf16(w4[0], w4[1]); w.y = cvt_pk_bf16(w4[2], w4[3]); o[64 * j] = w; }
            ss = wave_sum_l(ss, F.lane);
            if (F.lane < 4) ssq4[(size_t)F.lane * NTOK + t0 + q] = F.lane == 0 ? ss : 0.f; }
    }
    cvt_moe_layers(F);
}

__device__ __forceinline__ float bf1(bf16_t v) { return __uint_as_float((unsigned)v << 16); }
__device__ __forceinline__ bf16_t f2bf(float f) { return (bf16_t)(cvt_pk_bf16(f, 0.f) & 0xffffu); }
template <int CTRL> __device__ __forceinline__ float dppx(float v) { return __int_as_float(__builtin_amdgcn_update_dpp(0, __float_as_int(v), CTRL, 0xf, 0xf, true)); }
__device__ __forceinline__ void p_cp(const Frame& F, int L) {
    const int ch = F.tid, lane = F.lane, wv = F.wave;
    const GAS char* Ub = (const GAS char*)(F.ws + WS_U); const GAS char* Pb = (const GAS char*)(F.ws + WS_P); GAS char* Sb = (GAS char*)(F.ws + WS_SD);
    const unsigned ch2 = (unsigned)ch * 2u, lane16 = (unsigned)lane * 16u, lds0 = (unsigned)(size_t)F.lds;
    constexpr unsigned CP_IN = 0u, CP_OUT = 65536u, CP_HIST = 65536u;
#define CP_DMA(gptr, ldsoff) do { unsigned keep_; asm volatile("s_mov_b32 %0, m0\n\ts_mov_b32 m0, %3\n\ts_nop 0\n\tglobal_load_lds_dwordx4 %1, %2\n\ts_mov_b32 m0, %0" : "=&s"(keep_) : "v"(lane16), "s"(pg8::uni64((const GAS char*)(gptr))), "s"(lds0 + (unsigned)(ldsoff)) : "memory"); } while (0)
#define CP_ST16(gptr, voff, val) (*(GAS u32x4*)((GAS char*)(gptr) + (voff)) = (val))
#define LDSU16(off) ((unsigned)*(const LAS unsigned short*)(F.lds + (off)))
#define LDW(ptr, row) (*(const GAS float*)((const GAS char*)(ptr) + ((unsigned)(row) * (CONV_DIM * 4u) + ch2 * 2u)))
    const InPtrs IN(F);
    LAS float* red = (LAS float*)(F.lds + STAB_OFF);
    const int idx = ((lane >> 3) & 1) + 2 * ((lane >> 2) & 1) + 4 * ((lane >> 1) & 1) + 8 * (lane & 1);
    const bool b0 = lane & 1, b1 = lane & 2, b2 = lane & 4, b3 = lane & 8;
    const int g = F.wave >> 1, win = 2 << g;
    for (int chunk = F.bid; chunk < NTOK / 128; chunk += F.G) {
        const int r0 = chunk * 128, ts0 = r0 & (SEQ - 1);
        const unsigned hmask = ts0 != 0 ? 0xffffffffu : 0u; const int rh = ts0 != 0 ? r0 : r0 + 32;
#pragma unroll
        for (int k = 0; k < 6; ++k) { const int sidx = wv + 8 * k; const int pr = sidx - 30 < 14 ? sidx - 30 : 14;
            const GAS char* src = sidx < 30 ? Ub + (unsigned)(rh - 30 + sidx) * 1024u : Pb + (unsigned)(rh - 15 + pr) * 1024u;
            CP_DMA(src, CP_HIST + (unsigned)sidx * 1024u); }
#pragma unroll
        for (int q = 0; q < 2; ++q) { CP_DMA(Ub + (unsigned)(r0 + 8 * q + wv) * 1024u, CP_IN + (unsigned)q * 16384u + (unsigned)wv * 1024u); CP_DMA(Pb + (unsigned)(r0 + 8 * q + wv) * 1024u, CP_IN + (unsigned)q * 16384u + (unsigned)(8 + wv) * 1024u); }
        float w[CONV_W];
#pragma unroll
        for (int j = 0; j < CONV_W; ++j) w[j] = LDW(IN[I_CDW], L * CONV_W + j);
        const float cb = LDW(IN[I_CDWB], L), lg = LDW(IN[I_CLNG], L), lb = LDW(IN[I_CLNB], L);
        asm volatile("s_waitcnt vmcnt(0)" ::: "memory"); __syncthreads();
        {
            float cb_ = cb, lg_ = lg, lb_ = lb;
#pragma unroll
            for (int j = 0; j < CONV_W; ++j) asm volatile("" : "+v"(w[j]));
            asm volatile("" : "+v"(cb_), "+v"(lg_), "+v"(lb_)); (void)cb_; (void)lg_; (void)lb_; }
        float u[38];
#pragma unroll
        for (int i = 0; i < 30; ++i) u[i] = __uint_as_float((LDSU16(CP_HIST + (unsigned)i * 1024u + ch2) << 16) & hmask);
        float plast, h2[2], h4[4], h8[8];
        { float ph[15], T2[15], T4[13];
#pragma unroll
          for (int i = 0; i < 15; ++i) ph[i] = __uint_as_float((LDSU16(CP_HIST + (unsigned)(30 + i) * 1024u + ch2) << 16) & hmask);
#pragma unroll
          for (int k = 1; k <= 14; ++k) T2[k] = ph[15 - k] + ph[14 - k];
#pragma unroll
          for (int k = 1; k <= 12; ++k) T4[k] = T2[k] + T2[k + 2];
          h2[0] = T2[2]; h2[1] = T2[1];
#pragma unroll
          for (int o = 0; o < 4; ++o) h4[o] = T4[4 - o];
#pragma unroll
          for (int o = 0; o < 8; ++o) h8[o] = T4[8 - o] + T4[12 - o];
          plast = ph[14]; }
#define CP_SUBBLOCK(sb, BUF) do { \
            const int rb = r0 + 8 * (sb), sn = (sb) + 2 < 16 ? (sb) + 2 : 15; \
            const unsigned stg = CP_IN + (unsigned)((sb) & 3) * 16384u, stn = CP_IN + (unsigned)(((sb) + 2) & 3) * 16384u, outw = CP_OUT + (unsigned)((sb) & 1) * 16384u, outr = CP_OUT + (unsigned)(((sb) + 1) & 1) * 16384u; \
            asm volatile("s_waitcnt vmcnt(4) lgkmcnt(0)" ::: "memory"); \
            __builtin_amdgcn_s_barrier(); asm volatile("" ::: "memory");     \
            if ((sb) > 0) { const LAS char* orow = (const LAS char*)(F.lds + outr + (unsigned)wv * 2048u + lane16); const u32x4 o0 = *(const LAS u32x4*)orow, o1 = *(const LAS u32x4*)(orow + 1024); \
                GAS char* drow = Sb + (unsigned)(rb - 8 + wv) * 2048u; CP_ST16(drow, lane16, o0); CP_ST16(drow, lane16 + 1024u, o1); } \
            CP_DMA(Ub + (unsigned)(r0 + 8 * sn + wv) * 1024u, stn + (unsigned)wv * 1024u); CP_DMA(Pb + (unsigned)(r0 + 8 * sn + wv) * 1024u, stn + (unsigned)(8 + wv) * 1024u); \
            float pc[8]; \
            _Pragma("unroll") for (int o = 0; o < 8; ++o) { u[30 + o] = __uint_as_float(LDSU16(stg + (unsigned)o * 1024u + ch2) << 16); pc[o] = __uint_as_float(LDSU16(stg + (unsigned)(8 + o) * 1024u + ch2) << 16); } \
            float v[8], a[16]; \
            _Pragma("unroll") for (int o = 0; o < 8; ++o) { float s_ = cb; \
                _Pragma("unroll") for (int j = 0; j < CONV_W; ++j) s_ += w[j] * u[o + j]; \
                v[o] = s_; a[o] = s_; a[8 + o] = s_ * s_; } \
            _Pragma("unroll") for (int i = 0; i < 8; ++i) { const float keep = b0 ? a[i + 8] : a[i], send = b0 ? a[i] : a[i + 8]; a[i] = keep + dppx<0xB1>(send); } \
            _Pragma("unroll") for (int i = 0; i < 4; ++i) { const float keep = b1 ? a[i + 4] : a[i], send = b1 ? a[i] : a[i + 4]; a[i] = keep + dppx<0x4E>(send); } \
            _Pragma("unroll") for (int i = 0; i < 2; ++i) { const float keep = b2 ? a[i + 2] : a[i], send = b2 ? a[i] : a[i + 2]; a[i] = keep + dppx<0x124>(send); } \
            { const float keep = b3 ? a[1] : a[0], send = b3 ? a[0] : a[1]; a[0] = keep + dppx<0x128>(send); } \
            a[0] += shx<16>(a[0], lane); a[0] += shx<32>(a[0], lane);       \
            LAS float* rb_ = red + (BUF) * 128; \
            if (lane < 16) rb_[idx * 8 + wv] = a[0]; \
              \
            { float sw[8]; \
              _Pragma("unroll") for (int o = 0; o < 8; ++o) sw[o] = pc[o] + (o ? pc[o > 0 ? o - 1 : 0] : plast); \
              plast = pc[7]; \
              if (g >= 1) { float t4[8]; \
                  _Pragma("unroll") for (int o = 0; o < 8; ++o) t4[o] = sw[o] + (o >= 2 ? sw[o >= 2 ? o - 2 : 0] : h2[o & 1]); \
                  h2[0] = sw[6]; h2[1] = sw[7]; \
                  _Pragma("unroll") for (int o = 0; o < 8; ++o) sw[o] = t4[o]; \
                  if (g >= 2) { float t8[8]; \
                      _Pragma("unroll") for (int o = 0; o < 8; ++o) t8[o] = t4[o] + (o >= 4 ? t4[o >= 4 ? o - 4 : 0] : h4[o & 3]); \
                      _Pragma("unroll") for (int o = 0; o < 4; ++o) h4[o] = t4[4 + o]; \
                      _Pragma("unroll") for (int o = 0; o < 8; ++o) sw[o] = t8[o]; \
                      if (g >= 3) { _Pragma("unroll") for (int o = 0; o < 8; ++o) { sw[o] = t8[o] + h8[o]; h8[o] = t8[o]; } } } } \
              _Pragma("unroll") for (int o = 0; o < 8; ++o) { const int ts = ts0 + 8 * (sb) + o; const float inv = __builtin_amdgcn_rcpf((float)((ts + 1) < win ? (ts + 1) : win)); \
                  *(LAS bf16_t*)(F.lds + outw + (unsigned)o * 2048u + ch2) = f2bf(sw[o] * inv - pc[o]); } } \
            LDS_WAIT(); __builtin_amdgcn_s_barrier(); asm volatile("" ::: "memory");     \
              \
            float mean_l, rstd_l; \
            { const LAS float* rp = rb_ + (lane & 7) * 8; const f32x4 s0 = *(const LAS f32x4*)(rp), s1 = *(const LAS f32x4*)(rp + 4), q0 = *(const LAS f32x4*)(rp + 64), q1 = *(const LAS f32x4*)(rp + 68); \
              mean_l = (((s0[0] + s0[1]) + (s0[2] + s0[3])) + ((s1[0] + s1[1]) + (s1[2] + s1[3]))) * (1.0f / CONV_DIM); \
              const float ex2 = (((q0[0] + q0[1]) + (q0[2] + q0[3])) + ((q1[0] + q1[1]) + (q1[2] + q1[3]))) * (1.0f / CONV_DIM); \
              rstd_l = __builtin_amdgcn_rsqf(__builtin_fmaxf(ex2 - mean_l * mean_l, 0.f) + LN_EPS); } \
            _Pragma("unroll") for (int o = 0; o < 8; ++o) { const float mean = rdl(mean_l, o), rstd = rdl(rstd_l, o); \
                const float y = (v[o] - mean) * rstd * lg + lb; \
                *(LAS bf16_t*)(F.lds + outw + (unsigned)o * 2048u + 1024u + ch2) = f2bf(y * __builtin_amdgcn_rcpf(1.0f + __builtin_amdgcn_exp2f(y * -1.4426950408889634f))); } \
            _Pragma("unroll") for (int i = 0; i < 30; ++i) u[i] = u[i + 8]; } while (0)
#pragma unroll 1
        for (int sb = 0; sb < 16; sb += 2) { CP_SUBBLOCK(sb, 0); CP_SUBBLOCK(sb + 1, 1); }
#undef CP_SUBBLOCK
        LDS_WAIT(); __builtin_amdgcn_s_barrier(); asm volatile("" ::: "memory");
        { const LAS char* orow = (const LAS char*)(F.lds + CP_OUT + 16384u + (unsigned)wv * 2048u + lane16); const u32x4 o0 = *(const LAS u32x4*)orow, o1 = *(const LAS u32x4*)(orow + 1024);
          GAS char* drow = Sb + (unsigned)(r0 + 120 + wv) * 2048u; CP_ST16(drow, lane16, o0); CP_ST16(drow, lane16 + 1024u, o1); }
        asm volatile("s_waitcnt vmcnt(0)" ::: "memory"); __syncthreads();
    }
#undef CP_DMA
#undef CP_ST16
#undef LDSU16
#undef LDW
}

__device__ __forceinline__ void p_r1(const Frame& F, int i, int L) {
    LAS u32x4* WH = (LAS u32x4*)F.lds; LAS u32x4* WL = (LAS u32x4*)(F.lds + 32768);
    LAS unsigned* cntw = (LAS unsigned*)(F.lds + 65536);
    gcbf_t x = wsb(F, WS_XB); const int lane = F.lane, w = F.wave;
    const InPtrs IN(F);
    constexpr int NCH = NTOK / 128;
    int chunk = F.bid;
    const int tl = lane & 15, q = lane >> 4;
    float rwv[4][8]; f32x4 g0[4], g1[4];
#pragma unroll
    for (int r = 0; r < 4; ++r) { const int idx = F.tid + r * (NWAVES * 64), s_ = idx >> 6, l_ = idx & 63, n7 = l_ & 7, k0 = 32 * s_ + 8 * (l_ >> 4);
        g0[r] = *(const GAS f32x4*)(IN[I_FFNN] + L * DM + k0); g1[r] = *(const GAS f32x4*)(IN[I_FFNN] + L * DM + k0 + 4);
#pragma unroll
        for (int j = 0; j < 8; ++j) rwv[r][j] = IN[I_RW][(size_t)(i * DM + k0 + j) * 8 + n7]; }
    __builtin_amdgcn_sched_barrier(0);
    u32x4 xa[32];
    {   const int c0 = chunk < NCH ? chunk : NCH - 1;
        const GAS char* xrow = (const GAS char*)(x + (size_t)(c0 * 128 + w * 16 + tl) * DM) + q * 16;
#pragma unroll
        for (int s = 0; s < 32; ++s) xa[s] = *(const GAS u32x4*)(xrow + s * 64); }
    __builtin_amdgcn_sched_barrier(0);
#pragma unroll
    for (int r = 0; r < 4; ++r) { const int idx = F.tid + r * (NWAVES * 64); const float msk = (idx & 8) ? 0.f : 1.f;
        float wv[8];
#pragma unroll
        for (int j = 0; j < 8; ++j) wv[j] = rwv[r][j] * (j < 4 ? g0[r][j & 3] : g1[r][j & 3]) * msk;
        u32x4 hi, lo;
#pragma unroll
        for (int p = 0; p < 4; ++p) { const unsigned h = cvt_pk_bf16(wv[2 * p], wv[2 * p + 1]); hi[p] = h;
            lo[p] = cvt_pk_bf16(wv[2 * p] - bf_lo(h), wv[2 * p + 1] - bf_hi(h)); }
        WH[idx] = hi; WL[idx] = lo; }
    LDS_WAIT(); __syncthreads();
    gu_t toke = wsu(F, WS_TOKE); gf_t tokp = wsf(F, WS_TOKP); gf_t tokr = wsf(F, WS_TOKR); gu_t cnt = wsu(F, WS_CNT); gcf_t ssq4 = wsf(F, WS_SSQ4);
    while (chunk < NCH) {
        const int t0 = chunk * 128 + w * 16;
        float rstd; { const unsigned tq = (unsigned)(t0 + tl); const float s01 = ssq4[tq] + ssq4[NTOK + tq], s23 = ssq4[2 * NTOK + tq] + ssq4[3 * NTOK + tq];
            rstd = __builtin_amdgcn_rsqf((s01 + s23) * (1.0f / DM) + RMS_EPS); }
        f32x4 acc = (f32x4){0.f, 0.f, 0.f, 0.f};
#pragma unroll
        for (int s = 0; s < 32; ++s) { const u32x4 wh = WH[s * 64 + lane], wl = WL[s * 64 + lane];
            acc = __builtin_amdgcn_mfma_f32_16x16x32_bf16(__builtin_bit_cast(bf16x8, wh), __builtin_bit_cast(bf16x8, xa[s]), acc, 0, 0, 0);
            acc = __builtin_amdgcn_mfma_f32_16x16x32_bf16(__builtin_bit_cast(bf16x8, wl), __builtin_bit_cast(bf16x8, xa[s]), acc, 0, 0, 0); }
        float lg[8];
#pragma unroll
        for (int r = 0; r < 4; ++r) { const float o = shx<16>(acc[r], lane); lg[r] = (q & 1) ? o : acc[r]; lg[4 + r] = (q & 1) ? acc[r] : o; }
        int e1 = 0; float l1 = lg[0];
#pragma unroll
        for (int e = 1; e < 8; ++e) if (lg[e] > l1) { l1 = lg[e]; e1 = e; }
        int e2 = -1; float l2 = 0.f;
#pragma unroll
        for (int e = 0; e < 8; ++e) if (e != e1 && (e2 < 0 || lg[e] > l2)) { l2 = lg[e]; e2 = e; }
        const float p1 = __builtin_amdgcn_rcpf(1.0f + __builtin_amdgcn_exp2f((l2 - l1) * rstd * 1.4426950408889634f));
        if (lane < 16) { const int t = t0 + lane; toke[t] = (unsigned)e1 | ((unsigned)e2 << 8); tokp[t] = p1; tokr[t] = rstd; }
        unsigned c[8];
#pragma unroll
        for (int e = 0; e < 8; ++e) c[e] = (unsigned)__popcll(__ballot(lane < 16 && e1 == e)) + (unsigned)__popcll(__ballot(lane < 16 && e2 == e));
        if (lane < 8) { unsigned v = c[0];
#pragma unroll
            for (int e = 1; e < 8; ++e) v = lane == e ? c[e] : v;
            cntw[w * 8 + lane] = v; }
        LDS_WAIT(); __syncthreads();
        if (F.tid < 8) { unsigned s = 0;
#pragma unroll
            for (int q2 = 0; q2 < 8; ++q2) s += cntw[q2 * 8 + F.tid];
            cnt[chunk * 8 + F.tid] = s; }
        __syncthreads();
        chunk += F.G;
        if (chunk < NCH) { const GAS char* xrow = (const GAS char*)(x + (size_t)(chunk * 128 + w * 16 + tl) * DM) + q * 16;
#pragma unroll
            for (int s = 0; s < 32; ++s) xa[s] = *(const GAS u32x4*)(xrow + s * 64); }
    }
}
__device__ __forceinline__ void p_r2(const Frame& F) {
    LAS unsigned* lc = (LAS unsigned*)F.lds;
    LAS unsigned* pre = lc + 2048;
    LAS unsigned* tslot = pre + 64;
    LAS unsigned* te = tslot + 256;
    gu_t cnt = wsu(F, WS_CNT); gu_t toke = wsu(F, WS_TOKE); gu_t slotof = wsu(F, WS_SLOTOF); gu_t panel = wsu(F, WS_PANEL);
    gcf_t tokr = wsf(F, WS_TOKR);
    GAS unsigned char* XG = F.ws + WS_XG; gcbf_t xs = wsb(F, WS_XB);
    for (int q = F.tid; q < 2048; q += NWAVES * 64) lc[q] = __hip_atomic_load(cnt + q, RLX_AGENT);
    LDS_WAIT(); __syncthreads();
    for (int chunk = F.bid; chunk < NTOK / 128; chunk += F.G) {
        {
            const int e = F.wave; unsigned tot = 0, before = 0;
#pragma unroll
            for (int q = 0; q < 4; ++q) { const int c = 4 * F.lane + q; const unsigned v = lc[c * 8 + e]; before += c < chunk ? v : 0u; tot += v; }
#define R2SUM(M) before += (unsigned)shx_i<M>((int)before, F.lane); tot += (unsigned)shx_i<M>((int)tot, F.lane);
            R2SUM(1) R2SUM(2) R2SUM(4) R2SUM(8) R2SUM(16) R2SUM(32)
#undef R2SUM
            if (F.lane == 0) { pre[e] = before; pre[16 + e] = tot; } }
        if (F.tid < 128) te[F.tid] = __hip_atomic_load(toke + chunk * 128 + F.tid, RLX_AGENT);
        LDS_WAIT(); __syncthreads();
        if (F.tid == 0) { unsigned seg = 0; for (int e = 0; e < 8; ++e) { pre[8 + e] = seg; seg += (pre[16 + e] + 255u) & ~255u; } pre[24] = seg >> 8; }
        LDS_WAIT(); __syncthreads();
        {
            const unsigned e = F.wave; unsigned slot = pre[8 + e] + pre[e];
#pragma unroll
            for (int h = 0; h < 2; ++h) { const int tt = 64 * h + F.lane; const unsigned ee = te[tt]; const bool f1 = (ee & 255u) == e, f2 = (ee >> 8) == e;
                const unsigned long long m = __ballot(f1 || f2); const unsigned pfx = __builtin_amdgcn_mbcnt_hi((unsigned)(m >> 32), __builtin_amdgcn_mbcnt_lo((unsigned)m, 0u));
                if (f1) tslot[2 * tt] = slot + pfx; else if (f2) tslot[2 * tt + 1] = slot + pfx;
                slot += (unsigned)__popcll(m); } }
        if (chunk == 0 && F.tid >= 64 && F.tid < 72) { const unsigned e = F.tid - 64; const unsigned p0 = pre[8 + e] >> 8, p1 = (pre[8 + e] + ((pre[16 + e] + 255u) & ~255u)) >> 8;
            for (unsigned p = p0; p < p1; ++p) panel[1 + p] = e;
            if (e == 0) panel[0] = pre[24]; }
        LDS_WAIT(); __syncthreads();
#pragma unroll 1
        for (int tt = 0; tt < 16; tt += 4) { u32x4 v[4][2]; float r[4]; unsigned s0[4], s1[4];
#pragma unroll
            for (int q = 0; q < 4; ++q) { const int tl = F.wave * 16 + tt + q, t = chunk * 128 + tl; s0[q] = tslot[2 * tl]; s1[q] = tslot[2 * tl + 1]; r[q] = tokr[t];
#pragma unroll
                for (int h = 0; h < 2; ++h) v[q][h] = *((const GAS u32x4*)(xs + (size_t)t * DM) + F.lane + 64 * h); }
#pragma unroll
            for (int q = 0; q < 4; ++q) { const int t = chunk * 128 + F.wave * 16 + tt + q;
                GAS u32x2* d0 = (GAS u32x2*)(XG + (size_t)s0[q] * DM) + F.lane; GAS u32x2* d1 = (GAS u32x2*)(XG + (size_t)s1[q] * DM) + F.lane;
#pragma unroll
                for (int h = 0; h < 2; ++h) { f32x4 a, b; pg8::unpack8(v[q][h], a, b); u32x2 w; w.x = pg8::pk_fp8x4(a[0] * r[q], a[1] * r[q], a[2] * r[q], a[3] * r[q]); w.y = pg8::pk_fp8x4(b[0] * r[q], b[1] * r[q], b[2] * r[q], b[3] * r[q]);
                    d0[64 * h] = w; d1[64 * h] = w; }
                (void)t; } }
        if (F.tid < 256) slotof[chunk * 256 + F.tid] = tslot[F.tid];
        __syncthreads();
    }
}
__device__ __forceinline__ void p_cb(const Frame& F, bool final_) {
    const int gw = F.bid * NWAVES + F.wave, NGW = F.G * NWAVES;
    const GAS unsigned* slotof = wsu(F, WS_SLOTOF); gcf_t tokp = wsf(F, WS_TOKP); gcbf_t Y = wsb(F, WS_Y);
    gbf_t xs = wsb(F, WS_XB); gf_t ssq4 = wsf(F, WS_SSQ4); const InPtrs IN(F); gcf_t gfin = IN[I_FIN];
    gcbf_t YP = wsb(F, WS_YP); int mainP, tailP, nsplit; pg8::MoeOrder2::split((int)__hip_atomic_load(wsu(F, WS_PANEL), RLX_AGENT), F.G, mainP, tailP, nsplit);
    mainP = __builtin_amdgcn_readfirstlane(mainP); nsplit = __builtin_amdgcn_readfirstlane(nsplit);
    const unsigned main_rows = (unsigned)mainP * 256u; const int slab_rows = nsplit == 7 ? pg8::TAIL_ROWS : pg8::TAIL_ROWS2;
    f32x4 gf[4];
#pragma unroll
    for (int j = 0; j < 4; ++j) gf[j] = final_ ? *((const GAS f32x4*)gfin + (128 * (j >> 1) + 2 * F.lane + (j & 1))) : (f32x4){0.f, 0.f, 0.f, 0.f};
    for (int t0 = gw * 4; t0 < NTOK; t0 += NGW * 4) {
        unsigned s0[4], s1[4]; float p1[4]; u32x4 xv[4][2]; u32x2 ya[4][2], yb[4][2];
#pragma unroll
        for (int q = 0; q < 4; ++q) { s0[q] = slotof[2 * (t0 + q)]; s1[q] = slotof[2 * (t0 + q) + 1]; p1[q] = tokp[t0 + q]; }
#pragma unroll
        for (int q = 0; q < 4; ++q)
#pragma unroll
            for (int h = 0; h < 2; ++h) { xv[q][h] = *((const GAS u32x4*)(xs + (size_t)(t0 + q) * DM) + F.lane + 64 * h);
                ya[q][h] = *((const GAS u32x2*)((const GAS unsigned char*)Y + (size_t)s0[q] * DM) + F.lane + 64 * h); yb[q][h] = *((const GAS u32x2*)((const GAS unsigned char*)Y + (size_t)s1[q] * DM) + F.lane + 64 * h); }
#pragma unroll
        for (int q = 0; q < 4; ++q) { const int t = t0 + q; const float pa = p1[q], pb = 1.0f - pa; f32x4 v[4]; float ss = 0.f;
#pragma unroll
            for (int h = 0; h < 2; ++h) { f32x4 x0, x1, a0, a1, b0, b1; pg8::unpack8(xv[q][h], x0, x1); pg8::unpack_fp8x8(ya[q][h], a0, a1); pg8::unpack_fp8x8(yb[q][h], b0, b1); a0 *= 0.0625f; a1 *= 0.0625f; b0 *= 0.0625f; b1 *= 0.0625f;
                if (s0[q] >= main_rows) { u32x4 cs[7];
#pragma unroll
                    for (int sp = 0; sp < 7; ++sp) cs[sp] = *((const GAS u32x4*)(YP + (size_t)((sp < nsplit ? sp : 0) * slab_rows + s0[q] - main_rows) * DM) + F.lane + 64 * h);
                    __builtin_amdgcn_sched_barrier(0);
                    a0 = (f32x4){0.f, 0.f, 0.f, 0.f}; a1 = a0;
#pragma unroll
                    for (int sp = 0; sp < 7; ++sp) { f32x4 c0, c1; pg8::unpack8(cs[sp], c0, c1); const float m = sp < nsplit ? 1.0f : 0.0f; a0 += c0 * m; a1 += c1 * m; } }
                if (s1[q] >= main_rows) { u32x4 cs[7];
#pragma unroll
                    for (int sp = 0; sp < 7; ++sp) cs[sp] = *((const GAS u32x4*)(YP + (size_t)((sp < nsplit ? sp : 0) * slab_rows + s1[q] - main_rows) * DM) + F.lane + 64 * h);
                    __builtin_amdgcn_sched_barrier(0);
                    b0 = (f32x4){0.f, 0.f, 0.f, 0.f}; b1 = b0;
#pragma unroll
                    for (int sp = 0; sp < 7; ++sp) { f32x4 c0, c1; pg8::unpack8(cs[sp], c0, c1); const float m = sp < nsplit ? 1.0f : 0.0f; b0 += c0 * m; b1 += c1 * m; } }
                v[2 * h] = x0 + pa * a0 + pb * b0; v[2 * h + 1] = x1 + pa * a1 + pb * b1; }
#pragma unroll
            for (int j = 0; j < 4; ++j) ss += (v[j][0] * v[j][0] + v[j][1] * v[j][1]) + (v[j][2] * v[j][2] + v[j][3] * v[j][3]);
            ss = wave_sum_l(ss, F.lane);
            if (final_) { const float rstd = __builtin_amdgcn_rsqf(ss * (1.0f / DM) + RMS_EPS); GAS f32x4* orow = (GAS f32x4*)(F.out + (size_t)t * DM);
#pragma unroll
                for (int j = 0; j < 4; ++j) { const int e4 = 128 * (j >> 1) + 2 * F.lane + (j & 1); orow[e4] = v[j] * rstd * gf[j]; }
            } else {
#pragma unroll
                for (int h = 0; h < 2; ++h) { *((GAS u32x4*)(xs + (size_t)t * DM) + F.lane + 64 * h) = pg8::pack8(v[2 * h], v[2 * h + 1]);
                    u32x2 w8; w8.x = pg8::pk_fp8x4(v[2 * h][0], v[2 * h][1], v[2 * h][2], v[2 * h][3]); w8.y = pg8::pk_fp8x4(v[2 * h + 1][0], v[2 * h + 1][1], v[2 * h + 1][2], v[2 * h + 1][3]);
                    *((GAS u32x2*)(F.ws + WS_XB8 + (size_t)t * DM) + F.lane + 64 * h) = w8; }
                if (F.lane < 4) ssq4[(size_t)F.lane * NTOK + t] = F.lane == 0 ? ss : 0.f;
            } }
    }
}

constexpr int N_PHASES = 1 + DEPTH * 4 + 2 * 2 + 2 * 5;
__global__ void __launch_bounds__(NWAVES * 64, 2) trunk_fwd(Args args) {
    extern __shared__ __attribute__((aligned(16))) unsigned char lds_raw[];
    Frame F;
    F.lds = (LAS unsigned char*)lds_raw;
    F.kp = (kptr_t)__builtin_amdgcn_kernarg_segment_ptr(); F.out = (gf_t)args.out; F.ws = (GAS unsigned char*)args.ws;
    F.tid = threadIdx.x; F.lane = F.tid & 63; F.wave = __builtin_amdgcn_readfirstlane(F.tid >> 6); F.G = gridDim.x; F.bid = blockIdx.x;
    volatile LAS unsigned* MISC = (volatile LAS unsigned*)(F.lds + MISC_OFF);
    for (int u = F.tid; u < (LDS_BYTES - LDSCTL_OFF) / 4; u += NWAVES * 64) ((LAS unsigned*)(F.lds + LDSCTL_OFF))[u] = 0u;
    __syncthreads();
    gu32* ctl = (gu32*)(args.ws + WS_CTL);
#if MK_PER_PHASE
    XcdBarrier bar; bar.bar = ctl + CW_BAR; bar.x = 0; bar.st = nullptr; (void)bar; (void)MISC;
#else
    XcdBarrier bar = xcd_barrier_post(ctl + CW_BAR, MISC + 8, F.tid);
#endif
#if MK_PER_PHASE
    const int lo = args.ph_lo, hi = args.ph_hi;
    int ph = 0;
#endif
#if MK_PER_PHASE
#define IN_PH() (ph >= lo && ph < hi)
#else
#define IN_PH() true
#endif
#if MK_PER_PHASE
#define SEAM() do { ++ph; } while (0)
#else
#define SEAM() do { XcdBarrier b2_ = bar; asm volatile("" : "+s"(b2_.bar), "+s"(b2_.x)); xcd_barrier(b2_, hw_tid(F.wave)); } while (0)
#endif
#define PHASE_FRAME(Fp) Frame Fp = F; Fp.tid = hw_tid(F.wave); asm volatile("" : "+s"(Fp.ws), "+s"(Fp.out), "+v"(Fp.tid), "+s"(Fp.G), "+s"(Fp.bid)); Fp.lane = Fp.tid & 63
#if MK_PER_PHASE
#define REPBAR() do { } while (0)
#else
#define REPBAR() do { XcdBarrier b3_ = bar; asm volatile("" : "+s"(b3_.bar), "+s"(b3_.x)); xcd_barrier(b3_, hw_tid(F.wave)); } while (0)
#endif
    LAS unsigned char* ring = F.lds;
    LAS float* rtab = (LAS float*)(F.lds + RTAB_OFF); LAS float* stab = (LAS float*)(F.lds + STAB_OFF); LAS float* rawt = (LAS float*)(F.lds + RAW_OFF);

    if (PHON(0) && IN_PH()) {
_Pragma("unroll 1") for (int rep_ = 0; rep_ < NREP(0); ++rep_) { if (rep_) REPBAR(); PHASE_FRAME(Fp); p_prologue(Fp); } }
    SEAM();
#pragma unroll 1
    for (int L = 0; L < DEPTH; ++L) {
        if (PHON(1) && IN_PH()) {
_Pragma("unroll 1") for (int rep_ = 0; rep_ < NREP(1); ++rep_) { if (rep_) REPBAR();
            PHASE_FRAME(Fp); gf_t ssq4 = wsf(Fp, WS_SSQ4); gbf_t xb = wsb(Fp, WS_XB); (void)ssq4; (void)xb;
            pg8::StaticOrder S; S.init(NTOK, IN_COLS, Fp.G, Fp.bid);
            if (L < 2) { pg8::Gemm g{xb, wsb(Fp, WS_WIN) + (size_t)L * IN_COLS * DM, DM, DM, DM};
                pg8::EpiIn E{pg8::PreSsq4{ssq4, rtab, rawt}, wsb(Fp, WS_U), wsb(Fp, WS_P), wsb(Fp, WS_RQ), wsb(Fp, WS_SGP), 1.0f};
                pg8::gemm_phase<pg8::EpiIn, pg8::StaticOrder, pg8::KPlain>(ring, g, S, E, Fp.wave); }
            else { pg8::Gemm g{wsb(Fp, WS_XB8), wsb(Fp, WS_WIN8 + (size_t)(L - 2) * IN_COLS * DM), DM / 2, DM / 2, DM / 2};
                pg8::EpiIn E{pg8::PreSsq4{ssq4, rtab, rawt}, wsb(Fp, WS_U), wsb(Fp, WS_P), wsb(Fp, WS_RQ), wsb(Fp, WS_SGP), 0.03125f};
                pg8::gemm_phase<pg8::EpiIn, pg8::StaticOrder, pg8::KPlain, true>(ring, g, S, E, Fp.wave); }
        } }
        SEAM();
#if (DUP_MASK >> 12) & 1
        if (IN_PH()) { REPBAR();
            PHASE_FRAME(Fp);
            pg8::Gemm g{wsb(Fp, WS_XB), wsb(Fp, WS_WIN) + (size_t)L * IN_COLS * DM, DM, DM, DM}; pg8::HotOrder S{7, 0};
            pg8::EpiY E{pg8::PreNone{}, wsb(Fp, WS_ACT + 330 * MiB), 1.0f, nullptr, 0, 0};
            pg8::gemm_phase<pg8::EpiY, pg8::HotOrder, pg8::KPlain>(ring, g, S, E, Fp.wave);
        }
#endif
        if (PHON(2) && IN_PH()) {
_Pragma("unroll 1") for (int rep_ = 0; rep_ < NREP(2); ++rep_) { if (rep_) REPBAR(); PHASE_FRAME(Fp); p_cp(Fp, L); } }
        SEAM();
        if (PHON(3) && IN_PH()) {
_Pragma("unroll 1") for (int rep_ = 0; rep_ < NREP(3); ++rep_) { if (rep_) REPBAR();
            PHASE_FRAME(Fp); gf_t ssq4 = wsf(Fp, WS_SSQ4); gbf_t xb = wsb(Fp, WS_XB); (void)ssq4; (void)xb;
            pg8::Gemm g{wsb(Fp, WS_SD), wsb(Fp, WS_WM) + (size_t)L * DM * 640, DM, 640, 640, 2, SG_MG}; pg8::StaticOrder S; S.init(NTOK, DM, Fp.G, Fp.bid);
            if (L < 2) { pg8::EpiMerge<false> E{pg8::PreNone{}, wsb(Fp, WS_RQ), wsb(Fp, WS_SGP), wsb(Fp, WS_MERGED)}; pg8::gemm_phase<pg8::EpiMerge<false>, pg8::StaticOrder, pg8::KMerge>(ring, g, S, E, Fp.wave); }
            else { pg8::EpiMerge<true> E{pg8::PreNone{}, wsb(Fp, WS_RQ), wsb(Fp, WS_SGP), wsb(Fp, WS_MERGED)}; pg8::gemm_phase<pg8::EpiMerge<true>, pg8::StaticOrder, pg8::KMerge>(ring, g, S, E, Fp.wave); }
        } }
        SEAM();
        if (PHON(4) && IN_PH()) { {
            PHASE_FRAME(Fp); gf_t ssq4 = wsf(Fp, WS_SSQ4); gbf_t xb = wsb(Fp, WS_XB); (void)ssq4; (void)xb;
            pg8::StaticOrder S; S.init(NTOK, DM, Fp.G, Fp.bid);
            if (L < 2) { pg8::Gemm g{wsb(Fp, WS_MERGED), wsb(Fp, WS_WOUT) + (size_t)L * DM * DM, DM, DM, DM, 2, SG_OUT};
                pg8::EpiRes E{pg8::PreNone{}, xb, ssq4, stab, 1.0f, nullptr};
                pg8::gemm_phase<pg8::EpiRes, pg8::StaticOrder, pg8::KPlain>(ring, g, S, E, Fp.wave); }
            else { pg8::Gemm g{wsb(Fp, WS_MERGED), wsb(Fp, WS_WOUT + (size_t)L * DM * DM * 2), DM / 2, DM / 2, DM / 2, 2, SG_OUT};
                pg8::EpiRes E{pg8::PreNone{}, xb, ssq4, stab, 0.03125f, L == 2 ? Fp.ws + WS_XB8 : (GAS unsigned char*)nullptr};
                pg8::gemm_phase<pg8::EpiRes, pg8::StaticOrder, pg8::KPlain, true>(ring, g, S, E, Fp.wave); }
        } }
        SEAM();
        if ((L & 1) == 0) {
            const int i = L >> 1;
            if (PHON(5) && IN_PH()) {
_Pragma("unroll 1") for (int rep_ = 0; rep_ < NREP(5); ++rep_) { if (rep_) REPBAR();
            PHASE_FRAME(Fp); gf_t ssq4 = wsf(Fp, WS_SSQ4); gbf_t xb = wsb(Fp, WS_XB); (void)ssq4; (void)xb;
                pg8::StaticOrder S; S.init(NTOK, 2 * DFF, Fp.G, Fp.bid);
                if (i == 0) { pg8::Gemm g{xb, wsb(Fp, WS_DGU), DM, DM, DM};
                    pg8::EpiSwiglu<pg8::PreSsq4, false> E{pg8::PreSsq4{ssq4, rtab, rawt}, wsb(Fp, WS_HMID), DFF};
                    pg8::gemm_phase<pg8::EpiSwiglu<pg8::PreSsq4, false>, pg8::StaticOrder, pg8::KPlain>(ring, g, S, E, Fp.wave); }
                else { pg8::Gemm g{wsb(Fp, WS_XB8), wsb(Fp, WS_DGU8), DM / 2, DM / 2, DM / 2};
                    pg8::EpiSwiglu<pg8::PreSsq4, true> E{pg8::PreSsq4{ssq4, rtab, rawt}, Fp.ws + WS_H8, DFF};
                    pg8::gemm_phase<pg8::EpiSwiglu<pg8::PreSsq4, true>, pg8::StaticOrder, pg8::KPlain, true>(ring, g, S, E, Fp.wave); }
            } }
            SEAM();
            if (PHON(6) && IN_PH()) {
            PHASE_FRAME(Fp); gf_t ssq4 = wsf(Fp, WS_SSQ4); gbf_t xb = wsb(Fp, WS_XB); (void)ssq4; (void)xb;
                pg8::StaticOrder S; S.init(NTOK, DM, Fp.G, Fp.bid);
                if (i == 0) { pg8::Gemm g{wsb(Fp, WS_HMID), wsb(Fp, WS_DD), DFF, DFF, DFF, 2, SG_F2};
                    pg8::EpiRes E{pg8::PreNone{}, xb, ssq4, stab, 1.0f, nullptr};
                    pg8::gemm_phase<pg8::EpiRes, pg8::StaticOrder, pg8::KPlain>(ring, g, S, E, Fp.wave); }
                else { pg8::Gemm g{wsb(Fp, WS_H8), wsb(Fp, WS_DD8), DFF / 2, DFF / 2, DFF / 2, 2, SG_F2};
                    pg8::EpiRes E{pg8::PreNone{}, xb, ssq4, stab, 1.0f / 256.0f, Fp.ws + WS_XB8};
                    pg8::gemm_phase<pg8::EpiRes, pg8::StaticOrder, pg8::KPlain, true>(ring, g, S, E, Fp.wave); }
            }
            SEAM();
        } else {
            const int i = L >> 1;
            if (PHON(7) && IN_PH()) {
_Pragma("unroll 1") for (int rep_ = 0; rep_ < NREP(7); ++rep_) { if (rep_) REPBAR(); PHASE_FRAME(Fp); p_r1(Fp, i, L); } }
            SEAM();
            if (PHON(8) && IN_PH()) {
_Pragma("unroll 1") for (int rep_ = 0; rep_ < NREP(8); ++rep_) { if (rep_) REPBAR(); PHASE_FRAME(Fp); p_r2(Fp); } }
            SEAM();
            if (PHON(9) && IN_PH()) {
_Pragma("unroll 1") for (int rep_ = 0; rep_ < NREP(9); ++rep_) { if (rep_) REPBAR();
            PHASE_FRAME(Fp); gf_t ssq4 = wsf(Fp, WS_SSQ4); gbf_t xb = wsb(Fp, WS_XB); (void)ssq4; (void)xb;
                LAS unsigned* ptab = (LAS unsigned*)(Fp.lds + PTAB_OFF);
                for (int q = Fp.tid; q < 512; q += NWAVES * 64) ptab[q] = __hip_atomic_load(wsu(Fp, WS_PANEL) + q, RLX_AGENT);
                LDS_WAIT(); __syncthreads();
                pg8::Gemm g{wsb(Fp, WS_XG), wsb(Fp, WS_MGU + (size_t)i * NEXP * 2 * DFFE * DM), DM / 2, DM / 2, DM / 2}; pg8::MoeOrder S; S.init(ptab, 2 * DFFE, Fp.G, Fp.bid);
                pg8::EpiSwiglu8 E{pg8::PreNone{}, Fp.ws + WS_HE, DFFE};
                pg8::gemm_phase<pg8::EpiSwiglu8, pg8::MoeOrder, pg8::KPlain, true>(ring, g, S, E, Fp.wave);
            } }
            SEAM();
            if (PHON(10) && IN_PH()) {
_Pragma("unroll 1") for (int rep_ = 0; rep_ < NREP(10); ++rep_) { if (rep_) REPBAR();
            PHASE_FRAME(Fp); gf_t ssq4 = wsf(Fp, WS_SSQ4); gbf_t xb = wsb(Fp, WS_XB); (void)ssq4; (void)xb;
                LAS unsigned* ptab = (LAS unsigned*)(Fp.lds + PTAB_OFF);
                for (int q = Fp.tid; q < 512; q += NWAVES * 64) ptab[q] = __hip_atomic_load(wsu(Fp, WS_PANEL) + q, RLX_AGENT);
                LDS_WAIT(); __syncthreads();
                pg8::Gemm g{wsb(Fp, WS_HE), wsb(Fp, WS_MD + (size_t)i * NEXP * DM * DFFE), DFFE / 2, DFFE / 2, DFFE / 2}; pg8::MoeOrder2 S; S.init(ptab, Fp.G, Fp.bid);
                pg8::EpiY E{pg8::PreNone{}, wsb(Fp, WS_Y), 1.0f / 256.0f, wsb(Fp, WS_YP), S.mainP * 256, S.S == 7 ? pg8::TAIL_ROWS : pg8::TAIL_ROWS2};
                pg8::gemm_phase<pg8::EpiY, pg8::MoeOrder2, pg8::KPlainV, true, true>(ring, g, S, E, Fp.wave);
            } }
            SEAM();
            if (PHON(11) && IN_PH()) { PHASE_FRAME(Fp); p_cb(Fp, L == DEPTH - 1); }
            if (L != DEPTH - 1) SEAM();
        }
    }
#undef IN_PH
#undef SEAM
}

extern "C" void kernel_launch(void* const* d_in, const int* in_sizes, int n_in, void* d_out, int out_size, void* d_ws, size_t ws_size, hipStream_t stream) {
    static int grid = 0;
    if (grid == 0) {
        if (n_in != 20 || in_sizes[0] != NTOK * DM || out_size != NTOK * DM || ws_size < WS_END2) { fprintf(stderr, "kernel_launch: unexpected shapes / workspace (%d inputs, ws %zu, need %zu)\n", n_in, ws_size, (size_t)WS_END2); grid = -1; return; }
        int dev = 0, cus = 0, per_cu = 0;
        if (hipGetDevice(&dev) != hipSuccess || hipDeviceGetAttribute(&cus, hipDeviceAttributeMultiprocessorCount, dev) != hipSuccess) { grid = -1; return; }
        if (hipFuncSetAttribute((const void*)trunk_fwd, hipFuncAttributeMaxDynamicSharedMemorySize, LDS_BYTES) != hipSuccess) { fprintf(stderr, "kernel_launch: hipFuncSetAttribute failed\n"); grid = -1; return; }
        if (hipOccupancyMaxActiveBlocksPerMultiprocessor(&per_cu, (const void*)trunk_fwd, NWAVES * 64, LDS_BYTES) != hipSuccess || per_cu < 1) { fprintf(stderr, "kernel_launch: occupancy query says %d blocks per CU\n", per_cu); grid = -1; (void)hipGetLastError(); return; }
        grid = cus;
    }
    if (grid < 0) return;
    if (hipMemsetAsync((char*)d_ws + WS_CTL, 0, CTL_ZERO_BYTES, stream) != hipSuccess) return;
    Args a{};
    for (int i = 0; i < 20; ++i) a.in[i] = (const float*)d_in[i];
    a.out = (float*)d_out; a.ws = (unsigned char*)d_ws;
#if MK_PER_PHASE
    for (int p = 0; p < N_PHASES; ++p) { a.ph_lo = p; a.ph_hi = p + 1; hipLaunchKernelGGL(trunk_fwd, dim3(grid), dim3(NWAVES * 64), LDS_BYTES, stream, a); }
#else
    a.ph_lo = 0; a.ph_hi = N_PHASES;
    hipLaunchKernelGGL(trunk_fwd, dim3(grid), dim3(NWAVES * 64), LDS_BYTES, stream, a);
#endif
}
```

```cpp
#include <hip/hip_runtime.h>
#include <cstdio>
#include <cstdint>

#ifndef PH_MASK
#define PH_MASK 0xFFF
#endif
#define PHON(b) ((PH_MASK >> (b)) & 1)
#ifndef DUP_MASK
#define DUP_MASK 0
#endif
#define NREP(b) (((DUP_MASK >> (b)) & 1) ? 2 : 1)
#ifndef MK_PER_PHASE
#define MK_PER_PHASE 0
#endif

#define LAS __attribute__((address_space(3)))
#define GAS __attribute__((address_space(1)))
typedef unsigned short bf16_t;
typedef short bf16x8 __attribute__((ext_vector_type(8)));
typedef float f32x4 __attribute__((ext_vector_type(4)));
typedef float f32x2 __attribute__((ext_vector_type(2)));
typedef unsigned u32x4 __attribute__((ext_vector_type(4)));
typedef unsigned u32x2 __attribute__((ext_vector_type(2)));
typedef GAS unsigned gu32;
typedef GAS bf16_t* gbf_t; typedef const GAS bf16_t* gcbf_t; typedef GAS float* gf_t; typedef const GAS float* gcf_t; typedef GAS unsigned* gu_t;
#define ST4U(p) (*(GAS u32x4*)(p))
#define LD4U(p) (*(const GAS u32x4*)(p))
#define ST4F(p) (*(GAS f32x4*)(p))
#define LD4F(p) (*(const GAS f32x4*)(p))
#define RLX_AGENT __ATOMIC_RELAXED, __HIP_MEMORY_SCOPE_AGENT

constexpr int NTOK = 32768, DM = 1024, SEQ = 8192, DEPTH = 4;
constexpr int CONV_DIM = 512, CONV_W = 31;
constexpr int IN_COLS = 3584;
constexpr int DFF = 2816, NEXP = 8, DFFE = 3584;
constexpr int NSLOT = 2 * NTOK + NEXP * 256;
constexpr float RMS_EPS = 1e-6f, LN_EPS = 1e-5f;
constexpr int NWAVES = 8;

constexpr size_t MiB = 1u << 20;
constexpr size_t WS_CTL = 0, CTL_ZERO_BYTES = 65536;
constexpr size_t WS_SSQ4 = 1 * MiB;
constexpr size_t WS_TOKE = 3 * MiB;
constexpr size_t WS_TOKP = WS_TOKE + 131072;
constexpr size_t WS_TOKR = WS_TOKP + 131072;
constexpr size_t WS_SLOTOF = WS_TOKR + 131072;
constexpr size_t WS_CNT = WS_SLOTOF + 262144;
constexpr size_t WS_PANEL = WS_CNT + 8192;
constexpr size_t WS_RSLOT = WS_PANEL + 4096;
constexpr size_t WS_WIN = 6 * MiB;
constexpr size_t WS_WM = 34 * MiB;
constexpr size_t WS_WOUT = 39 * MiB;
constexpr size_t WS_DGU = 47 * MiB;
constexpr size_t WS_DD = 69 * MiB;
constexpr size_t WS_MGU = 80 * MiB;
constexpr size_t WS_MD = 192 * MiB;
constexpr size_t WS_XB = 248 * MiB;
constexpr size_t WS_ACT = 312 * MiB;
constexpr size_t WS_U = WS_ACT;
constexpr size_t WS_P = WS_ACT + 32 * MiB;
constexpr size_t WS_RQ = WS_ACT + 64 * MiB;
constexpr size_t WS_SGP = WS_ACT + 128 * MiB;
constexpr size_t WS_SD = WS_ACT + 192 * MiB;
constexpr size_t WS_MERGED = WS_ACT + 256 * MiB;
constexpr size_t WS_HMID = WS_ACT;
constexpr size_t WS_XG = WS_ACT;
constexpr size_t WS_Y = WS_ACT + 66 * MiB;
constexpr size_t WS_HE = WS_ACT + 198 * MiB;
constexpr size_t WS_H8 = WS_ACT;
constexpr size_t WS_YP = WS_ACT + 464 * MiB;
constexpr size_t WS_END = WS_ACT + 594 * MiB;
constexpr size_t WS_XB8 = WS_ACT + 432 * MiB;
constexpr size_t WS_WIN8 = 20 * MiB;
constexpr size_t WS_DGU8 = 58 * MiB;
constexpr size_t WS_DD8 = 75 * MiB;
constexpr size_t WS_END2 = WS_END;
static_assert(WS_WIN + (size_t)2 * IN_COLS * DM * 2 <= WS_WIN8 && WS_WIN8 + (size_t)2 * IN_COLS * DM <= WS_WM && WS_DGU + (size_t)2 * DFF * DM * 2 <= WS_DGU8 && WS_DGU8 + (size_t)2 * DFF * DM <= WS_DD && WS_DD + (size_t)DM * DFF * 2 <= WS_DD8 && WS_DD8 + (size_t)DM * DFF <= WS_MGU && WS_XB8 + (size_t)NTOK * DM <= WS_END && WS_HE + (size_t)NSLOT * DFFE <= WS_XB8, "d_ws map (fp8 copies)");
static_assert((size_t)NSLOT * DM <= 66 * MiB && (size_t)NSLOT * DM * 2 <= 132 * MiB && WS_HE + (size_t)NSLOT * DFFE <= WS_END && (size_t)2 * NEXP * 2 * DFFE * DM <= 112 * MiB && (size_t)2 * NEXP * DFFE * DM <= 56 * MiB, "d_ws map");

constexpr int CW_BAR = 4096;

constexpr int RING_BYTES = 131072;
constexpr int LDSCTL_OFF = RING_BYTES, MISC_OFF = LDSCTL_OFF + 320, PTAB_OFF = LDSCTL_OFF + 1024;
constexpr int RTAB_OFF = LDSCTL_OFF + 3072, STAB_OFF = LDSCTL_OFF + 4096, RAW_OFF = LDSCTL_OFF + 8192;
constexpr int LDS_BYTES = 147456;

__device__ __forceinline__ unsigned cvt_pk_bf16(float lo, float hi) { unsigned r; asm volatile("v_cvt_pk_bf16_f32 %0, %1, %2" : "=v"(r) : "v"(lo), "v"(hi)); return r; }
__device__ __forceinline__ float bf_lo(unsigned w) { return __uint_as_float(w << 16); }
__device__ __forceinline__ float bf_hi(unsigned w) { return __uint_as_float(w & 0xffff0000u); }
__device__ __forceinline__ float fast_exp(float x) { return __builtin_amdgcn_exp2f(x * 1.4426950408889634f); }
__device__ __forceinline__ float clamp30(float x) { return __builtin_fminf(__builtin_fmaxf(x, -30.f), 30.f); }
__device__ __forceinline__ float sigmoidf_(float x) { return __builtin_amdgcn_rcpf(1.0f + fast_exp(-clamp30(x))); }
__device__ __forceinline__ int hw_tid(int wave) { unsigned ones = ~0u; asm volatile("" : "+s"(ones));
    return wave * 64 + (int)__builtin_amdgcn_mbcnt_hi(ones, __builtin_amdgcn_mbcnt_lo(ones, 0u)); }
template <int M> __device__ __forceinline__ int shx_i(int v, int lane) {
    if constexpr (M < 32) return __builtin_amdgcn_ds_swizzle(v, (M << 10) | 0x1F);
    else return __builtin_amdgcn_ds_bpermute((lane ^ 32) << 2, v);
}
template <int M> __device__ __forceinline__ float shx(float v, int lane) { return __int_as_float(shx_i<M>(__float_as_int(v), lane)); }
__device__ __forceinline__ float wave_sum_l(float v, int lane) { v += shx<1>(v, lane); v += shx<2>(v, lane); v += shx<4>(v, lane); v += shx<8>(v, lane); v += shx<16>(v, lane); v += shx<32>(v, lane); return v; }
#define LDS_WAIT() asm volatile("s_waitcnt lgkmcnt(0)" ::: "memory")
#define VM_WAIT() asm volatile("s_waitcnt vmcnt(0)" ::: "memory")

namespace pg8 {
constexpr int BM = 256, BK = 64, HALF = 128, HTB = HALF * BK * 2, STAGE_BYTES = 8 * HTB, NXCD = 8, WGM = 8;
__host__ __device__ __forceinline__ int lds_byte(int r, int c) { const int st = (r >> 4) * 2 + (c >> 5), rr = r & 15, cc = c & 31, ob = rr * 64 + cc * 2; return st * 1024 + (ob ^ (((ob >> 9) & 1) << 5)); }
__host__ __device__ __forceinline__ void stage_rc(int b, int& R, int& C) { const int st = b / 1024, sb = b % 1024, swz = sb ^ (((sb >> 9) & 1) << 5); R = (st >> 1) * 16 + swz / 64; C = (st & 1) * 32 + (swz % 64) / 2; }
__host__ __device__ __forceinline__ int perm32(int rho) { const int n = rho >> 4, i = rho & 15; return 8 * (i >> 2) + 4 * n + (i & 3); }

struct Unit { int pm, pn, pb; int kt0 = 0, ntu = 0, part = -1; };
struct Gemm { gcbf_t A; gcbf_t Bt; int lda, ldb, K; int sg_n = 4, sg_k = 0; };

struct KPlain { static __device__ __forceinline__ int koff(const Unit&, int t) { return t * BK; } };
struct KPlainV { static __device__ __forceinline__ int koff(const Unit& u, int t) { return (u.kt0 + t) * BK; } };
struct KMerge { static __device__ __forceinline__ int koff(const Unit& u, int t) { return t < 8 ? 512 + t * BK : u.pn * 128 + (t - 8) * BK; } };

struct StaticOrder {
    int nM, nN, nwg, G, c;
    __device__ __forceinline__ void init(int M, int N, int G_, int c_) { nM = M / BM; nN = N / BM; nwg = nM * nN; G = G_; c = c_; }
    __device__ __forceinline__ bool next(int i, Unit& u) const {
        const long L = (long)i * G + c; if (i > 0 && L >= nwg) return false;
        int wgid = (int)L; { const int q = nwg / NXCD, r = nwg % NXCD, xcd = wgid % NXCD, off = wgid / NXCD; wgid = (xcd < r ? xcd * (q + 1) : r * (q + 1) + (xcd - r) * q) + off; }
        const int nig = WGM * nN, gid = wgid / nig, fm = gid * WGM, gsz = (nM - fm) < WGM ? (nM - fm) : WGM;
        u.pm = __builtin_amdgcn_readfirstlane(fm + ((wgid % nig) % gsz)); u.pn = __builtin_amdgcn_readfirstlane((wgid % nig) / gsz); u.pb = u.pn; return true;
    }
};
struct HotOrder { int NU; int c; __device__ __forceinline__ bool next(int i, Unit& u) const { if (i >= NU) return false; u.pm = 0; u.pn = 0; u.pb = 0; return true; } };
struct MoeOrder {
    int nM, nN, nwg, G, c; const LAS unsigned* ptab;
    __device__ __forceinline__ void init(const LAS unsigned* pt, int N, int G_, int c_) { ptab = pt; nM = __builtin_amdgcn_readfirstlane((int)pt[0]); nN = N / BM; nwg = nM * nN; G = G_; c = c_; }
    __device__ __forceinline__ bool next(int i, Unit& u) const {
        const long L = (long)i * G + c; if (i > 0 && L >= nwg) return false;
        int wgid = (int)L; { const int q = nwg / NXCD, r = nwg % NXCD, xcd = wgid % NXCD, off = wgid / NXCD; wgid = (xcd < r ? xcd * (q + 1) : r * (q + 1) + (xcd - r) * q) + off; }
        const int nig = WGM * nN, gid = wgid / nig, fm = gid * WGM, gsz = (nM - fm) < WGM ? (nM - fm) : WGM;
        u.pm = __builtin_amdgcn_readfirstlane(fm + ((wgid % nig) % gsz)); u.pn = __builtin_amdgcn_readfirstlane((wgid % nig) / gsz);
        u.pb = __builtin_amdgcn_readfirstlane((int)ptab[1 + u.pm]) * nN + u.pn; return true;
    }
};

struct MoeOrder2 {
    int nM, mainP, tailP, S, Um, nwg, G, c; const LAS unsigned* ptab;
    static __device__ __forceinline__ void split(int nM_, int G_, int& mainP_, int& tailP_, int& S_) {
        tailP_ = (G_ % 4 == 0) ? nM_ % (G_ / 4) : 0; S_ = tailP_ == 0 ? 1 : (28 * tailP_ <= G_ ? 7 : (8 * tailP_ <= G_ ? 2 : 1));
        if (S_ == 1) tailP_ = 0; mainP_ = nM_ - tailP_; }
    __device__ __forceinline__ void init(const LAS unsigned* pt, int G_, int c_) { ptab = pt; nM = __builtin_amdgcn_readfirstlane((int)pt[0]); G = G_; c = c_; split(nM, G, mainP, tailP, S); mainP = __builtin_amdgcn_readfirstlane(mainP); tailP = __builtin_amdgcn_readfirstlane(tailP); S = __builtin_amdgcn_readfirstlane(S); Um = mainP * 4; nwg = Um + tailP * 4 * S; }
    __device__ __forceinline__ bool next(int i, Unit& u) const {
        const long L = (long)i * G + c; if (i > 0 && L >= nwg) return false;
        if (L < Um) { int wgid = (int)L; { const int q = Um / NXCD, r = Um % NXCD, xcd = wgid % NXCD, off = wgid / NXCD; wgid = (xcd < r ? xcd * (q + 1) : r * (q + 1) + (xcd - r) * q) + off; }
            const int nig = WGM * 4, gid = wgid / nig, fm = gid * WGM, gsz = (mainP - fm) < WGM ? (mainP - fm) : WGM;
            u.pm = __builtin_amdgcn_readfirstlane(fm + ((wgid % nig) % gsz)); u.pn = __builtin_amdgcn_readfirstlane((wgid % nig) / gsz); u.kt0 = 0; u.ntu = 28; u.part = -1; }
        else { const int q = (int)L - Um, j = q / S, sp = q % S; u.pm = __builtin_amdgcn_readfirstlane(mainP + j / 4); u.pn = __builtin_amdgcn_readfirstlane(j % 4); u.ntu = __builtin_amdgcn_readfirstlane(28 / S); u.kt0 = __builtin_amdgcn_readfirstlane(sp * (28 / S)); u.part = __builtin_amdgcn_readfirstlane(sp); }
        u.pb = __builtin_amdgcn_readfirstlane((int)ptab[1 + u.pm]) * 4 + u.pn; return true;
    }
};

typedef f32x4 Acc[2][2][4][2];

__device__ __forceinline__ u32x4 pack8(const f32x4 v0, const f32x4 v1) { u32x4 w; w.x = cvt_pk_bf16(v0[0], v0[1]); w.y = cvt_pk_bf16(v0[2], v0[3]); w.z = cvt_pk_bf16(v1[0], v1[1]); w.w = cvt_pk_bf16(v1[2], v1[3]); return w; }
__device__ __forceinline__ void unpack8(const u32x4 w, f32x4& v0, f32x4& v1) { v0 = (f32x4){bf_lo(w.x), bf_hi(w.x), bf_lo(w.y), bf_hi(w.y)}; v1 = (f32x4){bf_lo(w.z), bf_hi(w.z), bf_lo(w.w), bf_hi(w.w)}; }

__device__ __forceinline__ unsigned long long uni64(const GAS char* p) { const unsigned long long v = (unsigned long long)p; const unsigned lo = __builtin_amdgcn_readfirstlane((unsigned)v), hi = __builtin_amdgcn_readfirstlane((unsigned)(v >> 32)); return ((unsigned long long)hi << 32) | lo; }
typedef short s16x2 __attribute__((ext_vector_type(2)));
__device__ __forceinline__ unsigned pk_fp8x4_s(float a, float b, float c, float d, float scale) { s16x2 w = {0, 0}; w = __builtin_amdgcn_cvt_scalef32_pk_fp8_f32(w, a, b, scale, false); w = __builtin_amdgcn_cvt_scalef32_pk_fp8_f32(w, c, d, scale, true); return __builtin_bit_cast(unsigned, w); }
__device__ __forceinline__ unsigned pk_fp8x4(float a, float b, float c, float d) { int w = __builtin_amdgcn_cvt_pk_fp8_f32(a, b, 0, false); w = __builtin_amdgcn_cvt_pk_fp8_f32(c, d, w, true); return (unsigned)w; }

__device__ __forceinline__ void unpack_fp8x8(const u32x2 w, f32x4& a, f32x4& b) {
    const f32x2 a0 = __builtin_amdgcn_cvt_pk_f32_fp8((int)w.x, false), a1 = __builtin_amdgcn_cvt_pk_f32_fp8((int)w.x, true), b0 = __builtin_amdgcn_cvt_pk_f32_fp8((int)w.y, false), b1 = __builtin_amdgcn_cvt_pk_f32_fp8((int)w.y, true);
    a = (f32x4){a0.x, a0.y, a1.x, a1.y}; b = (f32x4){b0.x, b0.y, b1.x, b1.y}; }

struct PreNone { static constexpr bool HAS_PRE = false;
    __device__ __forceinline__ void issue(const Unit&, int, int) const {}
    __device__ __forceinline__ void finish(int) const {} };
struct PreSsq4 { static constexpr bool HAS_PRE = true;
    gcf_t ssq4; LAS float* rtab; LAS float* raw;
    __device__ __forceinline__ void issue(const Unit& u, int tid, int wid) const {
        if (wid < 4) { int te = tid; asm volatile("" : "+v"(te)); const unsigned vo = (unsigned)te * 4u, l0 = (unsigned)(size_t)raw + (unsigned)wid * 256u;
#pragma unroll
            for (int k = 0; k < 4; ++k) { unsigned keep;
                asm volatile("s_mov_b32 %0, m0\n\ts_mov_b32 m0, %3\n\ts_nop 0\n\tglobal_load_lds_dword %1, %2\n\ts_mov_b32 m0, %0" : "=&s"(keep) : "v"(vo), "s"(uni64((const GAS char*)(ssq4 + u.pm * BM + k * NTOK))), "s"(l0 + (unsigned)k * 1024u) : "memory"); } } }
    __device__ __forceinline__ void finish(int tid) const {
        asm volatile("s_waitcnt vmcnt(16)" ::: "memory");
        int te = tid; asm volatile("" : "+v"(te));
        if (te < 256) { const unsigned la = (unsigned)(size_t)raw + (unsigned)te * 4u; float a, b, c, d;
            asm volatile("ds_read_b32 %0, %4\n\tds_read_b32 %1, %4 offset:1024\n\tds_read_b32 %2, %4 offset:2048\n\tds_read_b32 %3, %4 offset:3072\n\ts_waitcnt lgkmcnt(0)" : "=&v"(a), "=&v"(b), "=&v"(c), "=&v"(d) : "v"(la) : "memory");
            rtab[te] = __builtin_amdgcn_rsqf(((a + b) + (c + d)) * (1.0f / DM) + RMS_EPS); } } };
struct PreRow { static constexpr bool HAS_PRE = true;
    gcf_t rrow; LAS float* rtab; LAS float* raw;
    __device__ __forceinline__ void issue(const Unit& u, int tid, int wid) const {
        if (wid < 4) { int te = tid; asm volatile("" : "+v"(te)); const unsigned vo = (unsigned)te * 4u, l0 = (unsigned)(size_t)raw + (unsigned)wid * 256u; unsigned keep;
            asm volatile("s_mov_b32 %0, m0\n\ts_mov_b32 m0, %3\n\ts_nop 0\n\tglobal_load_lds_dword %1, %2\n\ts_mov_b32 m0, %0" : "=&s"(keep) : "v"(vo), "s"(uni64((const GAS char*)(rrow + u.pm * BM))), "s"(l0) : "memory"); } }
    __device__ __forceinline__ void finish(int tid) const {
        asm volatile("s_waitcnt vmcnt(16)" ::: "memory");
        int te = tid; asm volatile("" : "+v"(te));
        if (te < 256) { const unsigned la = (unsigned)(size_t)raw + (unsigned)te * 4u; float a;
            asm volatile("ds_read_b32 %0, %1\n\ts_waitcnt lgkmcnt(0)" : "=&v"(a) : "v"(la) : "memory");
            rtab[te] = a; } } };

struct EpiIn {
    static constexpr bool HAS_MID = false; static constexpr int MID_T = -1; typedef PreSsq4 Pre;
    Pre pre; gbf_t U, P, RQ, SGP; float ascale;
    __device__ __forceinline__ void mid(Acc&, const Unit&, int, int, int, int) const {}
    __device__ __forceinline__ void operator()(const Acc& acc, const Unit& u, int wr, int wc, int fr, int fq) const {
        const int rl0 = wr * 64 + fr, row0 = u.pm * BM + rl0, cw = wc * 32 + 8 * fq;
        float rs[2][4];
#pragma unroll
        for (int ai = 0; ai < 2; ++ai)
#pragma unroll
            for (int m = 0; m < 4; ++m) rs[ai][m] = pre.rtab[rl0 + ai * HALF + m * 16] * ascale;
        if (u.pn < 4) {
#pragma unroll
            for (int ai = 0; ai < 2; ++ai)
#pragma unroll
                for (int m = 0; m < 4; ++m) { const int row = row0 + ai * HALF + m * 16; const float r = rs[ai][m], rn = r * -1.4426950408889634f; f32x4 o[2];
#pragma unroll
                    for (int n = 0; n < 2; ++n)
#pragma unroll
                        for (int j = 0; j < 4; ++j) { const float a = acc[ai][0][m][n][j] * r, e = __builtin_amdgcn_exp2f(acc[ai][1][m][n][j] * rn); o[n][j] = a * __builtin_amdgcn_rcpf(1.0f + e); }
                    ST4U(U + ((unsigned)row * CONV_DIM + u.pn * 128 + cw)) = pack8(o[0], o[1]); }
        } else if (u.pn < 6) {
#pragma unroll
            for (int ai = 0; ai < 2; ++ai)
#pragma unroll
                for (int m = 0; m < 4; ++m) { const int row = row0 + ai * HALF + m * 16; const float r = rs[ai][m];
#pragma unroll
                    for (int bj = 0; bj < 2; ++bj) ST4U(P + ((unsigned)row * 512 + (u.pn - 4) * 256 + bj * HALF + cw)) = pack8(acc[ai][bj][m][0] * r, acc[ai][bj][m][1] * r); }
        } else {
#pragma unroll
            for (int ai = 0; ai < 2; ++ai)
#pragma unroll
                for (int m = 0; m < 4; ++m) { const int row = row0 + ai * HALF + m * 16; const float rn = rs[ai][m] * -1.4426950408889634f; unsigned qc[2][4], qp[2][4];
#pragma unroll
                    for (int n = 0; n < 2; ++n)
#pragma unroll
                        for (int j = 0; j < 4; ++j) { const float ec = __builtin_amdgcn_exp2f(acc[ai][0][m][n][j] * rn), ep = __builtin_amdgcn_exp2f(acc[ai][1][m][n][j] * rn);
                            qc[n][j] = __float_as_uint(__builtin_fmaf(__builtin_amdgcn_rcpf(1.0f + ec), 255.0f, 8388608.0f));
                            qp[n][j] = __float_as_uint(__builtin_fmaxf(__builtin_amdgcn_rcpf(1.0f + ep) * 255.0f, 1.0f) + 8388608.0f); }
                    const unsigned off = (unsigned)row * DM + (u.pn - 6) * 128 + cw;
                    u32x4 wq;
#pragma unroll
                    for (int d = 0; d < 4; ++d) { const int n = d >> 1, j = 2 * (d & 1);
                        wq[d] = __builtin_amdgcn_perm(__builtin_amdgcn_perm(qp[n][j + 1], qc[n][j + 1], 0x0c0c0400u), __builtin_amdgcn_perm(qp[n][j], qc[n][j], 0x0c0c0400u), 0x05040100u); }
                    ST4U((GAS unsigned char*)RQ + 2u * off) = wq; }
        }
    }
};
__device__ __forceinline__ u32x4 widen8(u32x2 a, u32x2 b) {
    const auto rx = __builtin_amdgcn_permlane16_swap(a.x, b.x, false, false), ry = __builtin_amdgcn_permlane16_swap(a.y, b.y, false, false);
    u32x4 o; o.x = rx[0]; o.y = ry[0]; o.z = rx[1]; o.w = ry[1]; return o; }
__device__ __forceinline__ void unpack_gates(const u32x4 w, f32x4& c0, f32x4& c1, f32x4& p0, f32x4& p1) {
    c0 = (f32x4){(float)(w.x & 255u), (float)((w.x >> 16) & 255u), (float)(w.y & 255u), (float)((w.y >> 16) & 255u)}; p0 = (f32x4){(float)((w.x >> 8) & 255u), (float)(w.x >> 24), (float)((w.y >> 8) & 255u), (float)(w.y >> 24)};
    c1 = (f32x4){(float)(w.z & 255u), (float)((w.z >> 16) & 255u), (float)(w.w & 255u), (float)((w.w >> 16) & 255u)}; p1 = (f32x4){(float)((w.z >> 8) & 255u), (float)(w.z >> 24), (float)((w.w >> 8) & 255u), (float)(w.w >> 24)}; }
template <bool F8  > struct EpiMerge {
    static constexpr bool HAS_MID = true; static constexpr int MID_T = 8; typedef PreNone Pre;
    Pre pre; gcbf_t RQ, SGP; gbf_t MG;
    __device__ __forceinline__ void mid(Acc& acc, const Unit& u, int wr, int wc, int fr, int fq) const {
        const int row0 = u.pm * BM + wr * 64 + fr, col0 = u.pn * BM + wc * 32 + 8 * fq;
        u32x4 wg_[2][4][2];
#pragma unroll
        for (int ai = 0; ai < 2; ++ai)
#pragma unroll
            for (int m = 0; m < 4; ++m)
#pragma unroll
                for (int bj = 0; bj < 2; ++bj) wg_[ai][m][bj] = LD4U((const GAS unsigned char*)RQ + 2u * ((unsigned)(row0 + ai * HALF + m * 16) * DM + col0 + bj * HALF));
        __builtin_amdgcn_sched_barrier(0);
#pragma unroll
        for (int ai = 0; ai < 2; ++ai)
#pragma unroll
            for (int m = 0; m < 4; ++m)
#pragma unroll
                for (int bj = 0; bj < 2; ++bj) { f32x4 c0, c1, p0, p1; unpack_gates(wg_[ai][m][bj], c0, c1, p0, p1);
#pragma unroll
                    for (int j = 0; j < 4; ++j) { acc[ai][bj][m][0][j] *= c0[j] * __builtin_amdgcn_rcpf(p0[j]); acc[ai][bj][m][1][j] *= c1[j] * __builtin_amdgcn_rcpf(p1[j]); } }
    }
    __device__ __forceinline__ void operator()(const Acc& acc, const Unit& u, int wr, int wc, int fr, int fq) const {
        const int row0 = u.pm * BM + wr * 64 + fr, col0 = u.pn * BM + wc * 32 + 8 * fq;
        u32x4 w[2][4][2]; u32x2 o8[2][2]; (void)o8;
#pragma unroll
        for (int ai = 0; ai < 2; ++ai)
#pragma unroll
            for (int m = 0; m < 4; ++m)
#pragma unroll
                for (int bj = 0; bj < 2; ++bj) w[ai][m][bj] = LD4U((const GAS unsigned char*)RQ + 2u * ((unsigned)(row0 + ai * HALF + m * 16) * DM + col0 + bj * HALF));
        __builtin_amdgcn_sched_barrier(0);
#pragma unroll
        for (int ai = 0; ai < 2; ++ai)
#pragma unroll
            for (int m = 0; m < 4; ++m)
#pragma unroll
                for (int bj = 0; bj < 2; ++bj) { f32x4 c0, c1, s0, s1; unpack_gates(w[ai][m][bj], c0, c1, s0, s1); (void)c0; (void)c1; const f32x4 a = acc[ai][bj][m][0] * (s0 * (1.0f / 255.0f)), b = acc[ai][bj][m][1] * (s1 * (1.0f / 255.0f));
                    if constexpr (F8) { o8[m & 1][bj].x = pk_fp8x4(a[0], a[1], a[2], a[3]); o8[m & 1][bj].y = pk_fp8x4(b[0], b[1], b[2], b[3]);
                        if (m & 1) ST4U((GAS unsigned char*)MG + ((unsigned)(row0 + ai * HALF + (m - 1) * 16 + (fq & 1) * 16) * DM + (col0 - 8 * (fq & 1)) + bj * HALF)) = widen8(o8[0][bj], o8[1][bj]); }
                    else ST4U(MG + ((unsigned)(row0 + ai * HALF + m * 16) * DM + col0 + bj * HALF)) = pack8(a, b); }
    }
};
struct EpiRes {
    static constexpr bool HAS_MID = false; static constexpr int MID_T = -1; typedef PreNone Pre;
    Pre pre; gbf_t xs; gf_t ssq4; LAS float* stab; float scale; GAS unsigned char* xb8;
    __device__ __forceinline__ void mid(Acc&, const Unit&, int, int, int, int) const {}
    __device__ __forceinline__ void operator()(const Acc& acc, const Unit& u, int wr, int wc, int fr, int fq) const {
        const int rl0 = wr * 64 + fr, col0 = u.pn * BM + wc * 32 + 8 * fq;
        u32x4 xw[2][4][2]; u32x2 w8[2][2];
#pragma unroll
        for (int ai = 0; ai < 2; ++ai)
#pragma unroll
            for (int m = 0; m < 4; ++m)
#pragma unroll
                for (int bj = 0; bj < 2; ++bj) xw[ai][m][bj] = LD4U(xs + ((unsigned)(u.pm * BM + rl0 + ai * HALF + m * 16) * DM + col0 + bj * HALF));
#pragma unroll
        for (int ai = 0; ai < 2; ++ai)
#pragma unroll
            for (int m = 0; m < 4; ++m) { const int rl = rl0 + ai * HALF + m * 16; const unsigned off = (unsigned)(u.pm * BM + rl) * DM + col0; float ss = 0.f;
#pragma unroll
                for (int bj = 0; bj < 2; ++bj) { f32x4 x0, x1; unpack8(xw[ai][m][bj], x0, x1);
                    const f32x4 y0 = x0 + acc[ai][bj][m][0] * scale, y1 = x1 + acc[ai][bj][m][1] * scale;
                    ST4U(xs + off + bj * HALF) = pack8(y0, y1);
                    if (xb8) { w8[m & 1][bj].x = pk_fp8x4(y0[0], y0[1], y0[2], y0[3]); w8[m & 1][bj].y = pk_fp8x4(y1[0], y1[1], y1[2], y1[3]);
                        if (m & 1) ST4U(xb8 + ((unsigned)(u.pm * BM + rl - 16 + (fq & 1) * 16) * DM + (col0 - 8 * (fq & 1)) + bj * HALF)) = widen8(w8[0][bj], w8[1][bj]); }
                    ss += ((y0[0] * y0[0] + y0[1] * y0[1]) + (y0[2] * y0[2] + y0[3] * y0[3])) + ((y1[0] * y1[0] + y1[1] * y1[1]) + (y1[2] * y1[2] + y1[3] * y1[3])); }
                ss += shx<16>(ss, fq * 16 + fr); ss += shx<32>(ss, fq * 16 + fr);
                if (fq == 0) stab[rl * 4 + wc] = ss; }
        asm volatile("s_waitcnt lgkmcnt(0)" ::: "memory"); __builtin_amdgcn_s_barrier(); asm volatile("" ::: "memory");
        const int tid = (wr * 4 + wc) * 64 + fq * 16 + fr;
        if (tid < 256) { const f32x4 v = *(const LAS f32x4*)(stab + tid * 4); ssq4[(unsigned)(u.pn * NTOK + u.pm * BM + tid)] = (v[0] + v[1]) + (v[2] + v[3]); }
    }
};
template <class PRE, bool O8  > struct EpiSwiglu {
    static constexpr bool HAS_MID = false; static constexpr int MID_T = -1; typedef PRE Pre;
    Pre pre; GAS void* Hv; int ldh;
    __device__ __forceinline__ void mid(Acc&, const Unit&, int, int, int, int) const {}
    __device__ __forceinline__ void operator()(const Acc& acc, const Unit& u, int wr, int wc, int fr, int fq) const {
        const int rl0 = wr * 64 + fr, row0 = u.pm * BM + rl0, cw = wc * 32 + 8 * fq;
        float rs[2][4]; u32x2 w8[2]; (void)w8;
#pragma unroll
        for (int ai = 0; ai < 2; ++ai)
#pragma unroll
            for (int m = 0; m < 4; ++m) rs[ai][m] = pre.rtab[rl0 + ai * HALF + m * 16] * (O8 ? 0.03125f : 1.0f);
#pragma unroll
        for (int ai = 0; ai < 2; ++ai)
#pragma unroll
            for (int m = 0; m < 4; ++m) { const int row = row0 + ai * HALF + m * 16; const float r = rs[ai][m], rr = O8 ? r * r * 4.0f : r * r, rn = r * -1.4426950408889634f; f32x4 o[2];
#pragma unroll
                for (int n = 0; n < 2; ++n)
#pragma unroll
                    for (int j = 0; j < 4; ++j) { float tg; asm("v_mul_f32 %0, %1, %2" : "=v"(tg) : "v"(acc[ai][0][m][n][j]), "v"(acc[ai][1][m][n][j]));
                        const float e = __builtin_amdgcn_exp2f(acc[ai][0][m][n][j] * rn); o[n][j] = tg * (rr * __builtin_amdgcn_rcpf(1.0f + e)); }
                if constexpr (O8) { w8[m & 1].x = pk_fp8x4(o[0][0], o[0][1], o[0][2], o[0][3]); w8[m & 1].y = pk_fp8x4(o[1][0], o[1][1], o[1][2], o[1][3]);
                    if (m & 1) ST4U((GAS unsigned char*)Hv + ((unsigned)(row - 16 + (fq & 1) * 16) * ldh + u.pn * 128 + cw - 8 * (fq & 1))) = widen8(w8[0], w8[1]); }
                else ST4U((gbf_t)Hv + ((unsigned)row * ldh + u.pn * 128 + cw)) = pack8(o[0], o[1]); }
    }
};
struct EpiSwiglu8 {
    static constexpr bool HAS_MID = false; static constexpr int MID_T = -1; typedef PreNone Pre;
    Pre pre; GAS unsigned char* H; int ldh;
    __device__ __forceinline__ void mid(Acc&, const Unit&, int, int, int, int) const {}
    __device__ __forceinline__ void operator()(const Acc& acc, const Unit& u, int wr, int wc, int fr, int fq) const {
        float c256 = 256.0f; asm volatile("" : "+s"(c256));
        const int row0 = u.pm * BM + wr * 64 + fr + (fq & 1) * 16, cw = wc * 32 + 8 * (fq & ~1);
#pragma unroll
        for (int ai = 0; ai < 2; ++ai)
#pragma unroll
            for (int mp = 0; mp < 2; ++mp) { u32x2 w[2];
#pragma unroll
                for (int q = 0; q < 2; ++q) { const int m = 2 * mp + q; f32x4 o[2];
#pragma unroll
                    for (int n = 0; n < 2; ++n)
#pragma unroll
                        for (int j = 0; j < 4; ++j) { float tg; asm("v_mul_f32 %0, %1, %2" : "=v"(tg) : "v"(acc[ai][0][m][n][j]), "v"(acc[ai][1][m][n][j]));
                            const float e = __builtin_amdgcn_exp2f(acc[ai][0][m][n][j] * (-0.03125f * 1.4426950408889634f)); o[n][j] = tg * __builtin_amdgcn_rcpf(1.0f + e); }
                    w[q].x = pk_fp8x4_s(o[0][0], o[0][1], o[0][2], o[0][3], c256); w[q].y = pk_fp8x4_s(o[1][0], o[1][1], o[1][2], o[1][3], c256); }
                ST4U(H + ((unsigned)(row0 + ai * HALF + mp * 32) * ldh + u.pn * 128 + cw)) = widen8(w[0], w[1]); }
    }
};
constexpr int TAIL_ROWS = 9 * 256;
constexpr int TAIL_ROWS2 = 32 * 256;
struct EpiY {
    static constexpr bool HAS_MID = false; static constexpr int MID_T = -1; typedef PreNone Pre;
    Pre pre; gbf_t Y; float scale; gbf_t YP; int main_rows, slab_rows;
    __device__ __forceinline__ void mid(Acc&, const Unit&, int, int, int, int) const {}
    __device__ __forceinline__ void operator()(const Acc& acc, const Unit& u, int wr, int wc, int fr, int fq) const {
        const int row0 = u.pm * BM + wr * 64 + fr, col0 = u.pn * BM + wc * 32 + 8 * fq;
        if (u.part < 0) { GAS unsigned char* base = (GAS unsigned char*)Y + (unsigned)(row0 + (fq & 1) * 16) * DM + (col0 - 8 * (fq & 1)); const float s16 = scale * 16.0f;
#pragma unroll
            for (int ai = 0; ai < 2; ++ai)
#pragma unroll
                for (int mp = 0; mp < 2; ++mp)
#pragma unroll
                    for (int bj = 0; bj < 2; ++bj) { u32x2 w[2];
#pragma unroll
                        for (int q = 0; q < 2; ++q) { const f32x4 a = acc[ai][bj][2 * mp + q][0] * s16, b = acc[ai][bj][2 * mp + q][1] * s16; w[q].x = pk_fp8x4(a[0], a[1], a[2], a[3]); w[q].y = pk_fp8x4(b[0], b[1], b[2], b[3]); }
                        ST4U(base + ((unsigned)(ai * HALF + mp * 32) * DM + bj * HALF)) = widen8(w[0], w[1]); }
        } else { gbf_t base = YP + (unsigned)(u.part * slab_rows + row0 - main_rows) * DM;
#pragma unroll
            for (int ai = 0; ai < 2; ++ai)
#pragma unroll
                for (int m = 0; m < 4; ++m) { gbf_t rp = base + ((unsigned)(ai * HALF + m * 16) * DM + col0);
#pragma unroll
                    for (int bj = 0; bj < 2; ++bj) ST4U(rp + bj * HALF) = pack8(acc[ai][bj][m][0] * scale, acc[ai][bj][m][1] * scale); } }
    }
};

typedef int i32x4 __attribute__((ext_vector_type(4)));
typedef int i32x8 __attribute__((ext_vector_type(8)));
#ifndef SG_OUT
#define SG_MG 0
#define SG_OUT 0
#define SG_F2 0
#endif
#ifndef STAG_STEP
#define STAG_STEP 0
#endif
template <class Epi, class Sched, class KA, bool FP8 = false, bool VARK = false>
__device__ __forceinline__ void gemm_phase(LAS unsigned char* lds, const Gemm g, const Sched& S, const Epi& E, int wave_) {
    { const int grp = (S.c >> 3) % g.sg_n;
      if (g.sg_k > 0) { for (int q = 0; q < grp * g.sg_k; ++q) __builtin_amdgcn_s_sleep(100); } else if (STAG_STEP > 0) { for (int q = 0; q < grp; ++q) __builtin_amdgcn_s_sleep(STAG_STEP); } }
    int tid_ = hw_tid(wave_); asm volatile("" : "+v"(tid_));
    const int tid = tid_, wid = __builtin_amdgcn_readfirstlane(tid >> 6), lane = tid & 63, wr = wid >> 2, wc = wid & 3, fr = lane & 15, fq = lane >> 4;
    const int K = g.K, nt = K / BK;
    unsigned voffA[2], voffB[2];
#pragma unroll
    for (int i = 0; i < 2; ++i) { int R, C; stage_rc(tid * 16 + i * 8192, R, C); const int Rb = (R & ~31) + perm32(R & 31);
        voffA[i] = (unsigned)(R * g.lda + C) * 2u; voffB[i] = (unsigned)(Rb * g.ldb + C) * 2u; }
    const size_t kstep = (size_t)(BK * 2);
    const size_t hstepA = (size_t)HALF * g.lda * 2, hstepB = (size_t)HALF * g.ldb * 2;
    const size_t tstepA = 2 * hstepA, tstepB = 2 * hstepB;
    const unsigned ldsw = (unsigned)wid * 1024u, lds0 = (unsigned)(size_t)lds;
    const int aoff = lds_byte(wr * 64 + fr, fq * 8), boff = lds_byte(wc * 32 + fr, fq * 8);
#define PG8_SA(b, h) (((b) * 2 + (h)) * HTB)
#define PG8_SB(b, h) ((4 + (b) * 2 + (h)) * HTB)
#define PG8_STAGE(bufoff, gbase, voff) do { _Pragma("unroll") for (int _i = 0; _i < 2; ++_i) { unsigned _keep; \
        asm volatile("s_mov_b32 %0, m0\n\ts_mov_b32 m0, %3\n\ts_nop 0\n\tglobal_load_lds_dwordx4 %1, %2\n\ts_mov_b32 m0, %0" : "=&s"(_keep) : "v"((voff)[_i]), "s"(uni64(gbase)), "s"(lds0 + (unsigned)(bufoff) + ldsw + (unsigned)(_i * 8192)) : "memory"); } } while (0)
#define PG8_LDA(dst, b, h) do { _Pragma("unroll") for (int m = 0; m < 4; ++m) { if constexpr (FP8) dst##8[m] = __builtin_shufflevector(*(const LAS i32x4*)(lds + PG8_SA(b, h) + aoff + m * 2048), *(const LAS i32x4*)(lds + PG8_SA(b, h) + aoff + m * 2048 + 1024), 0, 1, 2, 3, 4, 5, 6, 7); \
        else { _Pragma("unroll") for (int k = 0; k < 2; ++k) dst[m][k] = *(const LAS bf16x8*)(lds + PG8_SA(b, h) + aoff + m * 2048 + k * 1024); } } } while (0)
#define PG8_LDB(dst, b, h) do { _Pragma("unroll") for (int n = 0; n < 2; ++n) { if constexpr (FP8) dst##8[n] = __builtin_shufflevector(*(const LAS i32x4*)(lds + PG8_SB(b, h) + boff + n * 2048), *(const LAS i32x4*)(lds + PG8_SB(b, h) + boff + n * 2048 + 1024), 0, 1, 2, 3, 4, 5, 6, 7); \
        else { _Pragma("unroll") for (int k = 0; k < 2; ++k) dst[n][k] = *(const LAS bf16x8*)(lds + PG8_SB(b, h) + boff + n * 2048 + k * 1024); } } } while (0)
#define PG8_MMA(ai, bj, At, Bt) do { __builtin_amdgcn_s_setprio(1); _Pragma("unroll") for (int m = 0; m < 4; ++m) _Pragma("unroll") for (int n = 0; n < 2; ++n) { \
        if constexpr (FP8) { acc[ai][bj][m][n] = __builtin_amdgcn_mfma_scale_f32_16x16x128_f8f6f4(Bt##8[n], At##8[m], acc[ai][bj][m][n], 0, 0, 0, 0, 0, 0); } \
        else { _Pragma("unroll") for (int k = 0; k < 2; ++k) acc[ai][bj][m][n] = __builtin_amdgcn_mfma_f32_16x16x32_bf16(Bt[n][k], At[m][k], acc[ai][bj][m][n], 0, 0, 0); } } \
        __builtin_amdgcn_s_setprio(0); } while (0)
#define PG8_WAIT_V(n) asm volatile("s_waitcnt vmcnt(" #n ")" ::: "memory")
#define PG8_WAIT_L(n) asm volatile("s_waitcnt lgkmcnt(" #n ")" ::: "memory")
#define PG8_BAR __builtin_amdgcn_s_barrier()
#define PG8_SCHED __builtin_amdgcn_sched_barrier(0)
    Unit cur, nxt; int ui = 0;
    if (!S.next(0, cur)) return;
    Acc acc;
    {
#pragma unroll
    for (int a = 0; a < 2; ++a)
#pragma unroll
        for (int b = 0; b < 2; ++b)
#pragma unroll
            for (int m = 0; m < 4; ++m)
#pragma unroll
                for (int n = 0; n < 2; ++n) acc[a][b][m][n] = (f32x4){0.f, 0.f, 0.f, 0.f}; }
    bf16x8 At[4][2], B0[2][2], B1[2][2];
    i32x8 At8[4], B08[2], B18[2];
    typedef const GAS char* gcc_t;
    gcc_t cA = (gcc_t)g.A + (size_t)cur.pm * tstepA; gcc_t cB = (gcc_t)g.Bt + (size_t)cur.pb * tstepB + (VARK ? (size_t)cur.kt0 * kstep : 0);
    {
        gcc_t a0 = cA + (size_t)KA::koff(cur, 0) * 2; gcc_t a1 = cA + (size_t)KA::koff(cur, 1) * 2;
        PG8_STAGE(PG8_SB(0, 0), cB, voffB); PG8_STAGE(PG8_SB(0, 1), cB + hstepB, voffB); PG8_STAGE(PG8_SA(0, 0), a0, voffA); PG8_STAGE(PG8_SA(0, 1), a0 + hstepA, voffA);
        if (wr == 1) PG8_BAR;
        PG8_WAIT_V(2); PG8_BAR;
        PG8_STAGE(PG8_SB(1, 0), cB + kstep, voffB); PG8_STAGE(PG8_SA(1, 0), a1, voffA); PG8_STAGE(PG8_SB(1, 1), cB + hstepB + kstep, voffB);
        PG8_WAIT_V(6); PG8_BAR;
    }
    for (;;) {
        const bool has_next = S.next(ui + 1, nxt);
        if (!has_next) nxt = cur;
        gcc_t nA = has_next ? (gcc_t)g.A + (size_t)nxt.pm * tstepA : cA; gcc_t nB = has_next ? (gcc_t)g.Bt + (size_t)nxt.pb * tstepB + (VARK ? (size_t)nxt.kt0 * kstep : 0) : cB;
        const int ntc = VARK ? cur.ntu : nt;
#pragma unroll 1
        for (int t = 0; t < ntc; t += 2) {
            const bool last = (t == ntc - 2);
            gcc_t a1 = cA + (size_t)KA::koff(cur, t + 1) * 2;
            gcc_t a2 = last ? nA + (size_t)KA::koff(nxt, 0) * 2 : cA + (size_t)KA::koff(cur, t + 2) * 2;
            gcc_t a3 = last ? nA + (size_t)KA::koff(nxt, 1) * 2 : cA + (size_t)KA::koff(cur, t + 3) * 2;
            gcc_t b2 = last ? nB : cB + (size_t)(t + 2) * kstep; gcc_t b3 = b2 + kstep;
            if constexpr (Epi::HAS_MID) { if (t == Epi::MID_T) { const int te = hw_tid(wave_); E.mid(acc, cur, wr, wc, te & 15, (te >> 4) & 3); } }
            if constexpr (Epi::Pre::HAS_PRE) { if (t == 0) E.pre.issue(cur, hw_tid(wave_), wid); if (t == 2) E.pre.finish(hw_tid(wave_)); }
            PG8_LDB(B0, 0, 0); PG8_LDB(B1, 0, 1); PG8_SCHED; PG8_LDA(At, 0, 0); PG8_STAGE(PG8_SA(1, 1), a1 + hstepA, voffA);
            PG8_WAIT_V(8); PG8_WAIT_L(0); PG8_BAR; PG8_MMA(0, 0, At, B0); PG8_MMA(0, 1, At, B1); PG8_BAR; PG8_SCHED;
            PG8_LDA(At, 0, 1); PG8_STAGE(PG8_SB(0, 0), b2, voffB); PG8_STAGE(PG8_SB(0, 1), b2 + hstepB, voffB); PG8_STAGE(PG8_SA(0, 0), a2, voffA);
            PG8_WAIT_V(8); PG8_WAIT_L(0); PG8_BAR; PG8_MMA(1, 0, At, B0); PG8_MMA(1, 1, At, B1); PG8_BAR; PG8_SCHED;
            PG8_LDB(B0, 1, 0); PG8_LDB(B1, 1, 1); PG8_SCHED; PG8_LDA(At, 1, 0); PG8_STAGE(PG8_SA(0, 1), a2 + hstepA, voffA);
            PG8_WAIT_V(8); PG8_WAIT_L(0); PG8_BAR; PG8_MMA(0, 0, At, B0); PG8_MMA(0, 1, At, B1); PG8_BAR; PG8_SCHED;
            PG8_LDA(At, 1, 1); PG8_STAGE(PG8_SB(1, 0), b3, voffB); PG8_STAGE(PG8_SB(1, 1), b3 + hstepB, voffB); PG8_STAGE(PG8_SA(1, 0), a3, voffA);
            PG8_WAIT_V(8); PG8_WAIT_L(0); PG8_BAR; PG8_MMA(1, 0, At, B0); PG8_MMA(1, 1, At, B1); PG8_BAR; PG8_SCHED;
        }
        if (wr == 0) PG8_BAR;
        { const int te = hw_tid(wave_); E(acc, cur, wr, wc, te & 15, (te >> 4) & 3); }
        if (!has_next) break;
        const LAS char* zp = (const LAS char*)(lds + RING_BYTES + 12288) + (hw_tid(wave_) & 63) * 16;
#pragma unroll
        for (int a = 0; a < 2; ++a)
#pragma unroll
            for (int b = 0; b < 2; ++b)
#pragma unroll
                for (int m = 0; m < 4; ++m)
#pragma unroll
                    for (int n = 0; n < 2; ++n) acc[a][b][m][n] = *(const LAS f32x4*)(zp + (((a * 2 + b) * 4 + m) * 2 + n) * 16);
        cur = nxt; cA = nA; cB = nB; ++ui;
        if (wr == 1) PG8_BAR;
    }
    PG8_WAIT_V(0);
    PG8_BAR;
#undef PG8_SA
#undef PG8_SB
#undef PG8_STAGE
#undef PG8_LDA
#undef PG8_LDB
#undef PG8_MMA
#undef PG8_WAIT_V
#undef PG8_WAIT_L
#undef PG8_BAR
#undef PG8_SCHED
}
}

#define XB_TMO      128
#define XB_XCNT(j)  (256  + 64 * (j))
#define XB_XSUB(j)  (1280 + 64 * (j))
#define XB_XGEN(j)  (2304 + 64 * (j))
#define XB_TOP      3328
#define XB_TOPGEN   3392
#define XCD_BAR_WORDS 3456
#define XB_SPIN_CAP (1u << 18)
__device__ __forceinline__ unsigned xb_ld(gu32* p)              { return __hip_atomic_load(p, __ATOMIC_RELAXED, __HIP_MEMORY_SCOPE_AGENT); }
__device__ __forceinline__ unsigned xb_add(gu32* p, unsigned v) { return __hip_atomic_fetch_add(p, v, __ATOMIC_RELAXED, __HIP_MEMORY_SCOPE_AGENT); }
__device__ __forceinline__ unsigned xb_xcc_id() { return (unsigned)__builtin_amdgcn_s_getreg((3 << 11) | 20) & 0xFu; }
#define XB_SPIN(cond, bar) do { unsigned _sp = 0; while (cond) { __builtin_amdgcn_s_sleep(1); \
    if ((++_sp & 255u) == 0u) { if (xb_ld(&(bar)[XB_TMO])) break; if (_sp > XB_SPIN_CAP) { (void)xb_add(&(bar)[XB_TMO], 1u); break; } } } } while (0)
struct XcdBarrier { gu32* bar; unsigned x; volatile LAS unsigned* st; };
__device__ __forceinline__ XcdBarrier xcd_barrier_post(gu32* bar, volatile LAS unsigned* st, int tid) {
    XcdBarrier b; b.bar = bar; b.x = xb_xcc_id(); b.st = st;
    if (tid == 0) (void)xb_add(&bar[XB_XCNT(b.x)], 1u);
    return b;
}
__device__ __forceinline__ void xcd_barrier_complete(gu32* bar, unsigned x, unsigned& nloc, unsigned& nx) {
    const unsigned G = gridDim.x * gridDim.y * gridDim.z;
    unsigned sum, cnt, mine, sp = 0u;
    for (;;) {
        sum = 0u; cnt = 0u; mine = 0u;
#pragma unroll
        for (unsigned j = 0; j < 16; ++j) { const unsigned c = xb_ld(&bar[XB_XCNT(j)]); sum += c; cnt += (c > 0u) ? 1u : 0u; mine = (j == x) ? c : mine; }
        if (sum == G) break;
        __builtin_amdgcn_s_sleep(1);
        if ((++sp & 255u) == 0u) { if (xb_ld(&bar[XB_TMO])) break; if (sp > XB_SPIN_CAP) { (void)xb_add(&bar[XB_TMO], 1u); break; } }
    }
    nloc = mine > 0u ? mine : 1u; nx = cnt > 0u ? cnt : 1u;
}
__device__ __forceinline__ void xcd_barrier(const XcdBarrier& b, int tid) {
    asm volatile("s_waitcnt vmcnt(0)" ::: "memory");
    __syncthreads();
    if (tid == 0) {
        gu32* bar = b.bar;
        __builtin_amdgcn_s_waitcnt(0);
        unsigned nloc = b.st[0], nx = b.st[1];
        if (nloc == 0u) { xcd_barrier_complete(bar, b.x, nloc, nx); b.st[0] = nloc; b.st[1] = nx; }
        const unsigned old = xb_add(&bar[XB_XSUB(b.x)], 1u);
        const unsigned gen = old / nloc;
        if (old + 1u == (gen + 1u) * nloc) {
            __builtin_amdgcn_fence(__ATOMIC_RELEASE, "agent");
            asm volatile("s_waitcnt vmcnt(0)" ::: "memory");
            const unsigned og = xb_add(&bar[XB_TOP], 1u);
            const unsigned tg = og / nx;
            if (og + 1u == (tg + 1u) * nx) xb_add(&bar[XB_TOPGEN], 1u);
            else XB_SPIN(xb_ld(&bar[XB_TOPGEN]) == tg, bar);
            __builtin_amdgcn_fence(__ATOMIC_ACQUIRE, "agent");
            asm volatile("s_waitcnt vmcnt(0)" ::: "memory");
        } else {
            XB_SPIN(xb_ld(&bar[XB_TOPGEN]) == gen, bar);
            __builtin_amdgcn_fence(__ATOMIC_ACQUIRE, "agent");
            asm volatile("s_waitcnt vmcnt(0)" ::: "memory");
        }
    }
    __syncthreads();
}

struct Args { const float* in[20]; float* out; unsigned char* ws; int ph_lo, ph_hi; };
enum { I_X = 0, I_MIXN, I_WIN, I_CDW, I_CDWB, I_CLNG, I_CLNB, I_WCO, I_WPOOL, I_PSC, I_WOUT, I_FFNN, I_DG, I_DU, I_DD, I_RW, I_MG, I_MU, I_MD, I_FIN };

typedef const float* cfp_t;
typedef __attribute__((address_space(4))) const char* kptr_t;
struct Frame {
    LAS unsigned char* lds;
    kptr_t kp; gf_t out; GAS unsigned char* ws;
    int tid, lane, wave, G, bid;
};
struct InPtrs { kptr_t kp;
    __device__ __forceinline__ explicit InPtrs(const Frame& F) : kp(F.kp) { asm volatile("" : "+s"(kp)); }
    __device__ __forceinline__ gcf_t operator[](int k) const { return (gcf_t)((__attribute__((address_space(4))) const cfp_t*)kp)[k]; } };
__device__ __forceinline__ gbf_t wsb(const Frame& F, size_t off) { return (gbf_t)(F.ws + off); }
__device__ __forceinline__ gf_t wsf(const Frame& F, size_t off) { return (gf_t)(F.ws + off); }
__device__ __forceinline__ gu_t wsu(const Frame& F, size_t off) { return (gu_t)(F.ws + off); }


__device__ __forceinline__ float rdl(float v, int l) { return __int_as_float(__builtin_amdgcn_readlane(__float_as_int(v), l)); }
template <bool FP8>
__device__ __forceinline__ void cvt_item(gcf_t W, int N, int k0, int n0, GAS void* dstv, int ldd, int drow0, int dcol0, gcf_t sk, gcf_t sn, float mul, LAS unsigned* scr, int lane) {
    const float sN = (sn ? sn[n0 + lane] : 1.0f) * mul;
    gcf_t src = W + (size_t)k0 * N + n0 + lane;
    gcf_t skp = sk ? sk + k0 : src; const float g0 = skp[lane], g1 = FP8 ? skp[64 + lane] : 0.f; (void)g1;
    if constexpr (!FP8) {
        gbf_t dst = (gbf_t)dstv;
#pragma unroll
        for (int h = 0; h < 2; ++h) { float v[32];
#pragma unroll
            for (int i = 0; i < 32; ++i) v[i] = src[(size_t)(32 * h + i) * N];
#pragma unroll
            for (int i = 0; i < 16; ++i) { float a = v[2 * i], b = v[2 * i + 1]; if (sk) { a *= rdl(g0, 32 * h + 2 * i); b *= rdl(g0, 32 * h + 2 * i + 1); }
                scr[lane * 33 + 16 * h + i] = cvt_pk_bf16(a * sN, b * sN); } }
    } else {
#pragma unroll
        for (int h = 0; h < 4; ++h) { float v[32]; const float gh = h < 2 ? g0 : g1; const int gb = 32 * (h & 1);
#pragma unroll
            for (int i = 0; i < 32; ++i) v[i] = src[(size_t)(32 * h + i) * N];
#pragma unroll
            for (int i = 0; i < 8; ++i) { float a = v[4 * i], b = v[4 * i + 1], c = v[4 * i + 2], d = v[4 * i + 3];
                if (sk) { a *= rdl(gh, gb + 4 * i); b *= rdl(gh, gb + 4 * i + 1); c *= rdl(gh, gb + 4 * i + 2); d *= rdl(gh, gb + 4 * i + 3); }
                int w = __builtin_amdgcn_cvt_pk_fp8_f32(a * sN, b * sN, 0, false); w = __builtin_amdgcn_cvt_pk_fp8_f32(c * sN, d * sN, w, true);
                scr[lane * 33 + 8 * h + i] = (unsigned)w; } }
    }
    LDS_WAIT(); asm volatile("" ::: "memory");
    {
        GAS unsigned char* dst = (GAS unsigned char*)dstv; const int c = lane & 7; const int esz = FP8 ? 1 : 2;
#pragma unroll
        for (int q = 0; q < 8; ++q) { const int j = (lane >> 3) + 8 * q; const LAS unsigned* s = scr + j * 33 + 4 * c;
            u32x4 o; o.x = s[0]; o.y = s[1]; o.z = s[2]; o.w = s[3];
            ST4U(dst + ((size_t)(drow0 + j) * ldd + dcol0 + k0) * esz + 16 * c) = o; }
    }
    LDS_WAIT(); asm volatile("" ::: "memory");
}
__device__ __forceinline__ int gu_row(int n0, int up) { return 256 * (n0 >> 7) + (n0 & 127) + 128 * up; }
__device__ __forceinline__ int win_row(int n0) {
    if (n0 < 512) return gu_row(n0, 0);
    if (n0 < 1024) return gu_row(n0 - 512, 1);
    if (n0 < 1536) return n0;
    if (n0 < 2560) return 1536 + gu_row(n0 - 1536, 0);
    return 1536 + gu_row(n0 - 2560, 1);
}
constexpr int IT_WIN = 16 * 56, IT_WCO = 8 * 16, IT_WPOOL = 2 * 4, IT_WOUT = 16 * 16, IT_DGU = 16 * 44, IT_DD = 44 * 16;
constexpr int NIT_A = DEPTH * IT_WIN, NIT_B = DEPTH * IT_WCO, NIT_C = DEPTH * 4 * IT_WPOOL, NIT_D = DEPTH * IT_WOUT, NIT_E = 2 * IT_DGU, NIT_E3 = 2 * IT_DD;
constexpr int NIT_PRO = (2 * IT_WIN + IT_WIN) + NIT_B + NIT_C + (2 * IT_WOUT + IT_WOUT) + (2 * IT_DGU + IT_DD) + (IT_DGU + IT_DD / 2);
constexpr int IT_MGU = 8 * 56, IT_MD = 28 * 16, NIT_MOE = NEXP * (2 * IT_MGU + IT_MD);
__device__ __forceinline__ void cvt_pro_item(const Frame& F, const InPtrs& IN, int r, LAS unsigned* scr) {
    if (r < 2 * IT_WIN) { const int L = r / IT_WIN, q = r % IT_WIN, kb = q / 56, nb = q % 56;
        cvt_item<false>(IN[I_WIN] + (size_t)L * DM * IN_COLS, IN_COLS, kb * 64, nb * 64, wsb(F, WS_WIN) + (size_t)L * IN_COLS * DM, DM, win_row(nb * 64), 0, IN[I_MIXN] + L * DM, nullptr, 1.0f, scr, F.lane); return; } r -= 2 * IT_WIN;
    if (r < IT_WIN) { const int L = 2 + r / (IT_WIN / 2), q = r % (IT_WIN / 2), kb = q / 56, nb = q % 56;
        cvt_item<true>(IN[I_WIN] + (size_t)L * DM * IN_COLS, IN_COLS, kb * 128, nb * 64, F.ws + WS_WIN8 + (size_t)(L - 2) * IN_COLS * DM, DM, win_row(nb * 64), 0, IN[I_MIXN] + L * DM, nullptr, 32.0f, scr, F.lane); return; } r -= IT_WIN;
    if (r < NIT_B) { const int L = r / IT_WCO, q = r % IT_WCO, kb = q / 16, nb = q % 16;
        cvt_item<false>(IN[I_WCO] + (size_t)L * CONV_DIM * DM, DM, kb * 64, nb * 64, wsb(F, WS_WM) + (size_t)L * DM * 640, 640, nb * 64, 0, nullptr, nullptr, 1.0f, scr, F.lane); return; } r -= NIT_B;
    if (r < NIT_C) { const int Lg = r / IT_WPOOL, q = r % IT_WPOOL, kb = q / 4, nb = q % 4, L = Lg >> 2, g = Lg & 3;
        cvt_item<false>(IN[I_WPOOL] + (size_t)Lg * 128 * 256, 256, kb * 64, nb * 64, wsb(F, WS_WM) + (size_t)L * DM * 640, 640, 256 * g + nb * 64, 512, nullptr, IN[I_PSC] + L * DM + 256 * g, 1.0f, scr, F.lane); return; } r -= NIT_C;
    if (r < 2 * IT_WOUT) { const int L = r / IT_WOUT, q = r % IT_WOUT, kb = q / 16, nb = q % 16;
        cvt_item<false>(IN[I_WOUT] + (size_t)L * DM * DM, DM, kb * 64, nb * 64, wsb(F, WS_WOUT) + (size_t)L * DM * DM, DM, nb * 64, 0, nullptr, nullptr, 1.0f, scr, F.lane); return; } r -= 2 * IT_WOUT;
    if (r < IT_WOUT) { const int L = 2 + r / (IT_WOUT / 2), q = r % (IT_WOUT / 2), kb = q / 16, nb = q % 16;
        cvt_item<true>(IN[I_WOUT] + (size_t)L * DM * DM, DM, kb * 128, nb * 64, F.ws + WS_WOUT + (size_t)L * DM * DM * 2, DM, nb * 64, 0, nullptr, nullptr, 32.0f, scr, F.lane); return; } r -= IT_WOUT;
    if (r < 2 * IT_DGU) { const int up = r / IT_DGU, q = r % IT_DGU, kb = q / 44, nb = q % 44;
        cvt_item<false>((up ? IN[I_DU] : IN[I_DG]), DFF, kb * 64, nb * 64, wsb(F, WS_DGU), DM, gu_row(nb * 64, up), 0, IN[I_FFNN], nullptr, 1.0f, scr, F.lane); return; } r -= 2 * IT_DGU;
    if (r < IT_DD) { const int kb = r / 16, nb = r % 16;
        cvt_item<false>(IN[I_DD], DM, kb * 64, nb * 64, wsb(F, WS_DD), DFF, nb * 64, 0, nullptr, nullptr, 1.0f, scr, F.lane); return; } r -= IT_DD;
    if (r < IT_DGU) { const int up = r / (IT_DGU / 2), q = r % (IT_DGU / 2), kb = q / 44, nb = q % 44;
        cvt_item<true>((up ? IN[I_DU] : IN[I_DG]) + (size_t)DM * DFF, DFF, kb * 128, nb * 64, F.ws + WS_DGU8, DM, gu_row(nb * 64, up), 0, IN[I_FFNN] + 2 * DM, nullptr, 32.0f, scr, F.lane); return; } r -= IT_DGU;
    { const int kb = r / 16, nb = r % 16;
        cvt_item<true>(IN[I_DD] + (size_t)DFF * DM, DM, kb * 128, nb * 64, F.ws + WS_DD8, DFF, nb * 64, 0, nullptr, nullptr, 64.0f, scr, F.lane); }
}
__device__ __forceinline__ void cvt_moe_item(const Frame& F, const InPtrs& IN, int r, LAS unsigned* scr) {
    const int ie = r / (2 * IT_MGU + IT_MD), i = ie >> 3; int q = r % (2 * IT_MGU + IT_MD);
    if (q < 2 * IT_MGU) { const int up = q / IT_MGU; q %= IT_MGU; const int kb = q / 56, nb = q % 56;
        cvt_item<true>((up ? IN[I_MU] : IN[I_MG]) + (size_t)ie * DM * DFFE, DFFE, kb * 128, nb * 64, F.ws + WS_MGU + (size_t)ie * 2 * DFFE * DM, DM, gu_row(nb * 64, up), 0, IN[I_FFNN] + (2 * i + 1) * DM, nullptr, 32.0f, scr, F.lane); return; }
    q -= 2 * IT_MGU; { const int kb = q / 16, nb = q % 16;
        cvt_item<true>(IN[I_MD] + (size_t)ie * DFFE * DM, DM, kb * 128, nb * 64, F.ws + WS_MD + (size_t)ie * DM * DFFE, DFFE, nb * 64, 0, nullptr, nullptr, 64.0f, scr, F.lane); }
}
__device__ __forceinline__ void cvt_moe_layers(const Frame& F) {
    LAS unsigned* scr = (LAS unsigned*)(F.lds + F.wave * 8448);
    const int gw = F.bid * NWAVES + F.wave, NGW = F.G * NWAVES;
    const InPtrs IN(F);
    for (int it = gw; it < 2 * NIT_MOE; it += NGW) cvt_moe_item(F, IN, it, scr);
}

__device__ __forceinline__ void p_prologue(const Frame& F) {
    LAS unsigned* scr = (LAS unsigned*)(F.lds + F.wave * 8448);
    const int gw = F.bid * NWAVES + F.wave, NGW = F.G * NWAVES;
    const InPtrs IN(F);
    for (int it = gw; it < NIT_PRO; it += NGW) cvt_pro_item(F, IN, it, scr);
    gcf_t x = IN[I_X]; gbf_t xb = wsb(F, WS_XB); gf_t ssq4 = wsf(F, WS_SSQ4);
    for (int t0 = gw * 4; t0 < NTOK; t0 += NGW * 4) {
        f32x4 v[4][4];
#pragma unroll
        for (int q = 0; q < 4; ++q)
#pragma unroll
            for (int j = 0; j < 4; ++j) v[q][j] = *((const GAS f32x4*)(x + (size_t)(t0 + q) * DM) + F.lane + 64 * j);
#pragma unroll
        for (int q = 0; q < 4; ++q) { GAS u32x2* o = (GAS u32x2*)(xb + (size_t)(t0 + q) * DM) + F.lane; float ss = 0.f;
#pragma unroll
            for (int j = 0; j < 4; ++j) { const f32x4 w4 = v[q][j]; ss += (w4[0] * w4[0] + w4[1] * w4[1]) + (w4[2] * w4[2] + w4[3] * w4[3]); u32x2 w; w.x = cvt_pk_bf16(w4[0], w4[1]); w.y = cvt_pk_bf16(w4[2], w4[3]); o[64 * j] = w; }
            ss = wave_sum_l(ss, F.lane);
            if (F.lane < 4) ssq4[(size_t)F.lane * NTOK + t0 + q] = F.lane == 0 ? ss : 0.f; }
    }
    cvt_moe_layers(F);
}

__device__ __forceinline__ float bf1(bf16_t v) { return __uint_as_float((unsigned)v << 16); }
__device__ __forceinline__ bf16_t f2bf(float f) { return (bf16_t)(cvt_pk_bf16(f, 0.f) & 0xffffu); }
template <int CTRL> __device__ __forceinline__ float dppx(float v) { return __int_as_float(__builtin_amdgcn_update_dpp(0, __float_as_int(v), CTRL, 0xf, 0xf, true)); }
__device__ __forceinline__ void p_cp(const Frame& F, int L) {
    const int ch = F.tid, lane = F.lane, wv = F.wave;
    const GAS char* Ub = (const GAS char*)(F.ws + WS_U); const GAS char* Pb = (const GAS char*)(F.ws + WS_P); GAS char* Sb = (GAS char*)(F.ws + WS_SD);
    const unsigned ch2 = (unsigned)ch * 2u, lane16 = (unsigned)lane * 16u, lds0 = (unsigned)(size_t)F.lds;
    constexpr unsigned CP_IN = 0u, CP_OUT = 65536u, CP_HIST = 65536u;
#define CP_DMA(gptr, ldsoff) do { unsigned keep_; asm volatile("s_mov_b32 %0, m0\n\ts_mov_b32 m0, %3\n\ts_nop 0\n\tglobal_load_lds_dwordx4 %1, %2\n\ts_mov_b32 m0, %0" : "=&s"(keep_) : "v"(lane16), "s"(pg8::uni64((const GAS char*)(gptr))), "s"(lds0 + (unsigned)(ldsoff)) : "memory"); } while (0)
#define CP_ST16(gptr, voff, val) (*(GAS u32x4*)((GAS char*)(gptr) + (voff)) = (val))
#define LDSU16(off) ((unsigned)*(const LAS unsigned short*)(F.lds + (off)))
#define LDW(ptr, row) (*(const GAS float*)((const GAS char*)(ptr) + ((unsigned)(row) * (CONV_DIM * 4u) + ch2 * 2u)))
    const InPtrs IN(F);
    LAS float* red = (LAS float*)(F.lds + STAB_OFF);
    const int idx = ((lane >> 3) & 1) + 2 * ((lane >> 2) & 1) + 4 * ((lane >> 1) & 1) + 8 * (lane & 1);
    const bool b0 = lane & 1, b1 = lane & 2, b2 = lane & 4, b3 = lane & 8;
    const int g = F.wave >> 1, win = 2 << g;
    for (int chunk = F.bid; chunk < NTOK / 128; chunk += F.G) {
        const int r0 = chunk * 128, ts0 = r0 & (SEQ - 1);
        const unsigned hmask = ts0 != 0 ? 0xffffffffu : 0u; const int rh = ts0 != 0 ? r0 : r0 + 32;
#pragma unroll
        for (int k = 0; k < 6; ++k) { const int sidx = wv + 8 * k; const int pr = sidx - 30 < 14 ? sidx - 30 : 14;
            const GAS char* src = sidx < 30 ? Ub + (unsigned)(rh - 30 + sidx) * 1024u : Pb + (unsigned)(rh - 15 + pr) * 1024u;
            CP_DMA(src, CP_HIST + (unsigned)sidx * 1024u); }
#pragma unroll
        for (int q = 0; q < 2; ++q) { CP_DMA(Ub + (unsigned)(r0 + 8 * q + wv) * 1024u, CP_IN + (unsigned)q * 16384u + (unsigned)wv * 1024u); CP_DMA(Pb + (unsigned)(r0 + 8 * q + wv) * 1024u, CP_IN + (unsigned)q * 16384u + (unsigned)(8 + wv) * 1024u); }
        float w[CONV_W];
#pragma unroll
        for (int j = 0; j < CONV_W; ++j) w[j] = LDW(IN[I_CDW], L * CONV_W + j);
        const float cb = LDW(IN[I_CDWB], L), lg = LDW(IN[I_CLNG], L), lb = LDW(IN[I_CLNB], L);
        asm volatile("s_waitcnt vmcnt(0)" ::: "memory"); __syncthreads();
        {
            float cb_ = cb, lg_ = lg, lb_ = lb;
#pragma unroll
            for (int j = 0; j < CONV_W; ++j) asm volatile("" : "+v"(w[j]));
            asm volatile("" : "+v"(cb_), "+v"(lg_), "+v"(lb_)); (void)cb_; (void)lg_; (void)lb_; }
        float u[38];
#pragma unroll
        for (int i = 0; i < 30; ++i) u[i] = __uint_as_float((LDSU16(CP_HIST + (unsigned)i * 1024u + ch2) << 16) & hmask);
        float plast, h2[2], h4[4], h8[8];
        { float ph[15], T2[15], T4[13];
#pragma unroll
          for (int i = 0; i < 15; ++i) ph[i] = __uint_as_float((LDSU16(CP_HIST + (unsigned)(30 + i) * 1024u + ch2) << 16) & hmask);
#pragma unroll
          for (int k = 1; k <= 14; ++k) T2[k] = ph[15 - k] + ph[14 - k];
#pragma unroll
          for (int k = 1; k <= 12; ++k) T4[k] = T2[k] + T2[k + 2];
          h2[0] = T2[2]; h2[1] = T2[1];
#pragma unroll
          for (int o = 0; o < 4; ++o) h4[o] = T4[4 - o];
#pragma unroll
          for (int o = 0; o < 8; ++o) h8[o] = T4[8 - o] + T4[12 - o];
          plast = ph[14]; }
#define CP_SUBBLOCK(sb, BUF) do { \
            const int rb = r0 + 8 * (sb), sn = (sb) + 2 < 16 ? (sb) + 2 : 15; \
            const unsigned stg = CP_IN + (unsigned)((sb) & 3) * 16384u, stn = CP_IN + (unsigned)(((sb) + 2) & 3) * 16384u, outw = CP_OUT + (unsigned)((sb) & 1) * 16384u, outr = CP_OUT + (unsigned)(((sb) + 1) & 1) * 16384u; \
            asm volatile("s_waitcnt vmcnt(4) lgkmcnt(0)" ::: "memory"); \
            __builtin_amdgcn_s_barrier(); asm volatile("" ::: "memory");     \
            if ((sb) > 0) { const LAS char* orow = (const LAS char*)(F.lds + outr + (unsigned)wv * 2048u + lane16); const u32x4 o0 = *(const LAS u32x4*)orow, o1 = *(const LAS u32x4*)(orow + 1024); \
                GAS char* drow = Sb + (unsigned)(rb - 8 + wv) * 2048u; CP_ST16(drow, lane16, o0); CP_ST16(drow, lane16 + 1024u, o1); } \
            CP_DMA(Ub + (unsigned)(r0 + 8 * sn + wv) * 1024u, stn + (unsigned)wv * 1024u); CP_DMA(Pb + (unsigned)(r0 + 8 * sn + wv) * 1024u, stn + (unsigned)(8 + wv) * 1024u); \
            float pc[8]; \
            _Pragma("unroll") for (int o = 0; o < 8; ++o) { u[30 + o] = __uint_as_float(LDSU16(stg + (unsigned)o * 1024u + ch2) << 16); pc[o] = __uint_as_float(LDSU16(stg + (unsigned)(8 + o) * 1024u + ch2) << 16); } \
            float v[8], a[16]; \
            _Pragma("unroll") for (int o = 0; o < 8; ++o) { float s_ = cb; \
                _Pragma("unroll") for (int j = 0; j < CONV_W; ++j) s_ += w[j] * u[o + j]; \
                v[o] = s_; a[o] = s_; a[8 + o] = s_ * s_; } \
            _Pragma("unroll") for (int i = 0; i < 8; ++i) { const float keep = b0 ? a[i + 8] : a[i], send = b0 ? a[i] : a[i + 8]; a[i] = keep + dppx<0xB1>(send); } \
            _Pragma("unroll") for (int i = 0; i < 4; ++i) { const float keep = b1 ? a[i + 4] : a[i], send = b1 ? a[i] : a[i + 4]; a[i] = keep + dppx<0x4E>(send); } \
            _Pragma("unroll") for (int i = 0; i < 2; ++i) { const float keep = b2 ? a[i + 2] : a[i], send = b2 ? a[i] : a[i + 2]; a[i] = keep + dppx<0x124>(send); } \
            { const float keep = b3 ? a[1] : a[0], send = b3 ? a[0] : a[1]; a[0] = keep + dppx<0x128>(send); } \
            a[0] += shx<16>(a[0], lane); a[0] += shx<32>(a[0], lane);       \
            LAS float* rb_ = red + (BUF) * 128; \
            if (lane < 16) rb_[idx * 8 + wv] = a[0]; \
              \
            { float sw[8]; \
              _Pragma("unroll") for (int o = 0; o < 8; ++o) sw[o] = pc[o] + (o ? pc[o > 0 ? o - 1 : 0] : plast); \
              plast = pc[7]; \
              if (g >= 1) { float t4[8]; \
                  _Pragma("unroll") for (int o = 0; o < 8; ++o) t4[o] = sw[o] + (o >= 2 ? sw[o >= 2 ? o - 2 : 0] : h2[o & 1]); \
                  h2[0] = sw[6]; h2[1] = sw[7]; \
                  _Pragma("unroll") for (int o = 0; o < 8; ++o) sw[o] = t4[o]; \
                  if (g >= 2) { float t8[8]; \
                      _Pragma("unroll") for (int o = 0; o < 8; ++o) t8[o] = t4[o] + (o >= 4 ? t4[o >= 4 ? o - 4 : 0] : h4[o & 3]); \
                      _Pragma("unroll") for (int o = 0; o < 4; ++o) h4[o] = t4[4 + o]; \
                      _Pragma("unroll") for (int o = 0; o < 8; ++o) sw[o] = t8[o]; \
                      if (g >= 3) { _Pragma("unroll") for (int o = 0; o < 8; ++o) { sw[o] = t8[o] + h8[o]; h8[o] = t8[o]; } } } } \
              _Pragma("unroll") for (int o = 0; o < 8; ++o) { const int ts = ts0 + 8 * (sb) + o; const float inv = __builtin_amdgcn_rcpf((float)((ts + 1) < win ? (ts + 1) : win)); \
                  *(LAS bf16_t*)(F.lds + outw + (unsigned)o * 2048u + ch2) = f2bf(sw[o] * inv - pc[o]); } } \
            LDS_WAIT(); __builtin_amdgcn_s_barrier(); asm volatile("" ::: "memory");     \
              \
            float mean_l, rstd_l; \
            { const LAS float* rp = rb_ + (lane & 7) * 8; const f32x4 s0 = *(const LAS f32x4*)(rp), s1 = *(const LAS f32x4*)(rp + 4), q0 = *(const LAS f32x4*)(rp + 64), q1 = *(const LAS f32x4*)(rp + 68); \
              mean_l = (((s0[0] + s0[1]) + (s0[2] + s0[3])) + ((s1[0] + s1[1]) + (s1[2] + s1[3]))) * (1.0f / CONV_DIM); \
              const float ex2 = (((q0[0] + q0[1]) + (q0[2] + q0[3])) + ((q1[0] + q1[1]) + (q1[2] + q1[3]))) * (1.0f / CONV_DIM); \
              rstd_l = __builtin_amdgcn_rsqf(__builtin_fmaxf(ex2 - mean_l * mean_l, 0.f) + LN_EPS); } \
            _Pragma("unroll") for (int o = 0; o < 8; ++o) { const float mean = rdl(mean_l, o), rstd = rdl(rstd_l, o); \
                const float y = (v[o] - mean) * rstd * lg + lb; \
                *(LAS bf16_t*)(F.lds + outw + (unsigned)o * 2048u + 1024u + ch2) = f2bf(y * __builtin_amdgcn_rcpf(1.0f + __builtin_amdgcn_exp2f(y * -1.4426950408889634f))); } \
            _Pragma("unroll") for (int i = 0; i < 30; ++i) u[i] = u[i + 8]; } while (0)
#pragma unroll 1
        for (int sb = 0; sb < 16; sb += 2) { CP_SUBBLOCK(sb, 0); CP_SUBBLOCK(sb + 1, 1); }
#undef CP_SUBBLOCK
        LDS_WAIT(); __builtin_amdgcn_s_barrier(); asm volatile("" ::: "memory");
        { const LAS char* orow = (const LAS char*)(F.lds + CP_OUT + 16384u + (unsigned)wv * 2048u + lane16); const u32x4 o0 = *(const LAS u32x4*)orow, o1 = *(const LAS u32x4*)(orow + 1024);
          GAS char* drow = Sb + (unsigned)(r0 + 120 + wv) * 2048u; CP_ST16(drow, lane16, o0); CP_ST16(drow, lane16 + 1024u, o1); }
        asm volatile("s_waitcnt vmcnt(0)" ::: "memory"); __syncthreads();
    }
#undef CP_DMA
#undef CP_ST16
#undef LDSU16
#undef LDW
}

__device__ __forceinline__ void p_r1(const Frame& F, int i, int L) {
    LAS u32x4* WH = (LAS u32x4*)F.lds; LAS u32x4* WL = (LAS u32x4*)(F.lds + 32768);
    LAS unsigned* cntw = (LAS unsigned*)(F.lds + 65536);
    gcbf_t x = wsb(F, WS_XB); const int lane = F.lane, w = F.wave;
    const InPtrs IN(F);
    constexpr int NCH = NTOK / 128;
    int chunk = F.bid;
    const int tl = lane & 15, q = lane >> 4;
    float rwv[4][8]; f32x4 g0[4], g1[4];
#pragma unroll
    for (int r = 0; r < 4; ++r) { const int idx = F.tid + r * (NWAVES * 64), s_ = idx >> 6, l_ = idx & 63, n7 = l_ & 7, k0 = 32 * s_ + 8 * (l_ >> 4);
        g0[r] = *(const GAS f32x4*)(IN[I_FFNN] + L * DM + k0); g1[r] = *(const GAS f32x4*)(IN[I_FFNN] + L * DM + k0 + 4);
#pragma unroll
        for (int j = 0; j < 8; ++j) rwv[r][j] = IN[I_RW][(size_t)(i * DM + k0 + j) * 8 + n7]; }
    __builtin_amdgcn_sched_barrier(0);
    u32x4 xa[32];
    {   const int c0 = chunk < NCH ? chunk : NCH - 1;
        const GAS char* xrow = (const GAS char*)(x + (size_t)(c0 * 128 + w * 16 + tl) * DM) + q * 16;
#pragma unroll
        for (int s = 0; s < 32; ++s) xa[s] = *(const GAS u32x4*)(xrow + s * 64); }
    __builtin_amdgcn_sched_barrier(0);
#pragma unroll
    for (int r = 0; r < 4; ++r) { const int idx = F.tid + r * (NWAVES * 64); const float msk = (idx & 8) ? 0.f : 1.f;
        float wv[8];
#pragma unroll
        for (int j = 0; j < 8; ++j) wv[j] = rwv[r][j] * (j < 4 ? g0[r][j & 3] : g1[r][j & 3]) * msk;
        u32x4 hi, lo;
#pragma unroll
        for (int p = 0; p < 4; ++p) { const unsigned h = cvt_pk_bf16(wv[2 * p], wv[2 * p + 1]); hi[p] = h;
            lo[p] = cvt_pk_bf16(wv[2 * p] - bf_lo(h), wv[2 * p + 1] - bf_hi(h)); }
        WH[idx] = hi; WL[idx] = lo; }
    LDS_WAIT(); __syncthreads();
    gu_t toke = wsu(F, WS_TOKE); gf_t tokp = wsf(F, WS_TOKP); gf_t tokr = wsf(F, WS_TOKR); gu_t cnt = wsu(F, WS_CNT); gcf_t ssq4 = wsf(F, WS_SSQ4);
    while (chunk < NCH) {
        const int t0 = chunk * 128 + w * 16;
        float rstd; { const unsigned tq = (unsigned)(t0 + tl); const float s01 = ssq4[tq] + ssq4[NTOK + tq], s23 = ssq4[2 * NTOK + tq] + ssq4[3 * NTOK + tq];
            rstd = __builtin_amdgcn_rsqf((s01 + s23) * (1.0f / DM) + RMS_EPS); }
        f32x4 acc = (f32x4){0.f, 0.f, 0.f, 0.f};
#pragma unroll
        for (int s = 0; s < 32; ++s) { const u32x4 wh = WH[s * 64 + lane], wl = WL[s * 64 + lane];
            acc = __builtin_amdgcn_mfma_f32_16x16x32_bf16(__builtin_bit_cast(bf16x8, wh), __builtin_bit_cast(bf16x8, xa[s]), acc, 0, 0, 0);
            acc = __builtin_amdgcn_mfma_f32_16x16x32_bf16(__builtin_bit_cast(bf16x8, wl), __builtin_bit_cast(bf16x8, xa[s]), acc, 0, 0, 0); }
        float lg[8];
#pragma unroll
        for (int r = 0; r < 4; ++r) { const float o = shx<16>(acc[r], lane); lg[r] = (q & 1) ? o : acc[r]; lg[4 + r] = (q & 1) ? acc[r] : o; }
        int e1 = 0; float l1 = lg[0];
#pragma unroll
        for (int e = 1; e < 8; ++e) if (lg[e] > l1) { l1 = lg[e]; e1 = e; }
        int e2 = -1; float l2 = 0.f;
#pragma unroll
        for (int e = 0; e < 8; ++e) if (e != e1 && (e2 < 0 || lg[e] > l2)) { l2 = lg[e]; e2 = e; }
        const float p1 = __builtin_amdgcn_rcpf(1.0f + __builtin_amdgcn_exp2f((l2 - l1) * rstd * 1.4426950408889634f));
        if (lane < 16) { const int t = t0 + lane; toke[t] = (unsigned)e1 | ((unsigned)e2 << 8); tokp[t] = p1; tokr[t] = rstd; }
        unsigned c[8];
#pragma unroll
        for (int e = 0; e < 8; ++e) c[e] = (unsigned)__popcll(__ballot(lane < 16 && e1 == e)) + (unsigned)__popcll(__ballot(lane < 16 && e2 == e));
        if (lane < 8) { unsigned v = c[0];
#pragma unroll
            for (int e = 1; e < 8; ++e) v = lane == e ? c[e] : v;
            cntw[w * 8 + lane] = v; }
        LDS_WAIT(); __syncthreads();
        if (F.tid < 8) { unsigned s = 0;
#pragma unroll
            for (int q2 = 0; q2 < 8; ++q2) s += cntw[q2 * 8 + F.tid];
            cnt[chunk * 8 + F.tid] = s; }
        __syncthreads();
        chunk += F.G;
        if (chunk < NCH) { const GAS char* xrow = (const GAS char*)(x + (size_t)(chunk * 128 + w * 16 + tl) * DM) + q * 16;
#pragma unroll
            for (int s = 0; s < 32; ++s) xa[s] = *(const GAS u32x4*)(xrow + s * 64); }
    }
}
__device__ __forceinline__ void p_r2(const Frame& F) {
    LAS unsigned* lc = (LAS unsigned*)F.lds;
    LAS unsigned* pre = lc + 2048;
    LAS unsigned* tslot = pre + 64;
    LAS unsigned* te = tslot + 256;
    gu_t cnt = wsu(F, WS_CNT); gu_t toke = wsu(F, WS_TOKE); gu_t slotof = wsu(F, WS_SLOTOF); gu_t panel = wsu(F, WS_PANEL);
    gcf_t tokr = wsf(F, WS_TOKR);
    GAS unsigned char* XG = F.ws + WS_XG; gcbf_t xs = wsb(F, WS_XB);
    constexpr int NCH = NTOK / 128;
    int chunk = F.bid;
    u32x4 v[16][2]; float r[16];
    {   const int c0 = chunk < NCH ? chunk : NCH - 1;
        unsigned cv[4];
#pragma unroll
        for (int k = 0; k < 4; ++k) cv[k] = __hip_atomic_load(cnt + F.tid + k * (NWAVES * 64), RLX_AGENT);
        const unsigned tev = __hip_atomic_load(toke + c0 * 128 + (F.tid & 127), RLX_AGENT);
#pragma unroll
        for (int q = 0; q < 16; ++q) { const int t = c0 * 128 + F.wave * 16 + q; r[q] = tokr[t];
#pragma unroll
            for (int h = 0; h < 2; ++h) v[q][h] = *((const GAS u32x4*)(xs + (size_t)t * DM) + F.lane + 64 * h); }
        __builtin_amdgcn_sched_barrier(0);
#pragma unroll
        for (int k = 0; k < 4; ++k) lc[F.tid + k * (NWAVES * 64)] = cv[k];
        if (F.tid < 128) te[F.tid] = tev; }
    LDS_WAIT(); __syncthreads();
    while (chunk < NCH) {
        {
            const int e = F.wave; unsigned tot = 0, before = 0;
#pragma unroll
            for (int q = 0; q < 4; ++q) { const int c = 4 * F.lane + q; const unsigned vv = lc[c * 8 + e]; before += c < chunk ? vv : 0u; tot += vv; }
#define R2SUM(M) before += (unsigned)shx_i<M>((int)before, F.lane); tot += (unsigned)shx_i<M>((int)tot, F.lane);
            R2SUM(1) R2SUM(2) R2SUM(4) R2SUM(8) R2SUM(16) R2SUM(32)
#undef R2SUM
            if (F.lane == 0) { pre[e] = before; pre[16 + e] = tot; } }
        LDS_WAIT(); __syncthreads();
        if (F.tid == 0) { unsigned seg = 0; for (int e = 0; e < 8; ++e) { pre[8 + e] = seg; seg += (pre[16 + e] + 255u) & ~255u; } pre[24] = seg >> 8; }
        LDS_WAIT(); __syncthreads();
        {
            const unsigned e = F.wave; unsigned slot = pre[8 + e] + pre[e];
#pragma unroll
            for (int h = 0; h < 2; ++h) { const int tt = 64 * h + F.lane; const unsigned ee = te[tt]; const bool f1 = (ee & 255u) == e, f2 = (ee >> 8) == e;
                const unsigned long long m = __ballot(f1 || f2); const unsigned pfx = __builtin_amdgcn_mbcnt_hi((unsigned)(m >> 32), __builtin_amdgcn_mbcnt_lo((unsigned)m, 0u));
                if (f1) tslot[2 * tt] = slot + pfx; else if (f2) tslot[2 * tt + 1] = slot + pfx;
                slot += (unsigned)__popcll(m); } }
        if (chunk == 0 && F.tid >= 64 && F.tid < 72) { const unsigned e = F.tid - 64; const unsigned p0 = pre[8 + e] >> 8, p1 = (pre[8 + e] + ((pre[16 + e] + 255u) & ~255u)) >> 8;
            for (unsigned p = p0; p < p1; ++p) panel[1 + p] = e;
            if (e == 0) panel[0] = pre[24]; }
        LDS_WAIT(); __syncthreads();
#pragma unroll
        for (int q = 0; q < 16; ++q) { const int tl = F.wave * 16 + q; const unsigned s0 = tslot[2 * tl], s1 = tslot[2 * tl + 1];
            GAS u32x2* d0 = (GAS u32x2*)(XG + (size_t)s0 * DM) + F.lane; GAS u32x2* d1 = (GAS u32x2*)(XG + (size_t)s1 * DM) + F.lane;
#pragma unroll
            for (int h = 0; h < 2; ++h) { f32x4 a, b; pg8::unpack8(v[q][h], a, b); u32x2 w; w.x = pg8::pk_fp8x4(a[0] * r[q], a[1] * r[q], a[2] * r[q], a[3] * r[q]); w.y = pg8::pk_fp8x4(b[0] * r[q], b[1] * r[q], b[2] * r[q], b[3] * r[q]);
                d0[64 * h] = w; d1[64 * h] = w; } }
        if (F.tid < 256) slotof[chunk * 256 + F.tid] = tslot[F.tid];
        __syncthreads();
        chunk += F.G;
        if (chunk < NCH) {
            if (F.tid < 128) te[F.tid] = __hip_atomic_load(toke + chunk * 128 + F.tid, RLX_AGENT);
#pragma unroll
            for (int q = 0; q < 16; ++q) { const int t = chunk * 128 + F.wave * 16 + q; r[q] = tokr[t];
#pragma unroll
                for (int h = 0; h < 2; ++h) v[q][h] = *((const GAS u32x4*)(xs + (size_t)t * DM) + F.lane + 64 * h); } }
    }
}
__device__ __forceinline__ void p_cb(const Frame& F, bool final_) {
    const int gw = F.bid * NWAVES + F.wave, NGW = F.G * NWAVES;
    const GAS unsigned* slotof = wsu(F, WS_SLOTOF); gcf_t tokp = wsf(F, WS_TOKP); gcbf_t Y = wsb(F, WS_Y);
    gbf_t xs = wsb(F, WS_XB); gf_t ssq4 = wsf(F, WS_SSQ4); const InPtrs IN(F); gcf_t gfin = IN[I_FIN];
    gcbf_t YP = wsb(F, WS_YP); int mainP, tailP, nsplit; pg8::MoeOrder2::split((int)__hip_atomic_load(wsu(F, WS_PANEL), RLX_AGENT), F.G, mainP, tailP, nsplit);
    mainP = __builtin_amdgcn_readfirstlane(mainP); nsplit = __builtin_amdgcn_readfirstlane(nsplit);
    const unsigned main_rows = (unsigned)mainP * 256u; const int slab_rows = nsplit == 7 ? pg8::TAIL_ROWS : pg8::TAIL_ROWS2;
    f32x4 gf[4];
#pragma unroll
    for (int j = 0; j < 4; ++j) gf[j] = final_ ? *((const GAS f32x4*)gfin + (128 * (j >> 1) + 2 * F.lane + (j & 1))) : (f32x4){0.f, 0.f, 0.f, 0.f};
    for (int t0 = gw * 4; t0 < NTOK; t0 += NGW * 4) {
        unsigned s0[4], s1[4]; float p1[4]; u32x4 xv[4][2]; u32x2 ya[4][2], yb[4][2];
#pragma unroll
        for (int q = 0; q < 4; ++q) { s0[q] = slotof[2 * (t0 + q)]; s1[q] = slotof[2 * (t0 + q) + 1]; p1[q] = tokp[t0 + q]; }
#pragma unroll
        for (int q = 0; q < 4; ++q)
#pragma unroll
            for (int h = 0; h < 2; ++h) { xv[q][h] = *((const GAS u32x4*)(xs + (size_t)(t0 + q) * DM) + F.lane + 64 * h);
                ya[q][h] = *((const GAS u32x2*)((const GAS unsigned char*)Y + (size_t)s0[q] * DM) + F.lane + 64 * h); yb[q][h] = *((const GAS u32x2*)((const GAS unsigned char*)Y + (size_t)s1[q] * DM) + F.lane + 64 * h); }
#pragma unroll
        for (int q = 0; q < 4; ++q) { const int t = t0 + q; const float pa = p1[q], pb = 1.0f - pa; f32x4 v[4]; float ss = 0.f;
#pragma unroll
            for (int h = 0; h < 2; ++h) { f32x4 x0, x1, a0, a1, b0, b1; pg8::unpack8(xv[q][h], x0, x1); pg8::unpack_fp8x8(ya[q][h], a0, a1); pg8::unpack_fp8x8(yb[q][h], b0, b1); a0 *= 0.0625f; a1 *= 0.0625f; b0 *= 0.0625f; b1 *= 0.0625f;
                if (s0[q] >= main_rows) { u32x4 cs[7];
#pragma unroll
                    for (int sp = 0; sp < 7; ++sp) cs[sp] = *((const GAS u32x4*)(YP + (size_t)((sp < nsplit ? sp : 0) * slab_rows + s0[q] - main_rows) * DM) + F.lane + 64 * h);
                    __builtin_amdgcn_sched_barrier(0);
                    a0 = (f32x4){0.f, 0.f, 0.f, 0.f}; a1 = a0;
#pragma unroll
                    for (int sp = 0; sp < 7; ++sp) { f32x4 c0, c1; pg8::unpack8(cs[sp], c0, c1); const float m = sp < nsplit ? 1.0f : 0.0f; a0 += c0 * m; a1 += c1 * m; } }
                if (s1[q] >= main_rows) { u32x4 cs[7];
#pragma unroll
                    for (int sp = 0; sp < 7; ++sp) cs[sp] = *((const GAS u32x4*)(YP + (size_t)((sp < nsplit ? sp : 0) * slab_rows + s1[q] - main_rows) * DM) + F.lane + 64 * h);
                    __builtin_amdgcn_sched_barrier(0);
                    b0 = (f32x4){0.f, 0.f, 0.f, 0.f}; b1 = b0;
#pragma unroll
                    for (int sp = 0; sp < 7; ++sp) { f32x4 c0, c1; pg8::unpack8(cs[sp], c0, c1); const float m = sp < nsplit ? 1.0f : 0.0f; b0 += c0 * m; b1 += c1 * m; } }
                v[2 * h] = x0 + pa * a0 + pb * b0; v[2 * h + 1] = x1 + pa * a1 + pb * b1; }
#pragma unroll
            for (int j = 0; j < 4; ++j) ss += (v[j][0] * v[j][0] + v[j][1] * v[j][1]) + (v[j][2] * v[j][2] + v[j][3] * v[j][3]);
            ss = wave_sum_l(ss, F.lane);
            if (final_) { const float rstd = __builtin_amdgcn_rsqf(ss * (1.0f / DM) + RMS_EPS); GAS f32x4* orow = (GAS f32x4*)(F.out + (size_t)t * DM);
#pragma unroll
                for (int j = 0; j < 4; ++j) { const int e4 = 128 * (j >> 1) + 2 * F.lane + (j & 1); orow[e4] = v[j] * rstd * gf[j]; }
            } else {
#pragma unroll
                for (int h = 0; h < 2; ++h) { *((GAS u32x4*)(xs + (size_t)t * DM) + F.lane + 64 * h) = pg8::pack8(v[2 * h], v[2 * h + 1]);
                    u32x2 w8; w8.x = pg8::pk_fp8x4(v[2 * h][0], v[2 * h][1], v[2 * h][2], v[2 * h][3]); w8.y = pg8::pk_fp8x4(v[2 * h + 1][0], v[2 * h + 1][1], v[2 * h + 1][2], v[2 * h + 1][3]);
                    *((GAS u32x2*)(F.ws + WS_XB8 + (size_t)t * DM) + F.lane + 64 * h) = w8; }
                if (F.lane < 4) ssq4[(size_t)F.lane * NTOK + t] = F.lane == 0 ? ss : 0.f;
            } }
    }
}

constexpr int N_PHASES = 1 + DEPTH * 4 + 2 * 2 + 2 * 5;
__global__ void __launch_bounds__(NWAVES * 64, 2) trunk_fwd(Args args) {
    extern __shared__ __attribute__((aligned(16))) unsigned char lds_raw[];
    Frame F;
    F.lds = (LAS unsigned char*)lds_raw;
    F.kp = (kptr_t)__builtin_amdgcn_kernarg_segment_ptr(); F.out = (gf_t)args.out; F.ws = (GAS unsigned char*)args.ws;
    F.tid = threadIdx.x; F.lane = F.tid & 63; F.wave = __builtin_amdgcn_readfirstlane(F.tid >> 6); F.G = gridDim.x; F.bid = blockIdx.x;
    volatile LAS unsigned* MISC = (volatile LAS unsigned*)(F.lds + MISC_OFF);
    for (int u = F.tid; u < (LDS_BYTES - LDSCTL_OFF) / 4; u += NWAVES * 64) ((LAS unsigned*)(F.lds + LDSCTL_OFF))[u] = 0u;
    __syncthreads();
    gu32* ctl = (gu32*)(args.ws + WS_CTL);
#if MK_PER_PHASE
    XcdBarrier bar; bar.bar = ctl + CW_BAR; bar.x = 0; bar.st = nullptr; (void)bar; (void)MISC;
#else
    XcdBarrier bar = xcd_barrier_post(ctl + CW_BAR, MISC + 8, F.tid);
#endif
#if MK_PER_PHASE
    const int lo = args.ph_lo, hi = args.ph_hi;
    int ph = 0;
#endif
#if MK_PER_PHASE
#define IN_PH() (ph >= lo && ph < hi)
#else
#define IN_PH() true
#endif
#if MK_PER_PHASE
#define SEAM() do { ++ph; } while (0)
#else
#define SEAM() do { XcdBarrier b2_ = bar; asm volatile("" : "+s"(b2_.bar), "+s"(b2_.x)); xcd_barrier(b2_, hw_tid(F.wave)); } while (0)
#endif
#define PHASE_FRAME(Fp) Frame Fp = F; Fp.tid = hw_tid(F.wave); asm volatile("" : "+s"(Fp.ws), "+s"(Fp.out), "+v"(Fp.tid), "+s"(Fp.G), "+s"(Fp.bid)); Fp.lane = Fp.tid & 63
#if MK_PER_PHASE
#define REPBAR() do { } while (0)
#else
#define REPBAR() do { XcdBarrier b3_ = bar; asm volatile("" : "+s"(b3_.bar), "+s"(b3_.x)); xcd_barrier(b3_, hw_tid(F.wave)); } while (0)
#endif
    LAS unsigned char* ring = F.lds;
    LAS float* rtab = (LAS float*)(F.lds + RTAB_OFF); LAS float* stab = (LAS float*)(F.lds + STAB_OFF); LAS float* rawt = (LAS float*)(F.lds + RAW_OFF);

    if (PHON(0) && IN_PH()) {
_Pragma("unroll 1") for (int rep_ = 0; rep_ < NREP(0); ++rep_) { if (rep_) REPBAR(); PHASE_FRAME(Fp); p_prologue(Fp); } }
    SEAM();
#pragma unroll 1
    for (int L = 0; L < DEPTH; ++L) {
        if (PHON(1) && IN_PH()) {
_Pragma("unroll 1") for (int rep_ = 0; rep_ < NREP(1); ++rep_) { if (rep_) REPBAR();
            PHASE_FRAME(Fp); gf_t ssq4 = wsf(Fp, WS_SSQ4); gbf_t xb = wsb(Fp, WS_XB); (void)ssq4; (void)xb;
            pg8::StaticOrder S; S.init(NTOK, IN_COLS, Fp.G, Fp.bid);
            if (L < 2) { pg8::Gemm g{xb, wsb(Fp, WS_WIN) + (size_t)L * IN_COLS * DM, DM, DM, DM};
                pg8::EpiIn E{pg8::PreSsq4{ssq4, rtab, rawt}, wsb(Fp, WS_U), wsb(Fp, WS_P), wsb(Fp, WS_RQ), wsb(Fp, WS_SGP), 1.0f};
                pg8::gemm_phase<pg8::EpiIn, pg8::StaticOrder, pg8::KPlain>(ring, g, S, E, Fp.wave); }
            else { pg8::Gemm g{wsb(Fp, WS_XB8), wsb(Fp, WS_WIN8 + (size_t)(L - 2) * IN_COLS * DM), DM / 2, DM / 2, DM / 2};
                pg8::EpiIn E{pg8::PreSsq4{ssq4, rtab, rawt}, wsb(Fp, WS_U), wsb(Fp, WS_P), wsb(Fp, WS_RQ), wsb(Fp, WS_SGP), 0.03125f};
                pg8::gemm_phase<pg8::EpiIn, pg8::StaticOrder, pg8::KPlain, true>(ring, g, S, E, Fp.wave); }
        } }
        SEAM();
#if (DUP_MASK >> 12) & 1
        if (IN_PH()) { REPBAR();
            PHASE_FRAME(Fp);
            pg8::Gemm g{wsb(Fp, WS_XB), wsb(Fp, WS_WIN) + (size_t)L * IN_COLS * DM, DM, DM, DM}; pg8::HotOrder S{7, 0};
            pg8::EpiY E{pg8::PreNone{}, wsb(Fp, WS_ACT + 330 * MiB), 1.0f, nullptr, 0, 0};
            pg8::gemm_phase<pg8::EpiY, pg8::HotOrder, pg8::KPlain>(ring, g, S, E, Fp.wave);
        }
#endif
        if (PHON(2) && IN_PH()) {
_Pragma("unroll 1") for (int rep_ = 0; rep_ < NREP(2); ++rep_) { if (rep_) REPBAR(); PHASE_FRAME(Fp); p_cp(Fp, L); } }
        SEAM();
        if (PHON(3) && IN_PH()) {
_Pragma("unroll 1") for (int rep_ = 0; rep_ < NREP(3); ++rep_) { if (rep_) REPBAR();
            PHASE_FRAME(Fp); gf_t ssq4 = wsf(Fp, WS_SSQ4); gbf_t xb = wsb(Fp, WS_XB); (void)ssq4; (void)xb;
            pg8::Gemm g{wsb(Fp, WS_SD), wsb(Fp, WS_WM) + (size_t)L * DM * 640, DM, 640, 640, 2, SG_MG}; pg8::StaticOrder S; S.init(NTOK, DM, Fp.G, Fp.bid);
            if (L < 2) { pg8::EpiMerge<false> E{pg8::PreNone{}, wsb(Fp, WS_RQ), wsb(Fp, WS_SGP), wsb(Fp, WS_MERGED)}; pg8::gemm_phase<pg8::EpiMerge<false>, pg8::StaticOrder, pg8::KMerge>(ring, g, S, E, Fp.wave); }
            else { pg8::EpiMerge<true> E{pg8::PreNone{}, wsb(Fp, WS_RQ), wsb(Fp, WS_SGP), wsb(Fp, WS_MERGED)}; pg8::gemm_phase<pg8::EpiMerge<true>, pg8::StaticOrder, pg8::KMerge>(ring, g, S, E, Fp.wave); }
        } }
        SEAM();
        if (PHON(4) && IN_PH()) { {
            PHASE_FRAME(Fp); gf_t ssq4 = wsf(Fp, WS_SSQ4); gbf_t xb = wsb(Fp, WS_XB); (void)ssq4; (void)xb;
            pg8::StaticOrder S; S.init(NTOK, DM, Fp.G, Fp.bid);
            if (L < 2) { pg8::Gemm g{wsb(Fp, WS_MERGED), wsb(Fp, WS_WOUT) + (size_t)L * DM * DM, DM, DM, DM, 2, SG_OUT};
                pg8::EpiRes E{pg8::PreNone{}, xb, ssq4, stab, 1.0f, nullptr};
                pg8::gemm_phase<pg8::EpiRes, pg8::StaticOrder, pg8::KPlain>(ring, g, S, E, Fp.wave); }
            else { pg8::Gemm g{wsb(Fp, WS_MERGED), wsb(Fp, WS_WOUT + (size_t)L * DM * DM * 2), DM / 2, DM / 2, DM / 2, 2, SG_OUT};
                pg8::EpiRes E{pg8::PreNone{}, xb, ssq4, stab, 0.03125f, L == 2 ? Fp.ws + WS_XB8 : (GAS unsigned char*)nullptr};
                pg8::gemm_phase<pg8::EpiRes, pg8::StaticOrder, pg8::KPlain, true>(ring, g, S, E, Fp.wave); }
        } }
        SEAM();
        if ((L & 1) == 0) {
            const int i = L >> 1;
            if (PHON(5) && IN_PH()) {
_Pragma("unroll 1") for (int rep_ = 0; rep_ < NREP(5); ++rep_) { if (rep_) REPBAR();
            PHASE_FRAME(Fp); gf_t ssq4 = wsf(Fp, WS_SSQ4); gbf_t xb = wsb(Fp, WS_XB); (void)ssq4; (void)xb;
                pg8::StaticOrder S; S.init(NTOK, 2 * DFF, Fp.G, Fp.bid);
                if (i == 0) { pg8::Gemm g{xb, wsb(Fp, WS_DGU), DM, DM, DM};
                    pg8::EpiSwiglu<pg8::PreSsq4, false> E{pg8::PreSsq4{ssq4, rtab, rawt}, wsb(Fp, WS_HMID), DFF};
                    pg8::gemm_phase<pg8::EpiSwiglu<pg8::PreSsq4, false>, pg8::StaticOrder, pg8::KPlain>(ring, g, S, E, Fp.wave); }
                else { pg8::Gemm g{wsb(Fp, WS_XB8), wsb(Fp, WS_DGU8), DM / 2, DM / 2, DM / 2};
                    pg8::EpiSwiglu<pg8::PreSsq4, true> E{pg8::PreSsq4{ssq4, rtab, rawt}, Fp.ws + WS_H8, DFF};
                    pg8::gemm_phase<pg8::EpiSwiglu<pg8::PreSsq4, true>, pg8::StaticOrder, pg8::KPlain, true>(ring, g, S, E, Fp.wave); }
            } }
            SEAM();
            if (PHON(6) && IN_PH()) {
            PHASE_FRAME(Fp); gf_t ssq4 = wsf(Fp, WS_SSQ4); gbf_t xb = wsb(Fp, WS_XB); (void)ssq4; (void)xb;
                pg8::StaticOrder S; S.init(NTOK, DM, Fp.G, Fp.bid);
                if (i == 0) { pg8::Gemm g{wsb(Fp, WS_HMID), wsb(Fp, WS_DD), DFF, DFF, DFF, 2, SG_F2};
                    pg8::EpiRes E{pg8::PreNone{}, xb, ssq4, stab, 1.0f, nullptr};
                    pg8::gemm_phase<pg8::EpiRes, pg8::StaticOrder, pg8::KPlain>(ring, g, S, E, Fp.wave); }
                else { pg8::Gemm g{wsb(Fp, WS_H8), wsb(Fp, WS_DD8), DFF / 2, DFF / 2, DFF / 2, 2, SG_F2};
                    pg8::EpiRes E{pg8::PreNone{}, xb, ssq4, stab, 1.0f / 256.0f, Fp.ws + WS_XB8};
                    pg8::gemm_phase<pg8::EpiRes, pg8::StaticOrder, pg8::KPlain, true>(ring, g, S, E, Fp.wave); }
            }
            SEAM();
        } else {
            const int i = L >> 1;
            if (PHON(7) && IN_PH()) {
_Pragma("unroll 1") for (int rep_ = 0; rep_ < NREP(7); ++rep_) { if (rep_) REPBAR(); PHASE_FRAME(Fp); p_r1(Fp, i, L); } }
            SEAM();
            if (PHON(8) && IN_PH()) {
_Pragma("unroll 1") for (int rep_ = 0; rep_ < NREP(8); ++rep_) { if (rep_) REPBAR(); PHASE_FRAME(Fp); p_r2(Fp); } }
            SEAM();
            if (PHON(9) && IN_PH()) {
_Pragma("unroll 1") for (int rep_ = 0; rep_ < NREP(9); ++rep_) { if (rep_) REPBAR();
            PHASE_FRAME(Fp); gf_t ssq4 = wsf(Fp, WS_SSQ4); gbf_t xb = wsb(Fp, WS_XB); (void)ssq4; (void)xb;
                LAS unsigned* ptab = (LAS unsigned*)(Fp.lds + PTAB_OFF);
                for (int q = Fp.tid; q < 512; q += NWAVES * 64) ptab[q] = __hip_atomic_load(wsu(Fp, WS_PANEL) + q, RLX_AGENT);
                LDS_WAIT(); __syncthreads();
                pg8::Gemm g{wsb(Fp, WS_XG), wsb(Fp, WS_MGU + (size_t)i * NEXP * 2 * DFFE * DM), DM / 2, DM / 2, DM / 2}; pg8::MoeOrder S; S.init(ptab, 2 * DFFE, Fp.G, Fp.bid);
                pg8::EpiSwiglu8 E{pg8::PreNone{}, Fp.ws + WS_HE, DFFE};
                pg8::gemm_phase<pg8::EpiSwiglu8, pg8::MoeOrder, pg8::KPlain, true>(ring, g, S, E, Fp.wave);
            } }
            SEAM();
            if (PHON(10) && IN_PH()) {
_Pragma("unroll 1") for (int rep_ = 0; rep_ < NREP(10); ++rep_) { if (rep_) REPBAR();
            PHASE_FRAME(Fp); gf_t ssq4 = wsf(Fp, WS_SSQ4); gbf_t xb = wsb(Fp, WS_XB); (void)ssq4; (void)xb;
                LAS unsigned* ptab = (LAS unsigned*)(Fp.lds + PTAB_OFF);
                for (int q = Fp.tid; q < 512; q += NWAVES * 64) ptab[q] = __hip_atomic_load(wsu(Fp, WS_PANEL) + q, RLX_AGENT);
                LDS_WAIT(); __syncthreads();
                pg8::Gemm g{wsb(Fp, WS_HE), wsb(Fp, WS_MD + (size_t)i * NEXP * DM * DFFE), DFFE / 2, DFFE / 2, DFFE / 2}; pg8::MoeOrder2 S; S.init(ptab, Fp.G, Fp.bid);
                pg8::EpiY E{pg8::PreNone{}, wsb(Fp, WS_Y), 1.0f / 256.0f, wsb(Fp, WS_YP), S.mainP * 256, S.S == 7 ? pg8::TAIL_ROWS : pg8::TAIL_ROWS2};
                pg8::gemm_phase<pg8::EpiY, pg8::MoeOrder2, pg8::KPlainV, true, true>(ring, g, S, E, Fp.wave);
            } }
            SEAM();
            if (PHON(11) && IN_PH()) { PHASE_FRAME(Fp); p_cb(Fp, L == DEPTH - 1); }
            if (L != DEPTH - 1) SEAM();
        }
    }
#undef IN_PH
#undef SEAM
}

extern "C" void kernel_launch(void* const* d_in, const int* in_sizes, int n_in, void* d_out, int out_size, void* d_ws, size_t ws_size, hipStream_t stream) {
    static int grid = 0;
    if (grid == 0) {
        if (n_in != 20 || in_sizes[0] != NTOK * DM || out_size != NTOK * DM || ws_size < WS_END2) { fprintf(stderr, "kernel_launch: unexpected shapes / workspace (%d inputs, ws %zu, need %zu)\n", n_in, ws_size, (size_t)WS_END2); grid = -1; return; }
        int dev = 0, cus = 0, per_cu = 0;
        if (hipGetDevice(&dev) != hipSuccess || hipDeviceGetAttribute(&cus, hipDeviceAttributeMultiprocessorCount, dev) != hipSuccess) { grid = -1; return; }
        if (hipFuncSetAttribute((const void*)trunk_fwd, hipFuncAttributeMaxDynamicSharedMemorySize, LDS_BYTES) != hipSuccess) { fprintf(stderr, "kernel_launch: hipFuncSetAttribute failed\n"); grid = -1; return; }
        if (hipOccupancyMaxActiveBlocksPerMultiprocessor(&per_cu, (const void*)trunk_fwd, NWAVES * 64, LDS_BYTES) != hipSuccess || per_cu < 1) { fprintf(stderr, "kernel_launch: occupancy query says %d blocks per CU\n", per_cu); grid = -1; (void)hipGetLastError(); return; }
        grid = cus;
    }
    if (grid < 0) return;
    if (hipMemsetAsync((char*)d_ws + WS_CTL, 0, CTL_ZERO_BYTES, stream) != hipSuccess) return;
    Args a{};
    for (int i = 0; i < 20; ++i) a.in[i] = (const float*)d_in[i];
    a.out = (float*)d_out; a.ws = (unsigned char*)d_ws;
#if MK_PER_PHASE
    for (int p = 0; p < N_PHASES; ++p) { a.ph_lo = p; a.ph_hi = p + 1; hipLaunchKernelGGL(trunk_fwd, dim3(grid), dim3(NWAVES * 64), LDS_BYTES, stream, a); }
#else
    a.ph_lo = 0; a.ph_hi = N_PHASES;
    hipLaunchKernelGGL(trunk_fwd, dim3(grid), dim3(NWAVES * 64), LDS_BYTES, stream, a);
#endif
}
```

```cpp
#include <hip/hip_runtime.h>
#include <cstdio>
#include <cstdint>

#ifndef PH_MASK
#define PH_MASK 0xFFF
#endif
#define PHON(b) ((PH_MASK >> (b)) & 1)
#ifndef DUP_MASK
#define DUP_MASK 0
#endif
#define NREP(b) (((DUP_MASK >> (b)) & 1) ? 2 : 1)
#ifndef MK_PER_PHASE
#define MK_PER_PHASE 0
#endif

#define LAS __attribute__((address_space(3)))
#define GAS __attribute__((address_space(1)))
typedef unsigned short bf16_t;
typedef short bf16x8 __attribute__((ext_vector_type(8)));
typedef float f32x4 __attribute__((ext_vector_type(4)));
typedef float f32x2 __attribute__((ext_vector_type(2)));
typedef unsigned u32x4 __attribute__((ext_vector_type(4)));
typedef unsigned u32x2 __attribute__((ext_vector_type(2)));
typedef GAS unsigned gu32;
typedef GAS bf16_t* gbf_t; typedef const GAS bf16_t* gcbf_t; typedef GAS float* gf_t; typedef const GAS float* gcf_t; typedef GAS unsigned* gu_t;
#define ST4U(p) (*(GAS u32x4*)(p))
#define LD4U(p) (*(const GAS u32x4*)(p))
#define ST4F(p) (*(GAS f32x4*)(p))
#define LD4F(p) (*(const GAS f32x4*)(p))
#define RLX_AGENT __ATOMIC_RELAXED, __HIP_MEMORY_SCOPE_AGENT

constexpr int NTOK = 32768, DM = 1024, SEQ = 8192, DEPTH = 4;
constexpr int CONV_DIM = 512, CONV_W = 31;
constexpr int IN_COLS = 3584;
constexpr int DFF = 2816, NEXP = 8, DFFE = 3584;
constexpr int NSLOT = 2 * NTOK + NEXP * 256;
constexpr float RMS_EPS = 1e-6f, LN_EPS = 1e-5f;
constexpr int NWAVES = 8;

constexpr size_t MiB = 1u << 20;
constexpr size_t WS_CTL = 0, CTL_ZERO_BYTES = 65536;
constexpr size_t WS_SSQ4 = 1 * MiB;
constexpr size_t WS_TOKE = 3 * MiB;
constexpr size_t WS_TOKP = WS_TOKE + 131072;
constexpr size_t WS_TOKR = WS_TOKP + 131072;
constexpr size_t WS_SLOTOF = WS_TOKR + 131072;
constexpr size_t WS_CNT = WS_SLOTOF + 262144;
constexpr size_t WS_PANEL = WS_CNT + 8192;
constexpr size_t WS_RSLOT = WS_PANEL + 4096;
constexpr size_t WS_WIN = 6 * MiB;
constexpr size_t WS_WM = 34 * MiB;
constexpr size_t WS_WOUT = 39 * MiB;
constexpr size_t WS_DGU = 47 * MiB;
constexpr size_t WS_DD = 69 * MiB;
constexpr size_t WS_MGU = 80 * MiB;
constexpr size_t WS_MD = 192 * MiB;
constexpr size_t WS_XB = 248 * MiB;
constexpr size_t WS_ACT = 312 * MiB;
constexpr size_t WS_U = WS_ACT;
constexpr size_t WS_P = WS_ACT + 32 * MiB;
constexpr size_t WS_RQ = WS_ACT + 64 * MiB;
constexpr size_t WS_SGP = WS_ACT + 128 * MiB;
constexpr size_t WS_SD = WS_ACT + 192 * MiB;
constexpr size_t WS_MERGED = WS_ACT + 256 * MiB;
constexpr size_t WS_HMID = WS_ACT;
constexpr size_t WS_XG = WS_ACT;
constexpr size_t WS_Y = WS_ACT + 66 * MiB;
constexpr size_t WS_HE = WS_ACT + 198 * MiB;
constexpr size_t WS_H8 = WS_ACT;
constexpr size_t WS_YP = WS_ACT + 464 * MiB;
constexpr size_t WS_END = WS_ACT + 594 * MiB;
constexpr size_t WS_XB8 = WS_ACT + 432 * MiB;
constexpr size_t WS_WIN8 = 20 * MiB;
constexpr size_t WS_DGU8 = 58 * MiB;
constexpr size_t WS_DD8 = 75 * MiB;
constexpr size_t WS_END2 = WS_END;
static_assert(WS_WIN + (size_t)2 * IN_COLS * DM * 2 <= WS_WIN8 && WS_WIN8 + (size_t)2 * IN_COLS * DM <= WS_WM && WS_DGU + (size_t)2 * DFF * DM * 2 <= WS_DGU8 && WS_DGU8 + (size_t)2 * DFF * DM <= WS_DD && WS_DD + (size_t)DM * DFF * 2 <= WS_DD8 && WS_DD8 + (size_t)DM * DFF <= WS_MGU && WS_XB8 + (size_t)NTOK * DM <= WS_END && WS_HE + (size_t)NSLOT * DFFE <= WS_XB8, "d_ws map (fp8 copies)");
static_assert((size_t)NSLOT * DM <= 66 * MiB && (size_t)NSLOT * DM * 2 <= 132 * MiB && WS_HE + (size_t)NSLOT * DFFE <= WS_END && (size_t)2 * NEXP * 2 * DFFE * DM <= 112 * MiB && (size_t)2 * NEXP * DFFE * DM <= 56 * MiB, "d_ws map");

constexpr int CW_BAR = 4096;

constexpr int RING_BYTES = 131072;
constexpr int LDSCTL_OFF = RING_BYTES, MISC_OFF = LDSCTL_OFF + 320, PTAB_OFF = LDSCTL_OFF + 1024;
constexpr int RTAB_OFF = LDSCTL_OFF + 3072, STAB_OFF = LDSCTL_OFF + 4096, RAW_OFF = LDSCTL_OFF + 8192;
constexpr int LDS_BYTES = 147456;

__device__ __forceinline__ unsigned cvt_pk_bf16(float lo, float hi) { unsigned r; asm volatile("v_cvt_pk_bf16_f32 %0, %1, %2" : "=v"(r) : "v"(lo), "v"(hi)); return r; }
__device__ __forceinline__ float bf_lo(unsigned w) { return __uint_as_float(w << 16); }
__device__ __forceinline__ float bf_hi(unsigned w) { return __uint_as_float(w & 0xffff0000u); }
__device__ __forceinline__ float fast_exp(float x) { return __builtin_amdgcn_exp2f(x * 1.4426950408889634f); }
__device__ __forceinline__ float clamp30(float x) { return __builtin_fminf(__builtin_fmaxf(x, -30.f), 30.f); }
__device__ __forceinline__ float sigmoidf_(float x) { return __builtin_amdgcn_rcpf(1.0f + fast_exp(-clamp30(x))); }
__device__ __forceinline__ int hw_tid(int wave) { unsigned ones = ~0u; asm volatile("" : "+s"(ones));
    return wave * 64 + (int)__builtin_amdgcn_mbcnt_hi(ones, __builtin_amdgcn_mbcnt_lo(ones, 0u)); }
template <int M> __device__ __forceinline__ int shx_i(int v, int lane) {
    if constexpr (M < 32) return __builtin_amdgcn_ds_swizzle(v, (M << 10) | 0x1F);
    else return __builtin_amdgcn_ds_bpermute((lane ^ 32) << 2, v);
}
template <int M> __device__ __forceinline__ float shx(float v, int lane) { return __int_as_float(shx_i<M>(__float_as_int(v), lane)); }
__device__ __forceinline__ float wave_sum_l(float v, int lane) { v += shx<1>(v, lane); v += shx<2>(v, lane); v += shx<4>(v, lane); v += shx<8>(v, lane); v += shx<16>(v, lane); v += shx<32>(v, lane); return v; }
#define LDS_WAIT() asm volatile("s_waitcnt lgkmcnt(0)" ::: "memory")
#define VM_WAIT() asm volatile("s_waitcnt vmcnt(0)" ::: "memory")

namespace pg8 {
constexpr int BM = 256, BK = 64, HALF = 128, HTB = HALF * BK * 2, STAGE_BYTES = 8 * HTB, NXCD = 8, WGM = 8;
__host__ __device__ __forceinline__ int lds_byte(int r, int c) { const int st = (r >> 4) * 2 + (c >> 5), rr = r & 15, cc = c & 31, ob = rr * 64 + cc * 2; return st * 1024 + (ob ^ (((ob >> 9) & 1) << 5)); }
__host__ __device__ __forceinline__ void stage_rc(int b, int& R, int& C) { const int st = b / 1024, sb = b % 1024, swz = sb ^ (((sb >> 9) & 1) << 5); R = (st >> 1) * 16 + swz / 64; C = (st & 1) * 32 + (swz % 64) / 2; }
__host__ __device__ __forceinline__ int perm32(int rho) { const int n = rho >> 4, i = rho & 15; return 8 * (i >> 2) + 4 * n + (i & 3); }

struct Unit { int pm, pn, pb; int kt0 = 0, ntu = 0, part = -1; };
struct Gemm { gcbf_t A; gcbf_t Bt; int lda, ldb, K; int sg_n = 4, sg_k = 0; };

struct KPlain { static __device__ __forceinline__ int koff(const Unit&, int t) { return t * BK; } };
struct KPlainV { static __device__ __forceinline__ int koff(const Unit& u, int t) { return (u.kt0 + t) * BK; } };
struct KMerge { static __device__ __forceinline__ int koff(const Unit& u, int t) { return t < 8 ? 512 + t * BK : u.pn * 128 + (t - 8) * BK; } };

struct StaticOrder {
    int nM, nN, nwg, G, c;
    __device__ __forceinline__ void init(int M, int N, int G_, int c_) { nM = M / BM; nN = N / BM; nwg = nM * nN; G = G_; c = c_; }
    __device__ __forceinline__ bool next(int i, Unit& u) const {
        const long L = (long)i * G + c; if (i > 0 && L >= nwg) return false;
        int wgid = (int)L; { const int q = nwg / NXCD, r = nwg % NXCD, xcd = wgid % NXCD, off = wgid / NXCD; wgid = (xcd < r ? xcd * (q + 1) : r * (q + 1) + (xcd - r) * q) + off; }
        const int nig = WGM * nN, gid = wgid / nig, fm = gid * WGM, gsz = (nM - fm) < WGM ? (nM - fm) : WGM;
        u.pm = __builtin_amdgcn_readfirstlane(fm + ((wgid % nig) % gsz)); u.pn = __builtin_amdgcn_readfirstlane((wgid % nig) / gsz); u.pb = u.pn; return true;
    }
};
struct HotOrder { int NU; int c; __device__ __forceinline__ bool next(int i, Unit& u) const { if (i >= NU) return false; u.pm = 0; u.pn = 0; u.pb = 0; return true; } };
struct MoeOrder {
    int nM, nN, nwg, G, c; const LAS unsigned* ptab;
    __device__ __forceinline__ void init(const LAS unsigned* pt, int N, int G_, int c_) { ptab = pt; nM = __builtin_amdgcn_readfirstlane((int)pt[0]); nN = N / BM; nwg = nM * nN; G = G_; c = c_; }
    __device__ __forceinline__ bool next(int i, Unit& u) const {
        const long L = (long)i * G + c; if (i > 0 && L >= nwg) return false;
        int wgid = (int)L; { const int q = nwg / NXCD, r = nwg % NXCD, xcd = wgid % NXCD, off = wgid / NXCD; wgid = (xcd < r ? xcd * (q + 1) : r * (q + 1) + (xcd - r) * q) + off; }
        const int nig = WGM * nN, gid = wgid / nig, fm = gid * WGM, gsz = (nM - fm) < WGM ? (nM - fm) : WGM;
        u.pm = __builtin_amdgcn_readfirstlane(fm + ((wgid % nig) % gsz)); u.pn = __builtin_amdgcn_readfirstlane((wgid % nig) / gsz);
        u.pb = __builtin_amdgcn_readfirstlane((int)ptab[1 + u.pm]) * nN + u.pn; return true;
    }
};

struct MoeOrder2 {
    int nM, mainP, tailP, S, Um, nwg, G, c; const LAS unsigned* ptab;
    static __device__ __forceinline__ void split(int nM_, int G_, int& mainP_, int& tailP_, int& S_) {
        tailP_ = (G_ % 4 == 0) ? nM_ % (G_ / 4) : 0; S_ = tailP_ == 0 ? 1 : (28 * tailP_ <= G_ ? 7 : (8 * tailP_ <= G_ ? 2 : 1));
        if (S_ == 1) tailP_ = 0; mainP_ = nM_ - tailP_; }
    __device__ __forceinline__ void init(const LAS unsigned* pt, int G_, int c_) { ptab = pt; nM = __builtin_amdgcn_readfirstlane((int)pt[0]); G = G_; c = c_; split(nM, G, mainP, tailP, S); mainP = __builtin_amdgcn_readfirstlane(mainP); tailP = __builtin_amdgcn_readfirstlane(tailP); S = __builtin_amdgcn_readfirstlane(S); Um = mainP * 4; nwg = Um + tailP * 4 * S; }
    __device__ __forceinline__ bool next(int i, Unit& u) const {
        const long L = (long)i * G + c; if (i > 0 && L >= nwg) return false;
        if (L < Um) { int wgid = (int)L; { const int q = Um / NXCD, r = Um % NXCD, xcd = wgid % NXCD, off = wgid / NXCD; wgid = (xcd < r ? xcd * (q + 1) : r * (q + 1) + (xcd - r) * q) + off; }
            const int nig = WGM * 4, gid = wgid / nig, fm = gid * WGM, gsz = (mainP - fm) < WGM ? (mainP - fm) : WGM;
            u.pm = __builtin_amdgcn_readfirstlane(fm + ((wgid % nig) % gsz)); u.pn = __builtin_amdgcn_readfirstlane((wgid % nig) / gsz); u.kt0 = 0; u.ntu = 28; u.part = -1; }
        else { const int q = (int)L - Um, j = q / S, sp = q % S; u.pm = __builtin_amdgcn_readfirstlane(mainP + j / 4); u.pn = __builtin_amdgcn_readfirstlane(j % 4); u.ntu = __builtin_amdgcn_readfirstlane(28 / S); u.kt0 = __builtin_amdgcn_readfirstlane(sp * (28 / S)); u.part = __builtin_amdgcn_readfirstlane(sp); }
        u.pb = __builtin_amdgcn_readfirstlane((int)ptab[1 + u.pm]) * 4 + u.pn; return true;
    }
};

typedef f32x4 Acc[2][2][4][2];

__device__ __forceinline__ u32x4 pack8(const f32x4 v0, const f32x4 v1) { u32x4 w; w.x = cvt_pk_bf16(v0[0], v0[1]); w.y = cvt_pk_bf16(v0[2], v0[3]); w.z = cvt_pk_bf16(v1[0], v1[1]); w.w = cvt_pk_bf16(v1[2], v1[3]); return w; }
__device__ __forceinline__ void unpack8(const u32x4 w, f32x4& v0, f32x4& v1) { v0 = (f32x4){bf_lo(w.x), bf_hi(w.x), bf_lo(w.y), bf_hi(w.y)}; v1 = (f32x4){bf_lo(w.z), bf_hi(w.z), bf_lo(w.w), bf_hi(w.w)}; }

__device__ __forceinline__ unsigned long long uni64(const GAS char* p) { const unsigned long long v = (unsigned long long)p; const unsigned lo = __builtin_amdgcn_readfirstlane((unsigned)v), hi = __builtin_amdgcn_readfirstlane((unsigned)(v >> 32)); return ((unsigned long long)hi << 32) | lo; }
typedef short s16x2 __attribute__((ext_vector_type(2)));
__device__ __forceinline__ unsigned pk_fp8x4_s(float a, float b, float c, float d, float scale) { s16x2 w = {0, 0}; w = __builtin_amdgcn_cvt_scalef32_pk_fp8_f32(w, a, b, scale, false); w = __builtin_amdgcn_cvt_scalef32_pk_fp8_f32(w, c, d, scale, true); return __builtin_bit_cast(unsigned, w); }
__device__ __forceinline__ unsigned pk_fp8x4(float a, float b, float c, float d) { int w = __builtin_amdgcn_cvt_pk_fp8_f32(a, b, 0, false); w = __builtin_amdgcn_cvt_pk_fp8_f32(c, d, w, true); return (unsigned)w; }

__device__ __forceinline__ void unpack_fp8x8(const u32x2 w, f32x4& a, f32x4& b) {
    const f32x2 a0 = __builtin_amdgcn_cvt_pk_f32_fp8((int)w.x, false), a1 = __builtin_amdgcn_cvt_pk_f32_fp8((int)w.x, true), b0 = __builtin_amdgcn_cvt_pk_f32_fp8((int)w.y, false), b1 = __builtin_amdgcn_cvt_pk_f32_fp8((int)w.y, true);
    a = (f32x4){a0.x, a0.y, a1.x, a1.y}; b = (f32x4){b0.x, b0.y, b1.x, b1.y}; }

struct PreNone { static constexpr bool HAS_PRE = false;
    __device__ __forceinline__ void issue(const Unit&, int, int) const {}
    __device__ __forceinline__ void finish(int) const {} };
struct PreSsq4 { static constexpr bool HAS_PRE = true;
    gcf_t ssq4; LAS float* rtab; LAS float* raw;
    __device__ __forceinline__ void issue(const Unit& u, int tid, int wid) const {
        if (wid < 4) { int te = tid; asm volatile("" : "+v"(te)); const unsigned vo = (unsigned)te * 4u, l0 = (unsigned)(size_t)raw + (unsigned)wid * 256u;
#pragma unroll
            for (int k = 0; k < 4; ++k) { unsigned keep;
                asm volatile("s_mov_b32 %0, m0\n\ts_mov_b32 m0, %3\n\ts_nop 0\n\tglobal_load_lds_dword %1, %2\n\ts_mov_b32 m0, %0" : "=&s"(keep) : "v"(vo), "s"(uni64((const GAS char*)(ssq4 + u.pm * BM + k * NTOK))), "s"(l0 + (unsigned)k * 1024u) : "memory"); } } }
    __device__ __forceinline__ void finish(int tid) const {
        asm volatile("s_waitcnt vmcnt(16)" ::: "memory");
        int te = tid; asm volatile("" : "+v"(te));
        if (te < 256) { const unsigned la = (unsigned)(size_t)raw + (unsigned)te * 4u; float a, b, c, d;
            asm volatile("ds_read_b32 %0, %4\n\tds_read_b32 %1, %4 offset:1024\n\tds_read_b32 %2, %4 offset:2048\n\tds_read_b32 %3, %4 offset:3072\n\ts_waitcnt lgkmcnt(0)" : "=&v"(a), "=&v"(b), "=&v"(c), "=&v"(d) : "v"(la) : "memory");
            rtab[te] = __builtin_amdgcn_rsqf(((a + b) + (c + d)) * (1.0f / DM) + RMS_EPS); } } };
struct PreRow { static constexpr bool HAS_PRE = true;
    gcf_t rrow; LAS float* rtab; LAS float* raw;
    __device__ __forceinline__ void issue(const Unit& u, int tid, int wid) const {
        if (wid < 4) { int te = tid; asm volatile("" : "+v"(te)); const unsigned vo = (unsigned)te * 4u, l0 = (unsigned)(size_t)raw + (unsigned)wid * 256u; unsigned keep;
            asm volatile("s_mov_b32 %0, m0\n\ts_mov_b32 m0, %3\n\ts_nop 0\n\tglobal_load_lds_dword %1, %2\n\ts_mov_b32 m0, %0" : "=&s"(keep) : "v"(vo), "s"(uni64((const GAS char*)(rrow + u.pm * BM))), "s"(l0) : "memory"); } }
    __device__ __forceinline__ void finish(int tid) const {
        asm volatile("s_waitcnt vmcnt(16)" ::: "memory");
        int te = tid; asm volatile("" : "+v"(te));
        if (te < 256) { const unsigned la = (unsigned)(size_t)raw + (unsigned)te * 4u; float a;
            asm volatile("ds_read_b32 %0, %1\n\ts_waitcnt lgkmcnt(0)" : "=&v"(a) : "v"(la) : "memory");
            rtab[te] = a; } } };

struct EpiIn {
    static constexpr bool HAS_MID = false; static constexpr int MID_T = -1; typedef PreSsq4 Pre;
    Pre pre; gbf_t U, P, RQ, SGP; float ascale;
    __device__ __forceinline__ void mid(Acc&, const Unit&, int, int, int, int) const {}
    __device__ __forceinline__ void operator()(const Acc& acc, const Unit& u, int wr, int wc, int fr, int fq) const {
        const int rl0 = wr * 64 + fr, row0 = u.pm * BM + rl0, cw = wc * 32 + 8 * fq;
        float rs[2][4];
#pragma unroll
        for (int ai = 0; ai < 2; ++ai)
#pragma unroll
            for (int m = 0; m < 4; ++m) rs[ai][m] = pre.rtab[rl0 + ai * HALF + m * 16] * ascale;
        if (u.pn < 4) {
#pragma unroll
            for (int ai = 0; ai < 2; ++ai)
#pragma unroll
                for (int m = 0; m < 4; ++m) { const int row = row0 + ai * HALF + m * 16; const float r = rs[ai][m], rn = r * -1.4426950408889634f; f32x4 o[2];
#pragma unroll
                    for (int n = 0; n < 2; ++n)
#pragma unroll
                        for (int j = 0; j < 4; ++j) { const float a = acc[ai][0][m][n][j] * r, e = __builtin_amdgcn_exp2f(acc[ai][1][m][n][j] * rn); o[n][j] = a * __builtin_amdgcn_rcpf(1.0f + e); }
                    ST4U(U + ((unsigned)row * CONV_DIM + u.pn * 128 + cw)) = pack8(o[0], o[1]); }
        } else if (u.pn < 6) {
#pragma unroll
            for (int ai = 0; ai < 2; ++ai)
#pragma unroll
                for (int m = 0; m < 4; ++m) { const int row = row0 + ai * HALF + m * 16; const float r = rs[ai][m];
#pragma unroll
                    for (int bj = 0; bj < 2; ++bj) ST4U(P + ((unsigned)row * 512 + (u.pn - 4) * 256 + bj * HALF + cw)) = pack8(acc[ai][bj][m][0] * r, acc[ai][bj][m][1] * r); }
        } else {
#pragma unroll
            for (int ai = 0; ai < 2; ++ai)
#pragma unroll
                for (int m = 0; m < 4; ++m) { const int row = row0 + ai * HALF + m * 16; const float rn = rs[ai][m] * -1.4426950408889634f; unsigned qc[2][4], qp[2][4];
#pragma unroll
                    for (int n = 0; n < 2; ++n)
#pragma unroll
                        for (int j = 0; j < 4; ++j) { const float ec = __builtin_amdgcn_exp2f(acc[ai][0][m][n][j] * rn), ep = __builtin_amdgcn_exp2f(acc[ai][1][m][n][j] * rn);
                            qc[n][j] = __float_as_uint(__builtin_fmaf(__builtin_amdgcn_rcpf(1.0f + ec), 255.0f, 8388608.0f));
                            qp[n][j] = __float_as_uint(__builtin_fmaxf(__builtin_amdgcn_rcpf(1.0f + ep) * 255.0f, 1.0f) + 8388608.0f); }
                    const unsigned off = (unsigned)row * DM + (u.pn - 6) * 128 + cw;
                    u32x4 wq;
#pragma unroll
                    for (int d = 0; d < 4; ++d) { const int n = d >> 1, j = 2 * (d & 1);
                        wq[d] = __builtin_amdgcn_perm(__builtin_amdgcn_perm(qp[n][j + 1], qc[n][j + 1], 0x0c0c0400u), __builtin_amdgcn_perm(qp[n][j], qc[n][j], 0x0c0c0400u), 0x05040100u); }
                    ST4U((GAS unsigned char*)RQ + 2u * off) = wq; }
        }
    }
};
__device__ __forceinline__ u32x4 widen8(u32x2 a, u32x2 b) {
    const auto rx = __builtin_amdgcn_permlane16_swap(a.x, b.x, false, false), ry = __builtin_amdgcn_permlane16_swap(a.y, b.y, false, false);
    u32x4 o; o.x = rx[0]; o.y = ry[0]; o.z = rx[1]; o.w = ry[1]; return o; }
__device__ __forceinline__ void unpack_gates(const u32x4 w, f32x4& c0, f32x4& c1, f32x4& p0, f32x4& p1) {
    c0 = (f32x4){(float)(w.x & 255u), (float)((w.x >> 16) & 255u), (float)(w.y & 255u), (float)((w.y >> 16) & 255u)}; p0 = (f32x4){(float)((w.x >> 8) & 255u), (float)(w.x >> 24), (float)((w.y >> 8) & 255u), (float)(w.y >> 24)};
    c1 = (f32x4){(float)(w.z & 255u), (float)((w.z >> 16) & 255u), (float)(w.w & 255u), (float)((w.w >> 16) & 255u)}; p1 = (f32x4){(float)((w.z >> 8) & 255u), (float)(w.z >> 24), (float)((w.w >> 8) & 255u), (float)(w.w >> 24)}; }
template <bool F8  > struct EpiMerge {
    static constexpr bool HAS_MID = true; static constexpr int MID_T = 8; typedef PreNone Pre;
    Pre pre; gcbf_t RQ, SGP; gbf_t MG;
    __device__ __forceinline__ void mid(Acc& acc, const Unit& u, int wr, int wc, int fr, int fq) const {
        const int row0 = u.pm * BM + wr * 64 + fr, col0 = u.pn * BM + wc * 32 + 8 * fq;
        u32x4 wg_[2][4][2];
#pragma unroll
        for (int ai = 0; ai < 2; ++ai)
#pragma unroll
            for (int m = 0; m < 4; ++m)
#pragma unroll
                for (int bj = 0; bj < 2; ++bj) wg_[ai][m][bj] = LD4U((const GAS unsigned char*)RQ + 2u * ((unsigned)(row0 + ai * HALF + m * 16) * DM + col0 + bj * HALF));
        __builtin_amdgcn_sched_barrier(0);
#pragma unroll
        for (int ai = 0; ai < 2; ++ai)
#pragma unroll
            for (int m = 0; m < 4; ++m)
#pragma unroll
                for (int bj = 0; bj < 2; ++bj) { f32x4 c0, c1, p0, p1; unpack_gates(wg_[ai][m][bj], c0, c1, p0, p1);
#pragma unroll
                    for (int j = 0; j < 4; ++j) { acc[ai][bj][m][0][j] *= c0[j] * __builtin_amdgcn_rcpf(p0[j]); acc[ai][bj][m][1][j] *= c1[j] * __builtin_amdgcn_rcpf(p1[j]); } }
    }
    __device__ __forceinline__ void operator()(const Acc& acc, const Unit& u, int wr, int wc, int fr, int fq) const {
        const int row0 = u.pm * BM + wr * 64 + fr, col0 = u.pn * BM + wc * 32 + 8 * fq;
        u32x4 w[2][4][2]; u32x2 o8[2][2]; (void)o8;
#pragma unroll
        for (int ai = 0; ai < 2; ++ai)
#pragma unroll
            for (int m = 0; m < 4; ++m)
#pragma unroll
                for (int bj = 0; bj < 2; ++bj) w[ai][m][bj] = LD4U((const GAS unsigned char*)RQ + 2u * ((unsigned)(row0 + ai * HALF + m * 16) * DM + col0 + bj * HALF));
        __builtin_amdgcn_sched_barrier(0);
#pragma unroll
        for (int ai = 0; ai < 2; ++ai)
#pragma unroll
            for (int m = 0; m < 4; ++m)
#pragma unroll
                for (int bj = 0; bj < 2; ++bj) { f32x4 c0, c1, s0, s1; unpack_gates(w[ai][m][bj], c0, c1, s0, s1); (void)c0; (void)c1; const f32x4 a = acc[ai][bj][m][0] * (s0 * (1.0f / 255.0f)), b = acc[ai][bj][m][1] * (s1 * (1.0f / 255.0f));
                    if constexpr (F8) { o8[m & 1][bj].x = pk_fp8x4(a[0], a[1], a[2], a[3]); o8[m & 1][bj].y = pk_fp8x4(b[0], b[1], b[2], b[3]);
                        if (m & 1) ST4U((GAS unsigned char*)MG + ((unsigned)(row0 + ai * HALF + (m - 1) * 16 + (fq & 1) * 16) * DM + (col0 - 8 * (fq & 1)) + bj * HALF)) = widen8(o8[0][bj], o8[1][bj]); }
                    else ST4U(MG + ((unsigned)(row0 + ai * HALF + m * 16) * DM + col0 + bj * HALF)) = pack8(a, b); }
    }
};
struct EpiRes {
    static constexpr bool HAS_MID = false; static constexpr int MID_T = -1; typedef PreNone Pre;
    Pre pre; gbf_t xs; gf_t ssq4; LAS float* stab; float scale; GAS unsigned char* xb8;
    __device__ __forceinline__ void mid(Acc&, const Unit&, int, int, int, int) const {}
    __device__ __forceinline__ void operator()(const Acc& acc, const Unit& u, int wr, int wc, int fr, int fq) const {
        const int rl0 = wr * 64 + fr, col0 = u.pn * BM + wc * 32 + 8 * fq;
        u32x4 xw[2][4][2]; u32x2 w8[2][2];
#pragma unroll
        for (int ai = 0; ai < 2; ++ai)
#pragma unroll
            for (int m = 0; m < 4; ++m)
#pragma unroll
                for (int bj = 0; bj < 2; ++bj) xw[ai][m][bj] = LD4U(xs + ((unsigned)(u.pm * BM + rl0 + ai * HALF + m * 16) * DM + col0 + bj * HALF));
#pragma unroll
        for (int ai = 0; ai < 2; ++ai)
#pragma unroll
            for (int m = 0; m < 4; ++m) { const int rl = rl0 + ai * HALF + m * 16; const unsigned off = (unsigned)(u.pm * BM + rl) * DM + col0; float ss = 0.f;
#pragma unroll
                for (int bj = 0; bj < 2; ++bj) { f32x4 x0, x1; unpack8(xw[ai][m][bj], x0, x1);
                    const f32x4 y0 = x0 + acc[ai][bj][m][0] * scale, y1 = x1 + acc[ai][bj][m][1] * scale;
                    ST4U(xs + off + bj * HALF) = pack8(y0, y1);
                    if (xb8) { w8[m & 1][bj].x = pk_fp8x4(y0[0], y0[1], y0[2], y0[3]); w8[m & 1][bj].y = pk_fp8x4(y1[0], y1[1], y1[2], y1[3]);
                        if (m & 1) ST4U(xb8 + ((unsigned)(u.pm * BM + rl - 16 + (fq & 1) * 16) * DM + (col0 - 8 * (fq & 1)) + bj * HALF)) = widen8(w8[0][bj], w8[1][bj]); }
                    ss += ((y0[0] * y0[0] + y0[1] * y0[1]) + (y0[2] * y0[2] + y0[3] * y0[3])) + ((y1[0] * y1[0] + y1[1] * y1[1]) + (y1[2] * y1[2] + y1[3] * y1[3])); }
                ss += shx<16>(ss, fq * 16 + fr); ss += shx<32>(ss, fq * 16 + fr);
                if (fq == 0) stab[rl * 4 + wc] = ss; }
        asm volatile("s_waitcnt lgkmcnt(0)" ::: "memory"); __builtin_amdgcn_s_barrier(); asm volatile("" ::: "memory");
        const int tid = (wr * 4 + wc) * 64 + fq * 16 + fr;
        if (tid < 256) { const f32x4 v = *(const LAS f32x4*)(stab + tid * 4); ssq4[(unsigned)(u.pn * NTOK + u.pm * BM + tid)] = (v[0] + v[1]) + (v[2] + v[3]); }
    }
};
template <class PRE, bool O8  , bool IN8 = O8  > struct EpiSwiglu {
    static constexpr bool HAS_MID = false; static constexpr int MID_T = -1; typedef PRE Pre;
    Pre pre; GAS void* Hv; int ldh;
    __device__ __forceinline__ void mid(Acc&, const Unit&, int, int, int, int) const {}
    __device__ __forceinline__ void operator()(const Acc& acc, const Unit& u, int wr, int wc, int fr, int fq) const {
        const int rl0 = wr * 64 + fr, row0 = u.pm * BM + rl0, cw = wc * 32 + 8 * fq;
        float rs[2][4]; u32x2 w8[2]; (void)w8;
#pragma unroll
        for (int ai = 0; ai < 2; ++ai)
#pragma unroll
            for (int m = 0; m < 4; ++m) rs[ai][m] = pre.rtab[rl0 + ai * HALF + m * 16] * (IN8 ? 0.03125f : 1.0f);
#pragma unroll
        for (int ai = 0; ai < 2; ++ai)
#pragma unroll
            for (int m = 0; m < 4; ++m) { const int row = row0 + ai * HALF + m * 16; const float r = rs[ai][m], rr = O8 ? r * r * 4.0f : r * r, rn = r * -1.4426950408889634f; f32x4 o[2];
#pragma unroll
                for (int n = 0; n < 2; ++n)
#pragma unroll
                    for (int j = 0; j < 4; ++j) { float tg; asm("v_mul_f32 %0, %1, %2" : "=v"(tg) : "v"(acc[ai][0][m][n][j]), "v"(acc[ai][1][m][n][j]));
                        const float e = __builtin_amdgcn_exp2f(acc[ai][0][m][n][j] * rn); o[n][j] = tg * (rr * __builtin_amdgcn_rcpf(1.0f + e)); }
                if constexpr (O8) { w8[m & 1].x = pk_fp8x4(o[0][0], o[0][1], o[0][2], o[0][3]); w8[m & 1].y = pk_fp8x4(o[1][0], o[1][1], o[1][2], o[1][3]);
                    if (m & 1) ST4U((GAS unsigned char*)Hv + ((unsigned)(row - 16 + (fq & 1) * 16) * ldh + u.pn * 128 + cw - 8 * (fq & 1))) = widen8(w8[0], w8[1]); }
                else ST4U((gbf_t)Hv + ((unsigned)row * ldh + u.pn * 128 + cw)) = pack8(o[0], o[1]); }
    }
};
struct EpiSwiglu8 {
    static constexpr bool HAS_MID = false; static constexpr int MID_T = -1; typedef PreNone Pre;
    Pre pre; GAS unsigned char* H; int ldh;
    __device__ __forceinline__ void mid(Acc&, const Unit&, int, int, int, int) const {}
    __device__ __forceinline__ void operator()(const Acc& acc, const Unit& u, int wr, int wc, int fr, int fq) const {
        float c256 = 256.0f; asm volatile("" : "+s"(c256));
        const int row0 = u.pm * BM + wr * 64 + fr + (fq & 1) * 16, cw = wc * 32 + 8 * (fq & ~1);
#pragma unroll
        for (int ai = 0; ai < 2; ++ai)
#pragma unroll
            for (int mp = 0; mp < 2; ++mp) { u32x2 w[2];
#pragma unroll
                for (int q = 0; q < 2; ++q) { const int m = 2 * mp + q; f32x4 o[2];
#pragma unroll
                    for (int n = 0; n < 2; ++n)
#pragma unroll
                        for (int j = 0; j < 4; ++j) { float tg; asm("v_mul_f32 %0, %1, %2" : "=v"(tg) : "v"(acc[ai][0][m][n][j]), "v"(acc[ai][1][m][n][j]));
                            const float e = __builtin_amdgcn_exp2f(acc[ai][0][m][n][j] * (-0.03125f * 1.4426950408889634f)); o[n][j] = tg * __builtin_amdgcn_rcpf(1.0f + e); }
                    w[q].x = pk_fp8x4_s(o[0][0], o[0][1], o[0][2], o[0][3], c256); w[q].y = pk_fp8x4_s(o[1][0], o[1][1], o[1][2], o[1][3], c256); }
                ST4U(H + ((unsigned)(row0 + ai * HALF + mp * 32) * ldh + u.pn * 128 + cw)) = widen8(w[0], w[1]); }
    }
};
constexpr int TAIL_ROWS = 9 * 256;
constexpr int TAIL_ROWS2 = 32 * 256;
struct EpiY {
    static constexpr bool HAS_MID = false; static constexpr int MID_T = -1; typedef PreNone Pre;
    Pre pre; gbf_t Y; float scale; gbf_t YP; int main_rows, slab_rows;
    __device__ __forceinline__ void mid(Acc&, const Unit&, int, int, int, int) const {}
    __device__ __forceinline__ void operator()(const Acc& acc, const Unit& u, int wr, int wc, int fr, int fq) const {
        const int row0 = u.pm * BM + wr * 64 + fr, col0 = u.pn * BM + wc * 32 + 8 * fq;
        if (u.part < 0) { GAS unsigned char* base = (GAS unsigned char*)Y + (unsigned)(row0 + (fq & 1) * 16) * DM + (col0 - 8 * (fq & 1)); const float s16 = scale * 16.0f;
#pragma unroll
            for (int ai = 0; ai < 2; ++ai)
#pragma unroll
                for (int mp = 0; mp < 2; ++mp)
#pragma unroll
                    for (int bj = 0; bj < 2; ++bj) { u32x2 w[2];
#pragma unroll
                        for (int q = 0; q < 2; ++q) { const f32x4 a = acc[ai][bj][2 * mp + q][0] * s16, b = acc[ai][bj][2 * mp + q][1] * s16; w[q].x = pk_fp8x4(a[0], a[1], a[2], a[3]); w[q].y = pk_fp8x4(b[0], b[1], b[2], b[3]); }
                        ST4U(base + ((unsigned)(ai * HALF + mp * 32) * DM + bj * HALF)) = widen8(w[0], w[1]); }
        } else { gbf_t base = YP + (unsigned)(u.part * slab_rows + row0 - main_rows) * DM;
#pragma unroll
            for (int ai = 0; ai < 2; ++ai)
#pragma unroll
                for (int m = 0; m < 4; ++m) { gbf_t rp = base + ((unsigned)(ai * HALF + m * 16) * DM + col0);
#pragma unroll
                    for (int bj = 0; bj < 2; ++bj) ST4U(rp + bj * HALF) = pack8(acc[ai][bj][m][0] * scale, acc[ai][bj][m][1] * scale); } }
    }
};

typedef int i32x4 __attribute__((ext_vector_type(4)));
typedef int i32x8 __attribute__((ext_vector_type(8)));
#ifndef SG_OUT
#define SG_MG 0
#define SG_OUT 0
#define SG_F2 0
#endif
#ifndef STAG_STEP
#define STAG_STEP 0
#endif
template <class Epi, class Sched, class KA, bool FP8 = false, bool VARK = false>
__device__ __forceinline__ void gemm_phase(LAS unsigned char* lds, const Gemm g, const Sched& S, const Epi& E, int wave_) {
    { const int grp = (S.c >> 3) % g.sg_n;
      if (g.sg_k > 0) { for (int q = 0; q < grp * g.sg_k; ++q) __builtin_amdgcn_s_sleep(100); } else if (STAG_STEP > 0) { for (int q = 0; q < grp; ++q) __builtin_amdgcn_s_sleep(STAG_STEP); } }
    int tid_ = hw_tid(wave_); asm volatile("" : "+v"(tid_));
    const int tid = tid_, wid = __builtin_amdgcn_readfirstlane(tid >> 6), lane = tid & 63, wr = wid >> 2, wc = wid & 3, fr = lane & 15, fq = lane >> 4;
    const int K = g.K, nt = K / BK;
    unsigned voffA[2], voffB[2];
#pragma unroll
    for (int i = 0; i < 2; ++i) { int R, C; stage_rc(tid * 16 + i * 8192, R, C); const int Rb = (R & ~31) + perm32(R & 31);
        voffA[i] = (unsigned)(R * g.lda + C) * 2u; voffB[i] = (unsigned)(Rb * g.ldb + C) * 2u; }
    const size_t kstep = (size_t)(BK * 2);
    const size_t hstepA = (size_t)HALF * g.lda * 2, hstepB = (size_t)HALF * g.ldb * 2;
    const size_t tstepA = 2 * hstepA, tstepB = 2 * hstepB;
    const unsigned ldsw = (unsigned)wid * 1024u, lds0 = (unsigned)(size_t)lds;
    const int aoff = lds_byte(wr * 64 + fr, fq * 8), boff = lds_byte(wc * 32 + fr, fq * 8);
#define PG8_SA(b, h) (((b) * 2 + (h)) * HTB)
#define PG8_SB(b, h) ((4 + (b) * 2 + (h)) * HTB)
#define PG8_STAGE(bufoff, gbase, voff) do { _Pragma("unroll") for (int _i = 0; _i < 2; ++_i) { unsigned _keep; \
        asm volatile("s_mov_b32 %0, m0\n\ts_mov_b32 m0, %3\n\ts_nop 0\n\tglobal_load_lds_dwordx4 %1, %2\n\ts_mov_b32 m0, %0" : "=&s"(_keep) : "v"((voff)[_i]), "s"(uni64(gbase)), "s"(lds0 + (unsigned)(bufoff) + ldsw + (unsigned)(_i * 8192)) : "memory"); } } while (0)
#define PG8_LDA(dst, b, h) do { _Pragma("unroll") for (int m = 0; m < 4; ++m) { if constexpr (FP8) dst##8[m] = __builtin_shufflevector(*(const LAS i32x4*)(lds + PG8_SA(b, h) + aoff + m * 2048), *(const LAS i32x4*)(lds + PG8_SA(b, h) + aoff + m * 2048 + 1024), 0, 1, 2, 3, 4, 5, 6, 7); \
        else { _Pragma("unroll") for (int k = 0; k < 2; ++k) dst[m][k] = *(const LAS bf16x8*)(lds + PG8_SA(b, h) + aoff + m * 2048 + k * 1024); } } } while (0)
#define PG8_LDB(dst, b, h) do { _Pragma("unroll") for (int n = 0; n < 2; ++n) { if constexpr (FP8) dst##8[n] = __builtin_shufflevector(*(const LAS i32x4*)(lds + PG8_SB(b, h) + boff + n * 2048), *(const LAS i32x4*)(lds + PG8_SB(b, h) + boff + n * 2048 + 1024), 0, 1, 2, 3, 4, 5, 6, 7); \
        else { _Pragma("unroll") for (int k = 0; k < 2; ++k) dst[n][k] = *(const LAS bf16x8*)(lds + PG8_SB(b, h) + boff + n * 2048 + k * 1024); } } } while (0)
#define PG8_MMA(ai, bj, At, Bt) do { __builtin_amdgcn_s_setprio(1); _Pragma("unroll") for (int m = 0; m < 4; ++m) _Pragma("unroll") for (int n = 0; n < 2; ++n) { \
        if constexpr (FP8) { acc[ai][bj][m][n] = __builtin_amdgcn_mfma_scale_f32_16x16x128_f8f6f4(Bt##8[n], At##8[m], acc[ai][bj][m][n], 0, 0, 0, 0, 0, 0); } \
        else { _Pragma("unroll") for (int k = 0; k < 2; ++k) acc[ai][bj][m][n] = __builtin_amdgcn_mfma_f32_16x16x32_bf16(Bt[n][k], At[m][k], acc[ai][bj][m][n], 0, 0, 0); } } \
        __builtin_amdgcn_s_setprio(0); } while (0)
#define PG8_WAIT_V(n) asm volatile("s_waitcnt vmcnt(" #n ")" ::: "memory")
#define PG8_WAIT_L(n) asm volatile("s_waitcnt lgkmcnt(" #n ")" ::: "memory")
#define PG8_BAR __builtin_amdgcn_s_barrier()
#define PG8_SCHED __builtin_amdgcn_sched_barrier(0)
    Unit cur, nxt; int ui = 0;
    if (!S.next(0, cur)) return;
    Acc acc;
    {
#pragma unroll
    for (int a = 0; a < 2; ++a)
#pragma unroll
        for (int b = 0; b < 2; ++b)
#pragma unroll
            for (int m = 0; m < 4; ++m)
#pragma unroll
                for (int n = 0; n < 2; ++n) acc[a][b][m][n] = (f32x4){0.f, 0.f, 0.f, 0.f}; }
    bf16x8 At[4][2], B0[2][2], B1[2][2];
    i32x8 At8[4], B08[2], B18[2];
    typedef const GAS char* gcc_t;
    gcc_t cA = (gcc_t)g.A + (size_t)cur.pm * tstepA; gcc_t cB = (gcc_t)g.Bt + (size_t)cur.pb * tstepB + (VARK ? (size_t)cur.kt0 * kstep : 0);
    {
        gcc_t a0 = cA + (size_t)KA::koff(cur, 0) * 2; gcc_t a1 = cA + (size_t)KA::koff(cur, 1) * 2;
        PG8_STAGE(PG8_SB(0, 0), cB, voffB); PG8_STAGE(PG8_SB(0, 1), cB + hstepB, voffB); PG8_STAGE(PG8_SA(0, 0), a0, voffA); PG8_STAGE(PG8_SA(0, 1), a0 + hstepA, voffA);
        if (wr == 1) PG8_BAR;
        PG8_WAIT_V(2); PG8_BAR;
        PG8_STAGE(PG8_SB(1, 0), cB + kstep, voffB); PG8_STAGE(PG8_SA(1, 0), a1, voffA); PG8_STAGE(PG8_SB(1, 1), cB + hstepB + kstep, voffB);
        PG8_WAIT_V(6); PG8_BAR;
    }
    for (;;) {
        const bool has_next = S.next(ui + 1, nxt);
        if (!has_next) nxt = cur;
        gcc_t nA = has_next ? (gcc_t)g.A + (size_t)nxt.pm * tstepA : cA; gcc_t nB = has_next ? (gcc_t)g.Bt + (size_t)nxt.pb * tstepB + (VARK ? (size_t)nxt.kt0 * kstep : 0) : cB;
        const int ntc = VARK ? cur.ntu : nt;
#pragma unroll 1
        for (int t = 0; t < ntc; t += 2) {
            const bool last = (t == ntc - 2);
            gcc_t a1 = cA + (size_t)KA::koff(cur, t + 1) * 2;
            gcc_t a2 = last ? nA + (size_t)KA::koff(nxt, 0) * 2 : cA + (size_t)KA::koff(cur, t + 2) * 2;
            gcc_t a3 = last ? nA + (size_t)KA::koff(nxt, 1) * 2 : cA + (size_t)KA::koff(cur, t + 3) * 2;
            gcc_t b2 = last ? nB : cB + (size_t)(t + 2) * kstep; gcc_t b3 = b2 + kstep;
            if constexpr (Epi::HAS_MID) { if (t == Epi::MID_T) { const int te = hw_tid(wave_); E.mid(acc, cur, wr, wc, te & 15, (te >> 4) & 3); } }
            if constexpr (Epi::Pre::HAS_PRE) { if (t == 0) E.pre.issue(cur, hw_tid(wave_), wid); if (t == 2) E.pre.finish(hw_tid(wave_)); }
            PG8_LDB(B0, 0, 0); PG8_LDB(B1, 0, 1); PG8_SCHED; PG8_LDA(At, 0, 0); PG8_STAGE(PG8_SA(1, 1), a1 + hstepA, voffA);
            PG8_WAIT_V(8); PG8_WAIT_L(0); PG8_BAR; PG8_MMA(0, 0, At, B0); PG8_MMA(0, 1, At, B1); PG8_BAR; PG8_SCHED;
            PG8_LDA(At, 0, 1); PG8_STAGE(PG8_SB(0, 0), b2, voffB); PG8_STAGE(PG8_SB(0, 1), b2 + hstepB, voffB); PG8_STAGE(PG8_SA(0, 0), a2, voffA);
            PG8_WAIT_V(8); PG8_WAIT_L(0); PG8_BAR; PG8_MMA(1, 0, At, B0); PG8_MMA(1, 1, At, B1); PG8_BAR; PG8_SCHED;
            PG8_LDB(B0, 1, 0); PG8_LDB(B1, 1, 1); PG8_SCHED; PG8_LDA(At, 1, 0); PG8_STAGE(PG8_SA(0, 1), a2 + hstepA, voffA);
            PG8_WAIT_V(8); PG8_WAIT_L(0); PG8_BAR; PG8_MMA(0, 0, At, B0); PG8_MMA(0, 1, At, B1); PG8_BAR; PG8_SCHED;
            PG8_LDA(At, 1, 1); PG8_STAGE(PG8_SB(1, 0), b3, voffB); PG8_STAGE(PG8_SB(1, 1), b3 + hstepB, voffB); PG8_STAGE(PG8_SA(1, 0), a3, voffA);
            PG8_WAIT_V(8); PG8_WAIT_L(0); PG8_BAR; PG8_MMA(1, 0, At, B0); PG8_MMA(1, 1, At, B1); PG8_BAR; PG8_SCHED;
        }
        if (wr == 0) PG8_BAR;
        { const int te = hw_tid(wave_); E(acc, cur, wr, wc, te & 15, (te >> 4) & 3); }
        if (!has_next) break;
        const LAS char* zp = (const LAS char*)(lds + RING_BYTES + 12288) + (hw_tid(wave_) & 63) * 16;
#pragma unroll
        for (int a = 0; a < 2; ++a)
#pragma unroll
            for (int b = 0; b < 2; ++b)
#pragma unroll
                for (int m = 0; m < 4; ++m)
#pragma unroll
                    for (int n = 0; n < 2; ++n) acc[a][b][m][n] = *(const LAS f32x4*)(zp + (((a * 2 + b) * 4 + m) * 2 + n) * 16);
        cur = nxt; cA = nA; cB = nB; ++ui;
        if (wr == 1) PG8_BAR;
    }
    PG8_WAIT_V(0);
    PG8_BAR;
#undef PG8_SA
#undef PG8_SB
#undef PG8_STAGE
#undef PG8_LDA
#undef PG8_LDB
#undef PG8_MMA
#undef PG8_WAIT_V
#undef PG8_WAIT_L
#undef PG8_BAR
#undef PG8_SCHED
}
}

#define XB_TMO      128
#define XB_XCNT(j)  (256  + 64 * (j))
#define XB_XSUB(j)  (1280 + 64 * (j))
#define XB_XGEN(j)  (2304 + 64 * (j))
#define XB_TOP      3328
#define XB_TOPGEN   3392
#define XCD_BAR_WORDS 3456
#define XB_SPIN_CAP (1u << 18)
__device__ __forceinline__ unsigned xb_ld(gu32* p)              { return __hip_atomic_load(p, __ATOMIC_RELAXED, __HIP_MEMORY_SCOPE_AGENT); }
__device__ __forceinline__ unsigned xb_add(gu32* p, unsigned v) { return __hip_atomic_fetch_add(p, v, __ATOMIC_RELAXED, __HIP_MEMORY_SCOPE_AGENT); }
__device__ __forceinline__ unsigned xb_xcc_id() { return (unsigned)__builtin_amdgcn_s_getreg((3 << 11) | 20) & 0xFu; }
#define XB_SPIN(cond, bar) do { unsigned _sp = 0; while (cond) { __builtin_amdgcn_s_sleep(1); \
    if ((++_sp & 255u) == 0u) { if (xb_ld(&(bar)[XB_TMO])) break; if (_sp > XB_SPIN_CAP) { (void)xb_add(&(bar)[XB_TMO], 1u); break; } } } } while (0)
struct XcdBarrier { gu32* bar; unsigned x; volatile LAS unsigned* st; };
__device__ __forceinline__ XcdBarrier xcd_barrier_post(gu32* bar, volatile LAS unsigned* st, int tid) {
    XcdBarrier b; b.bar = bar; b.x = xb_xcc_id(); b.st = st;
    if (tid == 0) (void)xb_add(&bar[XB_XCNT(b.x)], 1u);
    return b;
}
__device__ __forceinline__ void xcd_barrier_complete(gu32* bar, unsigned x, unsigned& nloc, unsigned& nx) {
    const unsigned G = gridDim.x * gridDim.y * gridDim.z;
    unsigned sum, cnt, mine, sp = 0u;
    for (;;) {
        sum = 0u; cnt = 0u; mine = 0u;
#pragma unroll
        for (unsigned j = 0; j < 16; ++j) { const unsigned c = xb_ld(&bar[XB_XCNT(j)]); sum += c; cnt += (c > 0u) ? 1u : 0u; mine = (j == x) ? c : mine; }
        if (sum == G) break;
        __builtin_amdgcn_s_sleep(1);
        if ((++sp & 255u) == 0u) { if (xb_ld(&bar[XB_TMO])) break; if (sp > XB_SPIN_CAP) { (void)xb_add(&bar[XB_TMO], 1u); break; } }
    }
    nloc = mine > 0u ? mine : 1u; nx = cnt > 0u ? cnt : 1u;
}
__device__ __forceinline__ void xcd_barrier(const XcdBarrier& b, int tid) {
    asm volatile("s_waitcnt vmcnt(0)" ::: "memory");
    __syncthreads();
    if (tid == 0) {
        gu32* bar = b.bar;
        __builtin_amdgcn_s_waitcnt(0);
        unsigned nloc = b.st[0], nx = b.st[1];
        if (nloc == 0u) { xcd_barrier_complete(bar, b.x, nloc, nx); b.st[0] = nloc; b.st[1] = nx; }
        const unsigned old = xb_add(&bar[XB_XSUB(b.x)], 1u);
        const unsigned gen = old / nloc;
        if (old + 1u == (gen + 1u) * nloc) {
            __builtin_amdgcn_fence(__ATOMIC_RELEASE, "agent");
            asm volatile("s_waitcnt vmcnt(0)" ::: "memory");
            const unsigned og = xb_add(&bar[XB_TOP], 1u);
            const unsigned tg = og / nx;
            if (og + 1u == (tg + 1u) * nx) xb_add(&bar[XB_TOPGEN], 1u);
            else XB_SPIN(xb_ld(&bar[XB_TOPGEN]) == tg, bar);
            __builtin_amdgcn_fence(__ATOMIC_ACQUIRE, "agent");
            asm volatile("s_waitcnt vmcnt(0)" ::: "memory");
        } else {
            XB_SPIN(xb_ld(&bar[XB_TOPGEN]) == gen, bar);
            __builtin_amdgcn_fence(__ATOMIC_ACQUIRE, "agent");
            asm volatile("s_waitcnt vmcnt(0)" ::: "memory");
        }
    }
    __syncthreads();
}

struct Args { const float* in[20]; float* out; unsigned char* ws; int ph_lo, ph_hi; };
enum { I_X = 0, I_MIXN, I_WIN, I_CDW, I_CDWB, I_CLNG, I_CLNB, I_WCO, I_WPOOL, I_PSC, I_WOUT, I_FFNN, I_DG, I_DU, I_DD, I_RW, I_MG, I_MU, I_MD, I_FIN };

typedef const float* cfp_t;
typedef __attribute__((address_space(4))) const char* kptr_t;
struct Frame {
    LAS unsigned char* lds;
    kptr_t kp; gf_t out; GAS unsigned char* ws;
    int tid, lane, wave, G, bid;
};
struct InPtrs { kptr_t kp;
    __device__ __forceinline__ explicit InPtrs(const Frame& F) : kp(F.kp) { asm volatile("" : "+s"(kp)); }
    __device__ __forceinline__ gcf_t operator[](int k) const { return (gcf_t)((__attribute__((address_space(4))) const cfp_t*)kp)[k]; } };
__device__ __forceinline__ gbf_t wsb(const Frame& F, size_t off) { return (gbf_t)(F.ws + off); }
__device__ __forceinline__ gf_t wsf(const Frame& F, size_t off) { return (gf_t)(F.ws + off); }
__device__ __forceinline__ gu_t wsu(const Frame& F, size_t off) { return (gu_t)(F.ws + off); }


__device__ __forceinline__ float rdl(float v, int l) { return __int_as_float(__builtin_amdgcn_readlane(__float_as_int(v), l)); }
template <bool FP8>
__device__ __forceinline__ void cvt_item(gcf_t W, int N, int k0, int n0, GAS void* dstv, int ldd, int drow0, int dcol0, gcf_t sk, gcf_t sn, float mul, LAS unsigned* scr, int lane) {
    const float sN = (sn ? sn[n0 + lane] : 1.0f) * mul;
    gcf_t src = W + (size_t)k0 * N + n0 + lane;
    gcf_t skp = sk ? sk + k0 : src; const float g0 = skp[lane], g1 = FP8 ? skp[64 + lane] : 0.f; (void)g1;
    if constexpr (!FP8) {
        gbf_t dst = (gbf_t)dstv;
#pragma unroll
        for (int h = 0; h < 2; ++h) { float v[32];
#pragma unroll
            for (int i = 0; i < 32; ++i) v[i] = src[(size_t)(32 * h + i) * N];
#pragma unroll
            for (int i = 0; i < 16; ++i) { float a = v[2 * i], b = v[2 * i + 1]; if (sk) { a *= rdl(g0, 32 * h + 2 * i); b *= rdl(g0, 32 * h + 2 * i + 1); }
                scr[lane * 33 + 16 * h + i] = cvt_pk_bf16(a * sN, b * sN); } }
    } else {
#pragma unroll
        for (int h = 0; h < 4; ++h) { float v[32]; const float gh = h < 2 ? g0 : g1; const int gb = 32 * (h & 1);
#pragma unroll
            for (int i = 0; i < 32; ++i) v[i] = src[(size_t)(32 * h + i) * N];
#pragma unroll
            for (int i = 0; i < 8; ++i) { float a = v[4 * i], b = v[4 * i + 1], c = v[4 * i + 2], d = v[4 * i + 3];
                if (sk) { a *= rdl(gh, gb + 4 * i); b *= rdl(gh, gb + 4 * i + 1); c *= rdl(gh, gb + 4 * i + 2); d *= rdl(gh, gb + 4 * i + 3); }
                int w = __builtin_amdgcn_cvt_pk_fp8_f32(a * sN, b * sN, 0, false); w = __builtin_amdgcn_cvt_pk_fp8_f32(c * sN, d * sN, w, true);
                scr[lane * 33 + 8 * h + i] = (unsigned)w; } }
    }
    LDS_WAIT(); asm volatile("" ::: "memory");
    {
        GAS unsigned char* dst = (GAS unsigned char*)dstv; const int c = lane & 7; const int esz = FP8 ? 1 : 2;
#pragma unroll
        for (int q = 0; q < 8; ++q) { const int j = (lane >> 3) + 8 * q; const LAS unsigned* s = scr + j * 33 + 4 * c;
            u32x4 o; o.x = s[0]; o.y = s[1]; o.z = s[2]; o.w = s[3];
            ST4U(dst + ((size_t)(drow0 + j) * ldd + dcol0 + k0) * esz + 16 * c) = o; }
    }
    LDS_WAIT(); asm volatile("" ::: "memory");
}
__device__ __forceinline__ int gu_row(int n0, int up) { return 256 * (n0 >> 7) + (n0 & 127) + 128 * up; }
__device__ __forceinline__ int win_row(int n0) {
    if (n0 < 512) return gu_row(n0, 0);
    if (n0 < 1024) return gu_row(n0 - 512, 1);
    if (n0 < 1536) return n0;
    if (n0 < 2560) return 1536 + gu_row(n0 - 1536, 0);
    return 1536 + gu_row(n0 - 2560, 1);
}
constexpr int IT_WIN = 16 * 56, IT_WCO = 8 * 16, IT_WPOOL = 2 * 4, IT_WOUT = 16 * 16, IT_DGU = 16 * 44, IT_DD = 44 * 16;
constexpr int NIT_A = DEPTH * IT_WIN, NIT_B = DEPTH * IT_WCO, NIT_C = DEPTH * 4 * IT_WPOOL, NIT_D = DEPTH * IT_WOUT, NIT_E = 2 * IT_DGU, NIT_E3 = 2 * IT_DD;
constexpr int NIT_PRO = (2 * IT_WIN + IT_WIN) + NIT_B + NIT_C + (2 * IT_WOUT + IT_WOUT) + (IT_DGU + IT_DD) + (IT_DGU + IT_DD / 2);
constexpr int IT_MGU = 8 * 56, IT_MD = 28 * 16, NIT_MOE = NEXP * (2 * IT_MGU + IT_MD);
__device__ __forceinline__ void cvt_pro_item(const Frame& F, const InPtrs& IN, int r, LAS unsigned* scr) {
    if (r < 2 * IT_WIN) { const int L = r / IT_WIN, q = r % IT_WIN, kb = q / 56, nb = q % 56;
        cvt_item<false>(IN[I_WIN] + (size_t)L * DM * IN_COLS, IN_COLS, kb * 64, nb * 64, wsb(F, WS_WIN) + (size_t)L * IN_COLS * DM, DM, win_row(nb * 64), 0, IN[I_MIXN] + L * DM, nullptr, 1.0f, scr, F.lane); return; } r -= 2 * IT_WIN;
    if (r < IT_WIN) { const int L = 2 + r / (IT_WIN / 2), q = r % (IT_WIN / 2), kb = q / 56, nb = q % 56;
        cvt_item<true>(IN[I_WIN] + (size_t)L * DM * IN_COLS, IN_COLS, kb * 128, nb * 64, F.ws + WS_WIN8 + (size_t)(L - 2) * IN_COLS * DM, DM, win_row(nb * 64), 0, IN[I_MIXN] + L * DM, nullptr, 32.0f, scr, F.lane); return; } r -= IT_WIN;
    if (r < NIT_B) { const int L = r / IT_WCO, q = r % IT_WCO, kb = q / 16, nb = q % 16;
        cvt_item<false>(IN[I_WCO] + (size_t)L * CONV_DIM * DM, DM, kb * 64, nb * 64, wsb(F, WS_WM) + (size_t)L * DM * 640, 640, nb * 64, 0, nullptr, nullptr, 1.0f, scr, F.lane); return; } r -= NIT_B;
    if (r < NIT_C) { const int Lg = r / IT_WPOOL, q = r % IT_WPOOL, kb = q / 4, nb = q % 4, L = Lg >> 2, g = Lg & 3;
        cvt_item<false>(IN[I_WPOOL] + (size_t)Lg * 128 * 256, 256, kb * 64, nb * 64, wsb(F, WS_WM) + (size_t)L * DM * 640, 640, 256 * g + nb * 64, 512, nullptr, IN[I_PSC] + L * DM + 256 * g, 1.0f, scr, F.lane); return; } r -= NIT_C;
    if (r < 2 * IT_WOUT) { const int L = r / IT_WOUT, q = r % IT_WOUT, kb = q / 16, nb = q % 16;
        cvt_item<false>(IN[I_WOUT] + (size_t)L * DM * DM, DM, kb * 64, nb * 64, wsb(F, WS_WOUT) + (size_t)L * DM * DM, DM, nb * 64, 0, nullptr, nullptr, 1.0f, scr, F.lane); return; } r -= 2 * IT_WOUT;
    if (r < IT_WOUT) { const int L = 2 + r / (IT_WOUT / 2), q = r % (IT_WOUT / 2), kb = q / 16, nb = q % 16;
        cvt_item<true>(IN[I_WOUT] + (size_t)L * DM * DM, DM, kb * 128, nb * 64, F.ws + WS_WOUT + (size_t)L * DM * DM * 2, DM, nb * 64, 0, nullptr, nullptr, 32.0f, scr, F.lane); return; } r -= IT_WOUT;
    if (r < IT_DGU) { const int up = r / (IT_DGU / 2), q = r % (IT_DGU / 2), kb = q / 44, nb = q % 44;
        cvt_item<true>((up ? IN[I_DU] : IN[I_DG]), DFF, kb * 128, nb * 64, F.ws + WS_DGU, DM, gu_row(nb * 64, up), 0, IN[I_FFNN], nullptr, 32.0f, scr, F.lane); return; } r -= IT_DGU;
    if (r < IT_DD) { const int kb = r / 16, nb = r % 16;
        cvt_item<false>(IN[I_DD], DM, kb * 64, nb * 64, wsb(F, WS_DD), DFF, nb * 64, 0, nullptr, nullptr, 1.0f, scr, F.lane); return; } r -= IT_DD;
    if (r < IT_DGU) { const int up = r / (IT_DGU / 2), q = r % (IT_DGU / 2), kb = q / 44, nb = q % 44;
        cvt_item<true>((up ? IN[I_DU] : IN[I_DG]) + (size_t)DM * DFF, DFF, kb * 128, nb * 64, F.ws + WS_DGU8, DM, gu_row(nb * 64, up), 0, IN[I_FFNN] + 2 * DM, nullptr, 32.0f, scr, F.lane); return; } r -= IT_DGU;
    { const int kb = r / 16, nb = r % 16;
        cvt_item<true>(IN[I_DD] + (size_t)DFF * DM, DM, kb * 128, nb * 64, F.ws + WS_DD8, DFF, nb * 64, 0, nullptr, nullptr, 64.0f, scr, F.lane); }
}
__device__ __forceinline__ void cvt_moe_item(const Frame& F, const InPtrs& IN, int r, LAS unsigned* scr) {
    const int ie = r / (2 * IT_MGU + IT_MD), i = ie >> 3; int q = r % (2 * IT_MGU + IT_MD);
    if (q < 2 * IT_MGU) { const int up = q / IT_MGU; q %= IT_MGU; const int kb = q / 56, nb = q % 56;
        cvt_item<true>((up ? IN[I_MU] : IN[I_MG]) + (size_t)ie * DM * DFFE, DFFE, kb * 128, nb * 64, F.ws + WS_MGU + (size_t)ie * 2 * DFFE * DM, DM, gu_row(nb * 64, up), 0, IN[I_FFNN] + (2 * i + 1) * DM, nullptr, 32.0f, scr, F.lane); return; }
    q -= 2 * IT_MGU; { const int kb = q / 16, nb = q % 16;
        cvt_item<true>(IN[I_MD] + (size_t)ie * DFFE * DM, DM, kb * 128, nb * 64, F.ws + WS_MD + (size_t)ie * DM * DFFE, DFFE, nb * 64, 0, nullptr, nullptr, 64.0f, scr, F.lane); }
}
__device__ __forceinline__ void cvt_moe_layers(const Frame& F) {
    LAS unsigned* scr = (LAS unsigned*)(F.lds + F.wave * 8448);
    const int gw = F.bid * NWAVES + F.wave, NGW = F.G * NWAVES;
    const InPtrs IN(F);
    for (int it = gw; it < 2 * NIT_MOE; it += NGW) cvt_moe_item(F, IN, it, scr);
}

__device__ __forceinline__ void p_prologue(const Frame& F) {
    LAS unsigned* scr = (LAS unsigned*)(F.lds + F.wave * 8448);
    const int gw = F.bid * NWAVES + F.wave, NGW = F.G * NWAVES;
    const InPtrs IN(F);
    for (int it = gw; it < NIT_PRO; it += NGW) cvt_pro_item(F, IN, it, scr);
    gcf_t x = IN[I_X]; gbf_t xb = wsb(F, WS_XB); gf_t ssq4 = wsf(F, WS_SSQ4);
    for (int t0 = gw * 4; t0 < NTOK; t0 += NGW * 4) {
        f32x4 v[4][4];
#pragma unroll
        for (int q = 0; q < 4; ++q)
#pragma unroll
            for (int j = 0; j < 4; ++j) v[q][j] = *((const GAS f32x4*)(x + (size_t)(t0 + q) * DM) + F.lane + 64 * j);
#pragma unroll
        for (int q = 0; q < 4; ++q) { GAS u32x2* o = (GAS u32x2*)(xb + (size_t)(t0 + q) * DM) + F.lane; float ss = 0.f;
#pragma unroll
            for (int j = 0; j < 4; ++j) { const f32x4 w4 = v[q][j]; ss += (w4[0] * w4[0] + w4[1] * w4[1]) + (w4[2] * w4[2] + w4[3] * w4[3]); u32x2 w; w.x = cvt_pk_bf16(w4[0], w4[1]); w.y = cvt_pk_bf16(w4[2], w4[3]); o[64 * j] = w; }
            ss = wave_sum_l(ss, F.lane);
            if (F.lane < 4) ssq4[(size_t)F.lane * NTOK + t0 + q] = F.lane == 0 ? ss : 0.f; }
    }
    cvt_moe_layers(F);
}

__device__ __forceinline__ float bf1(bf16_t v) { return __uint_as_float((unsigned)v << 16); }
__device__ __forceinline__ bf16_t f2bf(float f) { return (bf16_t)(cvt_pk_bf16(f, 0.f) & 0xffffu); }
template <int CTRL> __device__ __forceinline__ float dppx(float v) { return __int_as_float(__builtin_amdgcn_update_dpp(0, __float_as_int(v), CTRL, 0xf, 0xf, true)); }
__device__ __forceinline__ void p_cp(const Frame& F, int L) {
    const int ch = F.tid, lane = F.lane, wv = F.wave;
    const GAS char* Ub = (const GAS char*)(F.ws + WS_U); const GAS char* Pb = (const GAS char*)(F.ws + WS_P); GAS char* Sb = (GAS char*)(F.ws + WS_SD);
    const unsigned ch2 = (unsigned)ch * 2u, lane16 = (unsigned)lane * 16u, lds0 = (unsigned)(size_t)F.lds;
    constexpr unsigned CP_IN = 0u, CP_OUT = 65536u, CP_HIST = 65536u;
#define CP_DMA(gptr, ldsoff) do { unsigned keep_; asm volatile("s_mov_b32 %0, m0\n\ts_mov_b32 m0, %3\n\ts_nop 0\n\tglobal_load_lds_dwordx4 %1, %2\n\ts_mov_b32 m0, %0" : "=&s"(keep_) : "v"(lane16), "s"(pg8::uni64((const GAS char*)(gptr))), "s"(lds0 + (unsigned)(ldsoff)) : "memory"); } while (0)
#define CP_ST16(gptr, voff, val) (*(GAS u32x4*)((GAS char*)(gptr) + (voff)) = (val))
#define LDSU16(off) ((unsigned)*(const LAS unsigned short*)(F.lds + (off)))
#define LDW(ptr, row) (*(const GAS float*)((const GAS char*)(ptr) + ((unsigned)(row) * (CONV_DIM * 4u) + ch2 * 2u)))
    const InPtrs IN(F);
    LAS float* red = (LAS float*)(F.lds + STAB_OFF);
    const int idx = ((lane >> 3) & 1) + 2 * ((lane >> 2) & 1) + 4 * ((lane >> 1) & 1) + 8 * (lane & 1);
    const bool b0 = lane & 1, b1 = lane & 2, b2 = lane & 4, b3 = lane & 8;
    const int g = F.wave >> 1, win = 2 << g;
    for (int chunk = F.bid; chunk < NTOK / 128; chunk += F.G) {
        const int r0 = chunk * 128, ts0 = r0 & (SEQ - 1);
        const unsigned hmask = ts0 != 0 ? 0xffffffffu : 0u; const int rh = ts0 != 0 ? r0 : r0 + 32;
#pragma unroll
        for (int k = 0; k < 6; ++k) { const int sidx = wv + 8 * k; const int pr = sidx - 30 < 14 ? sidx - 30 : 14;
            const GAS char* src = sidx < 30 ? Ub + (unsigned)(rh - 30 + sidx) * 1024u : Pb + (unsigned)(rh - 15 + pr) * 1024u;
            CP_DMA(src, CP_HIST + (unsigned)sidx * 1024u); }
#pragma unroll
        for (int q = 0; q < 2; ++q) { CP_DMA(Ub + (unsigned)(r0 + 8 * q + wv) * 1024u, CP_IN + (unsigned)q * 16384u + (unsigned)wv * 1024u); CP_DMA(Pb + (unsigned)(r0 + 8 * q + wv) * 1024u, CP_IN + (unsigned)q * 16384u + (unsigned)(8 + wv) * 1024u); }
        float w[CONV_W];
#pragma unroll
        for (int j = 0; j < CONV_W; ++j) w[j] = LDW(IN[I_CDW], L * CONV_W + j);
        const float cb = LDW(IN[I_CDWB], L), lg = LDW(IN[I_CLNG], L), lb = LDW(IN[I_CLNB], L);
        asm volatile("s_waitcnt vmcnt(0)" ::: "memory"); __syncthreads();
        {
            float cb_ = cb, lg_ = lg, lb_ = lb;
#pragma unroll
            for (int j = 0; j < CONV_W; ++j) asm volatile("" : "+v"(w[j]));
            asm volatile("" : "+v"(cb_), "+v"(lg_), "+v"(lb_)); (void)cb_; (void)lg_; (void)lb_; }
        float u[38];
#pragma unroll
        for (int i = 0; i < 30; ++i) u[i] = __uint_as_float((LDSU16(CP_HIST + (unsigned)i * 1024u + ch2) << 16) & hmask);
        float plast, h2[2], h4[4], h8[8];
        { float ph[15], T2[15], T4[13];
#pragma unroll
          for (int i = 0; i < 15; ++i) ph[i] = __uint_as_float((LDSU16(CP_HIST + (unsigned)(30 + i) * 1024u + ch2) << 16) & hmask);
#pragma unroll
          for (int k = 1; k <= 14; ++k) T2[k] = ph[15 - k] + ph[14 - k];
#pragma unroll
          for (int k = 1; k <= 12; ++k) T4[k] = T2[k] + T2[k + 2];
          h2[0] = T2[2]; h2[1] = T2[1];
#pragma unroll
          for (int o = 0; o < 4; ++o) h4[o] = T4[4 - o];
#pragma unroll
          for (int o = 0; o < 8; ++o) h8[o] = T4[8 - o] + T4[12 - o];
          plast = ph[14]; }
#define CP_SUBBLOCK(sb, BUF) do { \
            const int rb = r0 + 8 * (sb), sn = (sb) + 2 < 16 ? (sb) + 2 : 15; \
            const unsigned stg = CP_IN + (unsigned)((sb) & 3) * 16384u, stn = CP_IN + (unsigned)(((sb) + 2) & 3) * 16384u, outw = CP_OUT + (unsigned)((sb) & 1) * 16384u, outr = CP_OUT + (unsigned)(((sb) + 1) & 1) * 16384u; \
            asm volatile("s_waitcnt vmcnt(4) lgkmcnt(0)" ::: "memory"); \
            __builtin_amdgcn_s_barrier(); asm volatile("" ::: "memory");     \
            if ((sb) > 0) { const LAS char* orow = (const LAS char*)(F.lds + outr + (unsigned)wv * 2048u + lane16); const u32x4 o0 = *(const LAS u32x4*)orow, o1 = *(const LAS u32x4*)(orow + 1024); \
                GAS char* drow = Sb + (unsigned)(rb - 8 + wv) * 2048u; CP_ST16(drow, lane16, o0); CP_ST16(drow, lane16 + 1024u, o1); } \
            CP_DMA(Ub + (unsigned)(r0 + 8 * sn + wv) * 1024u, stn + (unsigned)wv * 1024u); CP_DMA(Pb + (unsigned)(r0 + 8 * sn + wv) * 1024u, stn + (unsigned)(8 + wv) * 1024u); \
            float pc[8]; \
            _Pragma("unroll") for (int o = 0; o < 8; ++o) { u[30 + o] = __uint_as_float(LDSU16(stg + (unsigned)o * 1024u + ch2) << 16); pc[o] = __uint_as_float(LDSU16(stg + (unsigned)(8 + o) * 1024u + ch2) << 16); } \
            float v[8], a[16]; \
            _Pragma("unroll") for (int o = 0; o < 8; ++o) { float s_ = cb; \
                _Pragma("unroll") for (int j = 0; j < CONV_W; ++j) s_ += w[j] * u[o + j]; \
                v[o] = s_; a[o] = s_; a[8 + o] = s_ * s_; } \
            _Pragma("unroll") for (int i = 0; i < 8; ++i) { const float keep = b0 ? a[i + 8] : a[i], send = b0 ? a[i] : a[i + 8]; a[i] = keep + dppx<0xB1>(send); } \
            _Pragma("unroll") for (int i = 0; i < 4; ++i) { const float keep = b1 ? a[i + 4] : a[i], send = b1 ? a[i] : a[i + 4]; a[i] = keep + dppx<0x4E>(send); } \
            _Pragma("unroll") for (int i = 0; i < 2; ++i) { const float keep = b2 ? a[i + 2] : a[i], send = b2 ? a[i] : a[i + 2]; a[i] = keep + dppx<0x124>(send); } \
            { const float keep = b3 ? a[1] : a[0], send = b3 ? a[0] : a[1]; a[0] = keep + dppx<0x128>(send); } \
            a[0] += shx<16>(a[0], lane); a[0] += shx<32>(a[0], lane);       \
            LAS float* rb_ = red + (BUF) * 128; \
            if (lane < 16) rb_[idx * 8 + wv] = a[0]; \
              \
            { float sw[8]; \
              _Pragma("unroll") for (int o = 0; o < 8; ++o) sw[o] = pc[o] + (o ? pc[o > 0 ? o - 1 : 0] : plast); \
              plast = pc[7]; \
              if (g >= 1) { float t4[8]; \
                  _Pragma("unroll") for (int o = 0; o < 8; ++o) t4[o] = sw[o] + (o >= 2 ? sw[o >= 2 ? o - 2 : 0] : h2[o & 1]); \
                  h2[0] = sw[6]; h2[1] = sw[7]; \
                  _Pragma("unroll") for (int o = 0; o < 8; ++o) sw[o] = t4[o]; \
                  if (g >= 2) { float t8[8]; \
                      _Pragma("unroll") for (int o = 0; o < 8; ++o) t8[o] = t4[o] + (o >= 4 ? t4[o >= 4 ? o - 4 : 0] : h4[o & 3]); \
                      _Pragma("unroll") for (int o = 0; o < 4; ++o) h4[o] = t4[4 + o]; \
                      _Pragma("unroll") for (int o = 0; o < 8; ++o) sw[o] = t8[o]; \
                      if (g >= 3) { _Pragma("unroll") for (int o = 0; o < 8; ++o) { sw[o] = t8[o] + h8[o]; h8[o] = t8[o]; } } } } \
              _Pragma("unroll") for (int o = 0; o < 8; ++o) { const int ts = ts0 + 8 * (sb) + o; const float inv = __builtin_amdgcn_rcpf((float)((ts + 1) < win ? (ts + 1) : win)); \
                  *(LAS bf16_t*)(F.lds + outw + (unsigned)o * 2048u + ch2) = f2bf(sw[o] * inv - pc[o]); } } \
            LDS_WAIT(); __builtin_amdgcn_s_barrier(); asm volatile("" ::: "memory");     \
              \
            float mean_l, rstd_l; \
            { const LAS float* rp = rb_ + (lane & 7) * 8; const f32x4 s0 = *(const LAS f32x4*)(rp), s1 = *(const LAS f32x4*)(rp + 4), q0 = *(const LAS f32x4*)(rp + 64), q1 = *(const LAS f32x4*)(rp + 68); \
              mean_l = (((s0[0] + s0[1]) + (s0[2] + s0[3])) + ((s1[0] + s1[1]) + (s1[2] + s1[3]))) * (1.0f / CONV_DIM); \
              const float ex2 = (((q0[0] + q0[1]) + (q0[2] + q0[3])) + ((q1[0] + q1[1]) + (q1[2] + q1[3]))) * (1.0f / CONV_DIM); \
              rstd_l = __builtin_amdgcn_rsqf(__builtin_fmaxf(ex2 - mean_l * mean_l, 0.f) + LN_EPS); } \
            _Pragma("unroll") for (int o = 0; o < 8; ++o) { const float mean = rdl(mean_l, o), rstd = rdl(rstd_l, o); \
                const float y = (v[o] - mean) * rstd * lg + lb; \
                *(LAS bf16_t*)(F.lds + outw + (unsigned)o * 2048u + 1024u + ch2) = f2bf(y * __builtin_amdgcn_rcpf(1.0f + __builtin_amdgcn_exp2f(y * -1.4426950408889634f))); } \
            _Pragma("unroll") for (int i = 0; i < 30; ++i) u[i] = u[i + 8]; } while (0)
#pragma unroll 1
        for (int sb = 0; sb < 16; sb += 2) { CP_SUBBLOCK(sb, 0); CP_SUBBLOCK(sb + 1, 1); }
#undef CP_SUBBLOCK
        LDS_WAIT(); __builtin_amdgcn_s_barrier(); asm volatile("" ::: "memory");
        { const LAS char* orow = (const LAS char*)(F.lds + CP_OUT + 16384u + (unsigned)wv * 2048u + lane16); const u32x4 o0 = *(const LAS u32x4*)orow, o1 = *(const LAS u32x4*)(orow + 1024);
          GAS char* drow = Sb + (unsigned)(r0 + 120 + wv) * 2048u; CP_ST16(drow, lane16, o0); CP_ST16(drow, lane16 + 1024u, o1); }
        asm volatile("s_waitcnt vmcnt(0)" ::: "memory"); __syncthreads();
    }
#undef CP_DMA
#undef CP_ST16
#undef LDSU16
#undef LDW
}

__device__ __forceinline__ void p_r1(const Frame& F, int i, int L) {
    LAS u32x4* WH = (LAS u32x4*)F.lds; LAS u32x4* WL = (LAS u32x4*)(F.lds + 32768);
    LAS unsigned* cntw = (LAS unsigned*)(F.lds + 65536);
    gcbf_t x = wsb(F, WS_XB); const int lane = F.lane, w = F.wave;
    const InPtrs IN(F);
    constexpr int NCH = NTOK / 128;
    int chunk = F.bid;
    const int tl = lane & 15, q = lane >> 4;
    float rwv[4][8]; f32x4 g0[4], g1[4];
#pragma unroll
    for (int r = 0; r < 4; ++r) { const int idx = F.tid + r * (NWAVES * 64), s_ = idx >> 6, l_ = idx & 63, n7 = l_ & 7, k0 = 32 * s_ + 8 * (l_ >> 4);
        g0[r] = *(const GAS f32x4*)(IN[I_FFNN] + L * DM + k0); g1[r] = *(const GAS f32x4*)(IN[I_FFNN] + L * DM + k0 + 4);
#pragma unroll
        for (int j = 0; j < 8; ++j) rwv[r][j] = IN[I_RW][(size_t)(i * DM + k0 + j) * 8 + n7]; }
    __builtin_amdgcn_sched_barrier(0);
    u32x4 xa[32];
    {   const int c0 = chunk < NCH ? chunk : NCH - 1;
        const GAS char* xrow = (const GAS char*)(x + (size_t)(c0 * 128 + w * 16 + tl) * DM) + q * 16;
#pragma unroll
        for (int s = 0; s < 32; ++s) xa[s] = *(const GAS u32x4*)(xrow + s * 64); }
    __builtin_amdgcn_sched_barrier(0);
#pragma unroll
    for (int r = 0; r < 4; ++r) { const int idx = F.tid + r * (NWAVES * 64); const float msk = (idx & 8) ? 0.f : 1.f;
        float wv[8];
#pragma unroll
        for (int j = 0; j < 8; ++j) wv[j] = rwv[r][j] * (j < 4 ? g0[r][j & 3] : g1[r][j & 3]) * msk;
        u32x4 hi, lo;
#pragma unroll
        for (int p = 0; p < 4; ++p) { const unsigned h = cvt_pk_bf16(wv[2 * p], wv[2 * p + 1]); hi[p] = h;
            lo[p] = cvt_pk_bf16(wv[2 * p] - bf_lo(h), wv[2 * p + 1] - bf_hi(h)); }
        WH[idx] = hi; WL[idx] = lo; }
    LDS_WAIT(); __syncthreads();
    gu_t toke = wsu(F, WS_TOKE); gf_t tokp = wsf(F, WS_TOKP); gf_t tokr = wsf(F, WS_TOKR); gu_t cnt = wsu(F, WS_CNT); gcf_t ssq4 = wsf(F, WS_SSQ4);
    while (chunk < NCH) {
        const int t0 = chunk * 128 + w * 16;
        float rstd; { const unsigned tq = (unsigned)(t0 + tl); const float s01 = ssq4[tq] + ssq4[NTOK + tq], s23 = ssq4[2 * NTOK + tq] + ssq4[3 * NTOK + tq];
            rstd = __builtin_amdgcn_rsqf((s01 + s23) * (1.0f / DM) + RMS_EPS); }
        f32x4 acc = (f32x4){0.f, 0.f, 0.f, 0.f};
#pragma unroll
        for (int s = 0; s < 32; ++s) { const u32x4 wh = WH[s * 64 + lane], wl = WL[s * 64 + lane];
            acc = __builtin_amdgcn_mfma_f32_16x16x32_bf16(__builtin_bit_cast(bf16x8, wh), __builtin_bit_cast(bf16x8, xa[s]), acc, 0, 0, 0);
            acc = __builtin_amdgcn_mfma_f32_16x16x32_bf16(__builtin_bit_cast(bf16x8, wl), __builtin_bit_cast(bf16x8, xa[s]), acc, 0, 0, 0); }
        float lg[8];
#pragma unroll
        for (int r = 0; r < 4; ++r) { const float o = shx<16>(acc[r], lane); lg[r] = (q & 1) ? o : acc[r]; lg[4 + r] = (q & 1) ? acc[r] : o; }
        int e1 = 0; float l1 = lg[0];
#pragma unroll
        for (int e = 1; e < 8; ++e) if (lg[e] > l1) { l1 = lg[e]; e1 = e; }
        int e2 = -1; float l2 = 0.f;
#pragma unroll
        for (int e = 0; e < 8; ++e) if (e != e1 && (e2 < 0 || lg[e] > l2)) { l2 = lg[e]; e2 = e; }
        const float p1 = __builtin_amdgcn_rcpf(1.0f + __builtin_amdgcn_exp2f((l2 - l1) * rstd * 1.4426950408889634f));
        if (lane < 16) { const int t = t0 + lane; toke[t] = (unsigned)e1 | ((unsigned)e2 << 8); tokp[t] = p1; tokr[t] = rstd; }
        unsigned c[8];
#pragma unroll
        for (int e = 0; e < 8; ++e) c[e] = (unsigned)__popcll(__ballot(lane < 16 && e1 == e)) + (unsigned)__popcll(__ballot(lane < 16 && e2 == e));
        if (lane < 8) { unsigned v = c[0];
#pragma unroll
            for (int e = 1; e < 8; ++e) v = lane == e ? c[e] : v;
            cntw[w * 8 + lane] = v; }
        LDS_WAIT(); __syncthreads();
        if (F.tid < 8) { unsigned s = 0;
#pragma unroll
            for (int q2 = 0; q2 < 8; ++q2) s += cntw[q2 * 8 + F.tid];
            cnt[chunk * 8 + F.tid] = s; }
        __syncthreads();
        chunk += F.G;
        if (chunk < NCH) { const GAS char* xrow = (const GAS char*)(x + (size_t)(chunk * 128 + w * 16 + tl) * DM) + q * 16;
#pragma unroll
            for (int s = 0; s < 32; ++s) xa[s] = *(const GAS u32x4*)(xrow + s * 64); }
    }
}
__device__ __forceinline__ void p_r2(const Frame& F) {
    LAS unsigned* lc = (LAS unsigned*)F.lds;
    LAS unsigned* pre = lc + 2048;
    LAS unsigned* tslot = pre + 64;
    LAS unsigned* te = tslot + 256;
    gu_t cnt = wsu(F, WS_CNT); gu_t toke = wsu(F, WS_TOKE); gu_t slotof = wsu(F, WS_SLOTOF); gu_t panel = wsu(F, WS_PANEL);
    gcf_t tokr = wsf(F, WS_TOKR);
    GAS unsigned char* XG = F.ws + WS_XG; gcbf_t xs = wsb(F, WS_XB);
    constexpr int NCH = NTOK / 128;
    int chunk = F.bid;
    u32x4 v[16][2]; float r[16];
    {   const int c0 = chunk < NCH ? chunk : NCH - 1;
        unsigned cv[4];
#pragma unroll
        for (int k = 0; k < 4; ++k) cv[k] = __hip_atomic_load(cnt + F.tid + k * (NWAVES * 64), RLX_AGENT);
        const unsigned tev = __hip_atomic_load(toke + c0 * 128 + (F.tid & 127), RLX_AGENT);
#pragma unroll
        for (int q = 0; q < 16; ++q) { const int t = c0 * 128 + F.wave * 16 + q; r[q] = tokr[t];
#pragma unroll
            for (int h = 0; h < 2; ++h) v[q][h] = *((const GAS u32x4*)(xs + (size_t)t * DM) + F.lane + 64 * h); }
        __builtin_amdgcn_sched_barrier(0);
#pragma unroll
        for (int k = 0; k < 4; ++k) lc[F.tid + k * (NWAVES * 64)] = cv[k];
        if (F.tid < 128) te[F.tid] = tev; }
    LDS_WAIT(); __syncthreads();
    while (chunk < NCH) {
        {
            const int e = F.wave; unsigned tot = 0, before = 0;
#pragma unroll
            for (int q = 0; q < 4; ++q) { const int c = 4 * F.lane + q; const unsigned vv = lc[c * 8 + e]; before += c < chunk ? vv : 0u; tot += vv; }
#define R2SUM(M) before += (unsigned)shx_i<M>((int)before, F.lane); tot += (unsigned)shx_i<M>((int)tot, F.lane);
            R2SUM(1) R2SUM(2) R2SUM(4) R2SUM(8) R2SUM(16) R2SUM(32)
#undef R2SUM
            if (F.lane == 0) { pre[e] = before; pre[16 + e] = tot; } }
        LDS_WAIT(); __syncthreads();
        if (F.tid == 0) { unsigned seg = 0; for (int e = 0; e < 8; ++e) { pre[8 + e] = seg; seg += (pre[16 + e] + 255u) & ~255u; } pre[24] = seg >> 8; }
        LDS_WAIT(); __syncthreads();
        {
            const unsigned e = F.wave; unsigned slot = pre[8 + e] + pre[e];
#pragma unroll
            for (int h = 0; h < 2; ++h) { const int tt = 64 * h + F.lane; const unsigned ee = te[tt]; const bool f1 = (ee & 255u) == e, f2 = (ee >> 8) == e;
                const unsigned long long m = __ballot(f1 || f2); const unsigned pfx = __builtin_amdgcn_mbcnt_hi((unsigned)(m >> 32), __builtin_amdgcn_mbcnt_lo((unsigned)m, 0u));
                if (f1) tslot[2 * tt] = slot + pfx; else if (f2) tslot[2 * tt + 1] = slot + pfx;
                slot += (unsigned)__popcll(m); } }
        if (chunk == 0 && F.tid >= 64 && F.tid < 72) { const unsigned e = F.tid - 64; const unsigned p0 = pre[8 + e] >> 8, p1 = (pre[8 + e] + ((pre[16 + e] + 255u) & ~255u)) >> 8;
            for (unsigned p = p0; p < p1; ++p) panel[1 + p] = e;
            if (e == 0) panel[0] = pre[24]; }
        LDS_WAIT(); __syncthreads();
#pragma unroll
        for (int q = 0; q < 16; ++q) { const int tl = F.wave * 16 + q; const unsigned s0 = tslot[2 * tl], s1 = tslot[2 * tl + 1];
            GAS u32x2* d0 = (GAS u32x2*)(XG + (size_t)s0 * DM) + F.lane; GAS u32x2* d1 = (GAS u32x2*)(XG + (size_t)s1 * DM) + F.lane;
#pragma unroll
            for (int h = 0; h < 2; ++h) { f32x4 a, b; pg8::unpack8(v[q][h], a, b); u32x2 w; w.x = pg8::pk_fp8x4(a[0] * r[q], a[1] * r[q], a[2] * r[q], a[3] * r[q]); w.y = pg8::pk_fp8x4(b[0] * r[q], b[1] * r[q], b[2] * r[q], b[3] * r[q]);
                d0[64 * h] = w; d1[64 * h] = w; } }
        if (F.tid < 256) slotof[chunk * 256 + F.tid] = tslot[F.tid];
        __syncthreads();
        chunk += F.G;
        if (chunk < NCH) {
            if (F.tid < 128) te[F.tid] = __hip_atomic_load(toke + chunk * 128 + F.tid, RLX_AGENT);
#pragma unroll
            for (int q = 0; q < 16; ++q) { const int t = chunk * 128 + F.wave * 16 + q; r[q] = tokr[t];
#pragma unroll
                for (int h = 0; h < 2; ++h) v[q][h] = *((const GAS u32x4*)(xs + (size_t)t * DM) + F.lane + 64 * h); } }
    }
}
__device__ __forceinline__ void p_cb(const Frame& F, bool final_) {
    const int gw = F.bid * NWAVES + F.wave, NGW = F.G * NWAVES;
    const GAS unsigned* slotof = wsu(F, WS_SLOTOF); gcf_t tokp = wsf(F, WS_TOKP); gcbf_t Y = wsb(F, WS_Y);
    gbf_t xs = wsb(F, WS_XB); gf_t ssq4 = wsf(F, WS_SSQ4); const InPtrs IN(F); gcf_t gfin = IN[I_FIN];
    gcbf_t YP = wsb(F, WS_YP); int mainP, tailP, nsplit; pg8::MoeOrder2::split((int)__hip_atomic_load(wsu(F, WS_PANEL), RLX_AGENT), F.G, mainP, tailP, nsplit);
    mainP = __builtin_amdgcn_readfirstlane(mainP); nsplit = __builtin_amdgcn_readfirstlane(nsplit);
    const unsigned main_rows = (unsigned)mainP * 256u; const int slab_rows = nsplit == 7 ? pg8::TAIL_ROWS : pg8::TAIL_ROWS2;
    f32x4 gf[4];
#pragma unroll
    for (int j = 0; j < 4; ++j) gf[j] = final_ ? *((const GAS f32x4*)gfin + (128 * (j >> 1) + 2 * F.lane + (j & 1))) : (f32x4){0.f, 0.f, 0.f, 0.f};
    for (int t0 = gw * 4; t0 < NTOK; t0 += NGW * 4) {
        unsigned s0[4], s1[4]; float p1[4]; u32x4 xv[4][2]; u32x2 ya[4][2], yb[4][2];
#pragma unroll
        for (int q = 0; q < 4; ++q) { s0[q] = slotof[2 * (t0 + q)]; s1[q] = slotof[2 * (t0 + q) + 1]; p1[q] = tokp[t0 + q]; }
#pragma unroll
        for (int q = 0; q < 4; ++q)
#pragma unroll
            for (int h = 0; h < 2; ++h) { xv[q][h] = *((const GAS u32x4*)(xs + (size_t)(t0 + q) * DM) + F.lane + 64 * h);
                ya[q][h] = *((const GAS u32x2*)((const GAS unsigned char*)Y + (size_t)s0[q] * DM) + F.lane + 64 * h); yb[q][h] = *((const GAS u32x2*)((const GAS unsigned char*)Y + (size_t)s1[q] * DM) + F.lane + 64 * h); }
#pragma unroll
        for (int q = 0; q < 4; ++q) { const int t = t0 + q; const float pa = p1[q], pb = 1.0f - pa; f32x4 v[4]; float ss = 0.f;
#pragma unroll
            for (int h = 0; h < 2; ++h) { f32x4 x0, x1, a0, a1, b0, b1; pg8::unpack8(xv[q][h], x0, x1); pg8::unpack_fp8x8(ya[q][h], a0, a1); pg8::unpack_fp8x8(yb[q][h], b0, b1); a0 *= 0.0625f; a1 *= 0.0625f; b0 *= 0.0625f; b1 *= 0.0625f;
                if (s0[q] >= main_rows) { u32x4 cs[7];
#pragma unroll
                    for (int sp = 0; sp < 7; ++sp) cs[sp] = *((const GAS u32x4*)(YP + (size_t)((sp < nsplit ? sp : 0) * slab_rows + s0[q] - main_rows) * DM) + F.lane + 64 * h);
                    __builtin_amdgcn_sched_barrier(0);
                    a0 = (f32x4){0.f, 0.f, 0.f, 0.f}; a1 = a0;
#pragma unroll
                    for (int sp = 0; sp < 7; ++sp) { f32x4 c0, c1; pg8::unpack8(cs[sp], c0, c1); const float m = sp < nsplit ? 1.0f : 0.0f; a0 += c0 * m; a1 += c1 * m; } }
                if (s1[q] >= main_rows) { u32x4 cs[7];
#pragma unroll
                    for (int sp = 0; sp < 7; ++sp) cs[sp] = *((const GAS u32x4*)(YP + (size_t)((sp < nsplit ? sp : 0) * slab_rows + s1[q] - main_rows) * DM) + F.lane + 64 * h);
                    __builtin_amdgcn_sched_barrier(0);
                    b0 = (f32x4){0.f, 0.f, 0.f, 0.f}; b1 = b0;
#pragma unroll
                    for (int sp = 0; sp < 7; ++sp) { f32x4 c0, c1; pg8::unpack8(cs[sp], c0, c1); const float m = sp < nsplit ? 1.0f : 0.0f; b0 += c0 * m; b1 += c1 * m; } }
                v[2 * h] = x0 + pa * a0 + pb * b0; v[2 * h + 1] = x1 + pa * a1 + pb * b1; }
#pragma unroll
            for (int j = 0; j < 4; ++j) ss += (v[j][0] * v[j][0] + v[j][1] * v[j][1]) + (v[j][2] * v[j][2] + v[j][3] * v[j][3]);
            ss = wave_sum_l(ss, F.lane);
            if (final_) { const float rstd = __builtin_amdgcn_rsqf(ss * (1.0f / DM) + RMS_EPS); GAS f32x4* orow = (GAS f32x4*)(F.out + (size_t)t * DM);
#pragma unroll
                for (int j = 0; j < 4; ++j) { const int e4 = 128 * (j >> 1) + 2 * F.lane + (j & 1); orow[e4] = v[j] * rstd * gf[j]; }
            } else {
#pragma unroll
                for (int h = 0; h < 2; ++h) { *((GAS u32x4*)(xs + (size_t)t * DM) + F.lane + 64 * h) = pg8::pack8(v[2 * h], v[2 * h + 1]);
                    u32x2 w8; w8.x = pg8::pk_fp8x4(v[2 * h][0], v[2 * h][1], v[2 * h][2], v[2 * h][3]); w8.y = pg8::pk_fp8x4(v[2 * h + 1][0], v[2 * h + 1][1], v[2 * h + 1][2], v[2 * h + 1][3]);
                    *((GAS u32x2*)(F.ws + WS_XB8 + (size_t)t * DM) + F.lane + 64 * h) = w8; }
                if (F.lane < 4) ssq4[(size_t)F.lane * NTOK + t] = F.lane == 0 ? ss : 0.f;
            } }
    }
}

constexpr int N_PHASES = 1 + DEPTH * 4 + 2 * 2 + 2 * 5;
__global__ void __launch_bounds__(NWAVES * 64, 2) trunk_fwd(Args args) {
    extern __shared__ __attribute__((aligned(16))) unsigned char lds_raw[];
    Frame F;
    F.lds = (LAS unsigned char*)lds_raw;
    F.kp = (kptr_t)__builtin_amdgcn_kernarg_segment_ptr(); F.out = (gf_t)args.out; F.ws = (GAS unsigned char*)args.ws;
    F.tid = threadIdx.x; F.lane = F.tid & 63; F.wave = __builtin_amdgcn_readfirstlane(F.tid >> 6); F.G = gridDim.x; F.bid = blockIdx.x;
    volatile LAS unsigned* MISC = (volatile LAS unsigned*)(F.lds + MISC_OFF);
    for (int u = F.tid; u < (LDS_BYTES - LDSCTL_OFF) / 4; u += NWAVES * 64) ((LAS unsigned*)(F.lds + LDSCTL_OFF))[u] = 0u;
    __syncthreads();
    gu32* ctl = (gu32*)(args.ws + WS_CTL);
#if MK_PER_PHASE
    XcdBarrier bar; bar.bar = ctl + CW_BAR; bar.x = 0; bar.st = nullptr; (void)bar; (void)MISC;
#else
    XcdBarrier bar = xcd_barrier_post(ctl + CW_BAR, MISC + 8, F.tid);
#endif
#if MK_PER_PHASE
    const int lo = args.ph_lo, hi = args.ph_hi;
    int ph = 0;
#endif
#if MK_PER_PHASE
#define IN_PH() (ph >= lo && ph < hi)
#else
#define IN_PH() true
#endif
#if MK_PER_PHASE
#define SEAM() do { ++ph; } while (0)
#else
#define SEAM() do { XcdBarrier b2_ = bar; asm volatile("" : "+s"(b2_.bar), "+s"(b2_.x)); xcd_barrier(b2_, hw_tid(F.wave)); } while (0)
#endif
#define PHASE_FRAME(Fp) Frame Fp = F; Fp.tid = hw_tid(F.wave); asm volatile("" : "+s"(Fp.ws), "+s"(Fp.out), "+v"(Fp.tid), "+s"(Fp.G), "+s"(Fp.bid)); Fp.lane = Fp.tid & 63
#if MK_PER_PHASE
#define REPBAR() do { } while (0)
#else
#define REPBAR() do { XcdBarrier b3_ = bar; asm volatile("" : "+s"(b3_.bar), "+s"(b3_.x)); xcd_barrier(b3_, hw_tid(F.wave)); } while (0)
#endif
    LAS unsigned char* ring = F.lds;
    LAS float* rtab = (LAS float*)(F.lds + RTAB_OFF); LAS float* stab = (LAS float*)(F.lds + STAB_OFF); LAS float* rawt = (LAS float*)(F.lds + RAW_OFF);

    if (PHON(0) && IN_PH()) {
_Pragma("unroll 1") for (int rep_ = 0; rep_ < NREP(0); ++rep_) { if (rep_) REPBAR(); PHASE_FRAME(Fp); p_prologue(Fp); } }
    SEAM();
#pragma unroll 1
    for (int L = 0; L < DEPTH; ++L) {
        if (PHON(1) && IN_PH()) {
_Pragma("unroll 1") for (int rep_ = 0; rep_ < NREP(1); ++rep_) { if (rep_) REPBAR();
            PHASE_FRAME(Fp); gf_t ssq4 = wsf(Fp, WS_SSQ4); gbf_t xb = wsb(Fp, WS_XB); (void)ssq4; (void)xb;
            pg8::StaticOrder S; S.init(NTOK, IN_COLS, Fp.G, Fp.bid);
            if (L < 2) { pg8::Gemm g{xb, wsb(Fp, WS_WIN) + (size_t)L * IN_COLS * DM, DM, DM, DM};
                pg8::EpiIn E{pg8::PreSsq4{ssq4, rtab, rawt}, wsb(Fp, WS_U), wsb(Fp, WS_P), wsb(Fp, WS_RQ), wsb(Fp, WS_SGP), 1.0f};
                pg8::gemm_phase<pg8::EpiIn, pg8::StaticOrder, pg8::KPlain>(ring, g, S, E, Fp.wave); }
            else { pg8::Gemm g{wsb(Fp, WS_XB8), wsb(Fp, WS_WIN8 + (size_t)(L - 2) * IN_COLS * DM), DM / 2, DM / 2, DM / 2};
                pg8::EpiIn E{pg8::PreSsq4{ssq4, rtab, rawt}, wsb(Fp, WS_U), wsb(Fp, WS_P), wsb(Fp, WS_RQ), wsb(Fp, WS_SGP), 0.03125f};
                pg8::gemm_phase<pg8::EpiIn, pg8::StaticOrder, pg8::KPlain, true>(ring, g, S, E, Fp.wave); }
        } }
        SEAM();
#if (DUP_MASK >> 12) & 1
        if (IN_PH()) { REPBAR();
            PHASE_FRAME(Fp);
            pg8::Gemm g{wsb(Fp, WS_XB), wsb(Fp, WS_WIN) + (size_t)L * IN_COLS * DM, DM, DM, DM}; pg8::HotOrder S{7, 0};
            pg8::EpiY E{pg8::PreNone{}, wsb(Fp, WS_ACT + 330 * MiB), 1.0f, nullptr, 0, 0};
            pg8::gemm_phase<pg8::EpiY, pg8::HotOrder, pg8::KPlain>(ring, g, S, E, Fp.wave);
        }
#endif
        if (PHON(2) && IN_PH()) {
_Pragma("unroll 1") for (int rep_ = 0; rep_ < NREP(2); ++rep_) { if (rep_) REPBAR(); PHASE_FRAME(Fp); p_cp(Fp, L); } }
        SEAM();
        if (PHON(3) && IN_PH()) {
_Pragma("unroll 1") for (int rep_ = 0; rep_ < NREP(3); ++rep_) { if (rep_) REPBAR();
            PHASE_FRAME(Fp); gf_t ssq4 = wsf(Fp, WS_SSQ4); gbf_t xb = wsb(Fp, WS_XB); (void)ssq4; (void)xb;
            pg8::Gemm g{wsb(Fp, WS_SD), wsb(Fp, WS_WM) + (size_t)L * DM * 640, DM, 640, 640, 2, SG_MG}; pg8::StaticOrder S; S.init(NTOK, DM, Fp.G, Fp.bid);
            if (L < 2) { pg8::EpiMerge<false> E{pg8::PreNone{}, wsb(Fp, WS_RQ), wsb(Fp, WS_SGP), wsb(Fp, WS_MERGED)}; pg8::gemm_phase<pg8::EpiMerge<false>, pg8::StaticOrder, pg8::KMerge>(ring, g, S, E, Fp.wave); }
            else { pg8::EpiMerge<true> E{pg8::PreNone{}, wsb(Fp, WS_RQ), wsb(Fp, WS_SGP), wsb(Fp, WS_MERGED)}; pg8::gemm_phase<pg8::EpiMerge<true>, pg8::StaticOrder, pg8::KMerge>(ring, g, S, E, Fp.wave); }
        } }
        SEAM();
        if (PHON(4) && IN_PH()) { {
            PHASE_FRAME(Fp); gf_t ssq4 = wsf(Fp, WS_SSQ4); gbf_t xb = wsb(Fp, WS_XB); (void)ssq4; (void)xb;
            pg8::StaticOrder S; S.init(NTOK, DM, Fp.G, Fp.bid);
            if (L < 2) { pg8::Gemm g{wsb(Fp, WS_MERGED), wsb(Fp, WS_WOUT) + (size_t)L * DM * DM, DM, DM, DM, 2, SG_OUT};
                pg8::EpiRes E{pg8::PreNone{}, xb, ssq4, stab, 1.0f, L == 0 ? Fp.ws + WS_XB8 : (GAS unsigned char*)nullptr};
                pg8::gemm_phase<pg8::EpiRes, pg8::StaticOrder, pg8::KPlain>(ring, g, S, E, Fp.wave); }
            else { pg8::Gemm g{wsb(Fp, WS_MERGED), wsb(Fp, WS_WOUT + (size_t)L * DM * DM * 2), DM / 2, DM / 2, DM / 2, 2, SG_OUT};
                pg8::EpiRes E{pg8::PreNone{}, xb, ssq4, stab, 0.03125f, L == 2 ? Fp.ws + WS_XB8 : (GAS unsigned char*)nullptr};
                pg8::gemm_phase<pg8::EpiRes, pg8::StaticOrder, pg8::KPlain, true>(ring, g, S, E, Fp.wave); }
        } }
        SEAM();
        if ((L & 1) == 0) {
            const int i = L >> 1;
            if (PHON(5) && IN_PH()) {
_Pragma("unroll 1") for (int rep_ = 0; rep_ < NREP(5); ++rep_) { if (rep_) REPBAR();
            PHASE_FRAME(Fp); gf_t ssq4 = wsf(Fp, WS_SSQ4); gbf_t xb = wsb(Fp, WS_XB); (void)ssq4; (void)xb;
                pg8::StaticOrder S; S.init(NTOK, 2 * DFF, Fp.G, Fp.bid);
                if (i == 0) { pg8::Gemm g{wsb(Fp, WS_XB8), wsb(Fp, WS_DGU), DM / 2, DM / 2, DM / 2};
                    pg8::EpiSwiglu<pg8::PreSsq4, false, true> E{pg8::PreSsq4{ssq4, rtab, rawt}, wsb(Fp, WS_HMID), DFF};
                    pg8::gemm_phase<pg8::EpiSwiglu<pg8::PreSsq4, false, true>, pg8::StaticOrder, pg8::KPlain, true>(ring, g, S, E, Fp.wave); }
                else { pg8::Gemm g{wsb(Fp, WS_XB8), wsb(Fp, WS_DGU8), DM / 2, DM / 2, DM / 2};
                    pg8::EpiSwiglu<pg8::PreSsq4, true> E{pg8::PreSsq4{ssq4, rtab, rawt}, Fp.ws + WS_H8, DFF};
                    pg8::gemm_phase<pg8::EpiSwiglu<pg8::PreSsq4, true>, pg8::StaticOrder, pg8::KPlain, true>(ring, g, S, E, Fp.wave); }
            } }
            SEAM();
            if (PHON(6) && IN_PH()) {
            PHASE_FRAME(Fp); gf_t ssq4 = wsf(Fp, WS_SSQ4); gbf_t xb = wsb(Fp, WS_XB); (void)ssq4; (void)xb;
                pg8::StaticOrder S; S.init(NTOK, DM, Fp.G, Fp.bid);
                if (i == 0) { pg8::Gemm g{wsb(Fp, WS_HMID), wsb(Fp, WS_DD), DFF, DFF, DFF, 2, SG_F2};
                    pg8::EpiRes E{pg8::PreNone{}, xb, ssq4, stab, 1.0f, nullptr};
                    pg8::gemm_phase<pg8::EpiRes, pg8::StaticOrder, pg8::KPlain>(ring, g, S, E, Fp.wave); }
                else { pg8::Gemm g{wsb(Fp, WS_H8), wsb(Fp, WS_DD8), DFF / 2, DFF / 2, DFF / 2, 2, SG_F2};
                    pg8::EpiRes E{pg8::PreNone{}, xb, ssq4, stab, 1.0f / 256.0f, Fp.ws + WS_XB8};
                    pg8::gemm_phase<pg8::EpiRes, pg8::StaticOrder, pg8::KPlain, true>(ring, g, S, E, Fp.wave); }
            }
            SEAM();
        } else {
            const int i = L >> 1;
            if (PHON(7) && IN_PH()) {
_Pragma("unroll 1") for (int rep_ = 0; rep_ < NREP(7); ++rep_) { if (rep_) REPBAR(); PHASE_FRAME(Fp); p_r1(Fp, i, L); } }
            SEAM();
            if (PHON(8) && IN_PH()) {
_Pragma("unroll 1") for (int rep_ = 0; rep_ < NREP(8); ++rep_) { if (rep_) REPBAR(); PHASE_FRAME(Fp); p_r2(Fp); } }
            SEAM();
            if (PHON(9) && IN_PH()) {
_Pragma("unroll 1") for (int rep_ = 0; rep_ < NREP(9); ++rep_) { if (rep_) REPBAR();
            PHASE_FRAME(Fp); gf_t ssq4 = wsf(Fp, WS_SSQ4); gbf_t xb = wsb(Fp, WS_XB); (void)ssq4; (void)xb;
                LAS unsigned* ptab = (LAS unsigned*)(Fp.lds + PTAB_OFF);
                for (int q = Fp.tid; q < 512; q += NWAVES * 64) ptab[q] = __hip_atomic_load(wsu(Fp, WS_PANEL) + q, RLX_AGENT);
                LDS_WAIT(); __syncthreads();
                pg8::Gemm g{wsb(Fp, WS_XG), wsb(Fp, WS_MGU + (size_t)i * NEXP * 2 * DFFE * DM), DM / 2, DM / 2, DM / 2}; pg8::MoeOrder S; S.init(ptab, 2 * DFFE, Fp.G, Fp.bid);
                pg8::EpiSwiglu8 E{pg8::PreNone{}, Fp.ws + WS_HE, DFFE};
                pg8::gemm_phase<pg8::EpiSwiglu8, pg8::MoeOrder, pg8::KPlain, true>(ring, g, S, E, Fp.wave);
            } }
            SEAM();
            if (PHON(10) && IN_PH()) {
_Pragma("unroll 1") for (int rep_ = 0; rep_ < NREP(10); ++rep_) { if (rep_) REPBAR();
            PHASE_FRAME(Fp); gf_t ssq4 = wsf(Fp, WS_SSQ4); gbf_t xb = wsb(Fp, WS_XB); (void)ssq4; (void)xb;
                LAS unsigned* ptab = (LAS unsigned*)(Fp.lds + PTAB_OFF);
                for (int q = Fp.tid; q < 512; q += NWAVES * 64) ptab[q] = __hip_atomic_load(wsu(Fp, WS_PANEL) + q, RLX_AGENT);
                LDS_WAIT(); __syncthreads();
                pg8::Gemm g{wsb(Fp, WS_HE), wsb(Fp, WS_MD + (size_t)i * NEXP * DM * DFFE), DFFE / 2, DFFE / 2, DFFE / 2}; pg8::MoeOrder2 S; S.init(ptab, Fp.G, Fp.bid);
                pg8::EpiY E{pg8::PreNone{}, wsb(Fp, WS_Y), 1.0f / 256.0f, wsb(Fp, WS_YP), S.mainP * 256, S.S == 7 ? pg8::TAIL_ROWS : pg8::TAIL_ROWS2};
                pg8::gemm_phase<pg8::EpiY, pg8::MoeOrder2, pg8::KPlainV, true, true>(ring, g, S, E, Fp.wave);
            } }
            SEAM();
            if (PHON(11) && IN_PH()) { PHASE_FRAME(Fp); p_cb(Fp, L == DEPTH - 1); }
            if (L != DEPTH - 1) SEAM();
        }
    }
#undef IN_PH
#undef SEAM
}

extern "C" void kernel_launch(void* const* d_in, const int* in_sizes, int n_in, void* d_out, int out_size, void* d_ws, size_t ws_size, hipStream_t stream) {
    static int grid = 0;
    if (grid == 0) {
        if (n_in != 20 || in_sizes[0] != NTOK * DM || out_size != NTOK * DM || ws_size < WS_END2) { fprintf(stderr, "kernel_launch: unexpected shapes / workspace (%d inputs, ws %zu, need %zu)\n", n_in, ws_size, (size_t)WS_END2); grid = -1; return; }
        int dev = 0, cus = 0, per_cu = 0;
        if (hipGetDevice(&dev) != hipSuccess || hipDeviceGetAttribute(&cus, hipDeviceAttributeMultiprocessorCount, dev) != hipSuccess) { grid = -1; return; }
        if (hipFuncSetAttribute((const void*)trunk_fwd, hipFuncAttributeMaxDynamicSharedMemorySize, LDS_BYTES) != hipSuccess) { fprintf(stderr, "kernel_launch: hipFuncSetAttribute failed\n"); grid = -1; return; }
        if (hipOccupancyMaxActiveBlocksPerMultiprocessor(&per_cu, (const void*)trunk_fwd, NWAVES * 64, LDS_BYTES) != hipSuccess || per_cu < 1) { fprintf(stderr, "kernel_launch: occupancy query says %d blocks per CU\n", per_cu); grid = -1; (void)hipGetLastError(); return; }
        grid = cus;
    }
    if (grid < 0) return;
    if (hipMemsetAsync((char*)d_ws + WS_CTL, 0, CTL_ZERO_BYTES, stream) != hipSuccess) return;
    Args a{};
    for (int i = 0; i < 20; ++i) a.in[i] = (const float*)d_in[i];
    a.out = (float*)d_out; a.ws = (unsigned char*)d_ws;
#if MK_PER_PHASE
    for (int p = 0; p < N_PHASES; ++p) { a.ph_lo = p; a.ph_hi = p + 1; hipLaunchKernelGGL(trunk_fwd, dim3(grid), dim3(NWAVES * 64), LDS_BYTES, stream, a); }
#else
    a.ph_lo = 0; a.ph_hi = N_PHASES;
    hipLaunchKernelGGL(trunk_fwd, dim3(grid), dim3(NWAVES * 64), LDS_BYTES, stream, a);
#endif
}
```
